# Optimizing an MI355X kernel written in HIP

```python
import jax, jax.numpy as jnp
from jax import lax
import numpy as np

D_MODEL = 1024
BATCH = 8
SEQ = 4096
DEPTH = 2

CHUNK = 64
N_A_LAYERS = DEPTH // 2
N_B_LAYERS = DEPTH - N_A_LAYERS
N_DENSE = (DEPTH + 1) // 2
N_MOE = DEPTH // 2

MLSTM_HEADS = 8
MLSTM_QK_DIM = D_MODEL // 16
MLSTM_V_DIM = D_MODEL // 8
MLSTM_QK = MLSTM_HEADS * MLSTM_QK_DIM
MLSTM_V = MLSTM_HEADS * MLSTM_V_DIM
MLSTM_PROJ = 2 * MLSTM_QK + 2 * MLSTM_V + 2 * MLSTM_HEADS
GATE_SOFTCAP = 15.0

SB_HEADS = 16
SB_HEAD_DIM = D_MODEL // SB_HEADS
SB_WIDTH = SB_HEADS * SB_HEAD_DIM
Q_BLOCK = 128

FFN_DIM = 2816
N_EXPERTS = 8
TOP_K = 2
EXPERT_DIM = 3584
EPS = 1e-6

kernel_name = "yoco_mlstm_stickbreaking_moe_trunk"


def rmsnorm(x, g):
    xf = x.astype(jnp.float32)
    y = xf * lax.rsqrt(jnp.mean(xf * xf, axis=-1, keepdims=True) + EPS)
    return (y * g.astype(jnp.float32)).astype(x.dtype)


def head_rms(x, g):
    xf = x.astype(jnp.float32)
    return xf * lax.rsqrt(jnp.mean(xf * xf, axis=-1, keepdims=True) + EPS) * g.astype(jnp.float32)


def swiglu(x, w_gate, w_up, w_down):
    return (jax.nn.silu(x @ w_gate) * (x @ w_up)) @ w_down


def soft_cap(z):
    return GATE_SOFTCAP * jnp.tanh(z / GATE_SOFTCAP)


def mlstm_chunkwise(q, k, v, ig, fg):
    B, H, S, dk = q.shape
    dv = v.shape[-1]
    L = CHUNK
    NC = S // L
    q = q.reshape(B, H, NC, L, dk)
    k = k.reshape(B, H, NC, L, dk)
    v = v.reshape(B, H, NC, L, dv)
    ig = ig.reshape(B, H, NC, L)
    b = lax.cumsum(jax.nn.log_sigmoid(fg).reshape(B, H, NC, L), axis=3)
    b_last = b[..., -1]
    g = b_last[..., None] - b + ig
    g_max = jnp.max(g, axis=-1)
    w = jnp.exp(g - g_max[..., None])
    c_loc = jnp.einsum('bhclv,bhclk->bhcvk', v * w[..., None], k)
    n_loc = jnp.einsum('bhcl,bhclk->bhck', w, k)

    def step(carry, inp):
        c, n, m = carry
        cl, nl, bl, gm = inp
        m_new = jnp.maximum(bl + m, gm)
        a = jnp.exp(bl + m - m_new)
        e = jnp.exp(gm - m_new)
        c_new = a[..., None, None] * c + e[..., None, None] * cl
        n_new = a[..., None] * n + e[..., None] * nl
        return (c_new, n_new, m_new), (c, n, m)

    init = (jnp.zeros((B, H, dv, dk), jnp.float32),
            jnp.zeros((B, H, dk), jnp.float32),
            jnp.full((B, H), -jnp.inf, jnp.float32))
    xs = (jnp.moveaxis(c_loc, 2, 0), jnp.moveaxis(n_loc, 2, 0),
          jnp.moveaxis(b_last, 2, 0), jnp.moveaxis(g_max, 2, 0))
    _, (c_prev, n_prev, m_prev) = lax.scan(step, init, xs)
    c_prev = jnp.moveaxis(c_prev, 0, 2)
    n_prev = jnp.moveaxis(n_prev, 0, 2)
    m_prev = jnp.moveaxis(m_prev, 0, 2)

    causal = jnp.tril(jnp.ones((L, L), dtype=bool))
    log_d = jnp.where(causal, b[..., :, None] - b[..., None, :] + ig[..., None, :], -jnp.inf)
    a_inter = b + m_prev[..., None]
    m_t = jnp.maximum(a_inter, jnp.max(log_d, axis=-1))
    s = jnp.einsum('bhctk,bhcsk->bhcts', q, k) * jnp.exp(log_d - m_t[..., None])
    w_inter = jnp.exp(a_inter - m_t)
    num = (jnp.einsum('bhcts,bhcsv->bhctv', s, v)
           + w_inter[..., None] * jnp.einsum('bhctk,bhcvk->bhctv', q, c_prev))
    den = jnp.sum(s, axis=-1) + w_inter * jnp.einsum('bhctk,bhck->bhct', q, n_prev)
    h = num / jnp.maximum(jnp.abs(den), jnp.exp(-m_t))[..., None]
    return h.reshape(B, H, S, dv)


def mlstm_mixer(xn, w_in, b_igate, b_fgate, g_h, w_out):
    B, S, _ = xn.shape
    H = MLSTM_HEADS
    proj = xn @ w_in
    o0 = 0
    q = proj[..., o0:o0 + MLSTM_QK]; o0 += MLSTM_QK
    k = proj[..., o0:o0 + MLSTM_QK]; o0 += MLSTM_QK
    v = proj[..., o0:o0 + MLSTM_V]; o0 += MLSTM_V
    og = proj[..., o0:o0 + MLSTM_V]; o0 += MLSTM_V
    ig = proj[..., o0:o0 + H]; o0 += H
    fg = proj[..., o0:o0 + H]
    to_heads = lambda t, d: jnp.transpose(t.reshape(B, S, H, d), (0, 2, 1, 3)).astype(jnp.float32)
    q = to_heads(q, MLSTM_QK_DIM)
    k = to_heads(k, MLSTM_QK_DIM) * (MLSTM_QK_DIM ** -0.5)
    v = to_heads(v, MLSTM_V_DIM)
    ig = soft_cap(jnp.transpose(ig.astype(jnp.float32) + b_igate, (0, 2, 1)))
    fg = soft_cap(jnp.transpose(fg.astype(jnp.float32) + b_fgate, (0, 2, 1)))
    h = mlstm_chunkwise(q, k, v, ig, fg)
    h = head_rms(h, jnp.ones((), jnp.float32))
    h = jnp.transpose(h, (0, 2, 1, 3)).reshape(B, S, MLSTM_V) * g_h.astype(jnp.float32)
    h = h * jax.nn.sigmoid(og.astype(jnp.float32))
    return h.astype(xn.dtype) @ w_out


def stick_breaking(q, k, v):
    B, H, S, d = q.shape
    NB = S // Q_BLOCK
    qb = jnp.moveaxis(q.reshape(B, H, NB, Q_BLOCK, d), 2, 0)
    key_pos = jnp.arange(S)

    def block(args):
        qi, t0 = args
        z = jnp.einsum('bhtd,bhsd->bhts', qi, k) * (d ** -0.5)
        t_pos = t0 + jnp.arange(Q_BLOCK)
        mask = key_pos[None, :] < t_pos[:, None]
        log_beta = jax.nn.log_sigmoid(z)
        log_1m = jnp.where(mask, log_beta - z, 0.0)
        between = lax.cumsum(log_1m, axis=3, reverse=True) - log_1m
        a = jnp.where(mask, jnp.exp(log_beta + between), 0.0)
        return jnp.einsum('bhts,bhsd->bhtd', a, v)

    out = lax.map(block, (qb, jnp.arange(NB, dtype=jnp.int32) * Q_BLOCK))
    return jnp.moveaxis(out, 0, 2).reshape(B, H, S, d)


def shared_kv(x, kv_norm, w_kv, g_k):
    B, S, _ = x.shape
    kv = rmsnorm(x, kv_norm) @ w_kv
    k = kv[..., :SB_WIDTH].reshape(B, S, SB_HEADS, SB_HEAD_DIM)
    v = kv[..., SB_WIDTH:].reshape(B, S, SB_HEADS, SB_HEAD_DIM)
    k = jnp.transpose(head_rms(k, g_k), (0, 2, 1, 3))
    v = jnp.transpose(v.astype(jnp.float32), (0, 2, 1, 3))
    return k, v


def sb_mixer(xn, k, v, w_q, g_q, w_o):
    B, S, _ = xn.shape
    q = (xn @ w_q).reshape(B, S, SB_HEADS, SB_HEAD_DIM)
    q = jnp.transpose(head_rms(q, g_q), (0, 2, 1, 3))
    o = stick_breaking(q, k, v)
    o = jnp.transpose(o, (0, 2, 1, 3)).reshape(B, S, SB_WIDTH).astype(xn.dtype)
    return o @ w_o


def moe_swiglu(xn, w_router, w_gate, w_up, w_down):
    B, S, D = xn.shape
    t = xn.reshape(B * S, D)
    logits = (t @ w_router).astype(jnp.float32)
    top_val, top_idx = lax.top_k(logits, TOP_K)
    top_w = jax.nn.softmax(top_val, axis=-1)
    combine = jnp.sum(jax.nn.one_hot(top_idx, N_EXPERTS, dtype=jnp.float32) * top_w[..., None], axis=1)
    combine = combine.astype(t.dtype)
    y = jnp.zeros_like(t)
    for e in range(N_EXPERTS):
        y = y + combine[:, e:e + 1] * swiglu(t, w_gate[e], w_up[e], w_down[e])
    return y.reshape(B, S, D)


def _normal(k, shape, scale):
    return jax.random.normal(k, shape, jnp.float32) * scale


def setup_inputs(seed: int = 0) -> dict:
    key = jax.random.key(seed)
    ks = jax.random.split(key, 24)
    D = D_MODEL
    return {
        "x": _normal(ks[0], (BATCH, SEQ, D), 1.0),
        "mix_norm": 1.0 + _normal(ks[1], (DEPTH, D), 0.05),
        "ffn_norm": 1.0 + _normal(ks[2], (DEPTH, D), 0.05),
        "mlstm_w_in": _normal(ks[3], (N_A_LAYERS, D, MLSTM_PROJ), D ** -0.5),
        "mlstm_b_igate": _normal(ks[4], (N_A_LAYERS, MLSTM_HEADS), 0.1),
        "mlstm_b_fgate": 3.0 + _normal(ks[5], (N_A_LAYERS, MLSTM_HEADS), 0.5),
        "mlstm_g_h": 1.0 + _normal(ks[6], (N_A_LAYERS, MLSTM_V), 0.05),
        "mlstm_w_out": _normal(ks[7], (N_A_LAYERS, MLSTM_V, D), MLSTM_V ** -0.5),
        "kv_norm": 1.0 + _normal(ks[8], (D,), 0.05),
        "w_kv": _normal(ks[9], (D, 2 * SB_WIDTH), D ** -0.5),
        "g_k": 1.0 + _normal(ks[10], (SB_HEAD_DIM,), 0.05),
        "sb_w_q": _normal(ks[11], (N_B_LAYERS, D, SB_WIDTH), D ** -0.5),
        "sb_g_q": 1.0 + _normal(ks[12], (N_B_LAYERS, SB_HEAD_DIM), 0.05),
        "sb_w_o": _normal(ks[13], (N_B_LAYERS, SB_WIDTH, D), SB_WIDTH ** -0.5),
        "ffn_w_gate": _normal(ks[14], (N_DENSE, D, FFN_DIM), D ** -0.5),
        "ffn_w_up": _normal(ks[15], (N_DENSE, D, FFN_DIM), D ** -0.5),
        "ffn_w_down": _normal(ks[16], (N_DENSE, FFN_DIM, D), FFN_DIM ** -0.5),
        "moe_w_router": _normal(ks[17], (N_MOE, D, N_EXPERTS), D ** -0.5),
        "moe_w_gate": _normal(ks[18], (N_MOE, N_EXPERTS, D, EXPERT_DIM), D ** -0.5),
        "moe_w_up": _normal(ks[19], (N_MOE, N_EXPERTS, D, EXPERT_DIM), D ** -0.5),
        "moe_w_down": _normal(ks[20], (N_MOE, N_EXPERTS, EXPERT_DIM, D), EXPERT_DIM ** -0.5),
    }


def reference(x, mix_norm, ffn_norm, mlstm_w_in, mlstm_b_igate, mlstm_b_fgate, mlstm_g_h,
              mlstm_w_out, kv_norm, w_kv, g_k, sb_w_q, sb_g_q, sb_w_o, ffn_w_gate, ffn_w_up,
              ffn_w_down, moe_w_router, moe_w_gate, moe_w_up, moe_w_down):
    k_sh = None
    v_sh = None
    for layer in range(DEPTH):
        xn = rmsnorm(x, mix_norm[layer])
        if layer < N_A_LAYERS:
            x = x + mlstm_mixer(xn, mlstm_w_in[layer], mlstm_b_igate[layer], mlstm_b_fgate[layer],
                                mlstm_g_h[layer], mlstm_w_out[layer])
        else:
            if layer == N_A_LAYERS:
                k_sh, v_sh = shared_kv(x, kv_norm, w_kv, g_k)
                xn = rmsnorm(x, mix_norm[layer])
            j = layer - N_A_LAYERS
            x = x + sb_mixer(xn, k_sh, v_sh, sb_w_q[j], sb_g_q[j], sb_w_o[j])
        xn = rmsnorm(x, ffn_norm[layer])
        if layer % 2 == 0:
            i = layer // 2
            x = x + swiglu(xn, ffn_w_gate[i], ffn_w_up[i], ffn_w_down[i])
        else:
            i = layer // 2
            x = x + moe_swiglu(xn, moe_w_router[i], moe_w_gate[i], moe_w_up[i], moe_w_down[i])
    return x
```

```cpp
#include <hip/hip_runtime.h>
#include <cstdio>
#include <cstdint>
#define GAS __attribute__((address_space(1)))
#define LAS __attribute__((address_space(3)))
typedef unsigned short bf16;
typedef unsigned short bf16_t;
typedef short bf16x8 __attribute__((ext_vector_type(8)));
typedef float f32x4 __attribute__((ext_vector_type(4)));
typedef float f32x2 __attribute__((ext_vector_type(2)));
typedef float f32x16 __attribute__((ext_vector_type(16)));
typedef unsigned u32x4 __attribute__((ext_vector_type(4)));
typedef unsigned u32x2 __attribute__((ext_vector_type(2)));
typedef GAS unsigned gu32;
#define RLX_AGENT __ATOMIC_RELAXED, __HIP_MEMORY_SCOPE_AGENT
#define LDS_WAIT() asm volatile("s_waitcnt lgkmcnt(0)" ::: "memory")
#define VM_WAIT() asm volatile("s_waitcnt vmcnt(0)" ::: "memory")

constexpr int DM = 1024, NBATCH = 8, SEQ = 4096, MTOK = NBATCH * SEQ;
constexpr int MH = 8, MDK = 64, MDV = 128, MPROJ = 3088, MPROJ_MAIN = 3072;
constexpr int SBH = 16, SBD = 64;
constexpr int FFN = 2816, NEXP = 8, EDIM = 3584;
constexpr float EPS = 1e-6f, SOFTCAP = 15.0f;
constexpr float LOG2E = 1.4426950408889634f;
constexpr int NWAVES = 8;
constexpr int MAXTILES = 264;
constexpr int HALF0_TILES = 128;
namespace pg8 {
constexpr int BM = 256, BK = 64, HALF = 128, HTB = HALF * BK * 2  , STAGE_BYTES = 8 * HTB, NXCD = 8, WGM = 8;

__host__ __device__ __forceinline__ int lds_byte(int r, int c) { const int st = (r >> 4) * 2 + (c >> 5), rr = r & 15, cc = c & 31, ob = rr * 64 + cc * 2; return st * 1024 + (ob ^ (((ob >> 9) & 1) << 5)); }
__host__ __device__ __forceinline__ void stage_rc(int b, int& R, int& C) { const int st = b / 1024, sb = b % 1024, swz = sb ^ (((sb >> 9) & 1) << 5); R = (st >> 1) * 16 + swz / 64; C = (st & 1) * 32 + (swz % 64) / 2; }
__host__ __device__ __forceinline__ int perm32(int rho) { const int n = rho >> 4, i = rho & 15; return 8 * (i >> 2) + 4 * n + (i & 3); }

struct Unit { int pm, pn, pb, pa; };
struct Gemm { const bf16_t* A; const bf16_t* Bt; int K; };

struct StaticOrder {
    int nM, nN, nwg, G, c;
    __device__ void init(int M, int N, int G_, int c_) { nM = M / BM; nN = N / BM; nwg = nM * nN; G = G_; c = c_; }
    __device__ bool next(int i, Unit& u) const {
        const long L = (long)i * G + c; if (L >= nwg) return false;
        int wgid = (int)L; { const int q = nwg / NXCD, r = nwg % NXCD, xcd = wgid % NXCD, off = wgid / NXCD; wgid = (xcd < r ? xcd * (q + 1) : r * (q + 1) + (xcd - r) * q) + off; }
        const int nig = WGM * nN, gid = wgid / nig, fm = gid * WGM, gsz = (nM - fm) < WGM ? (nM - fm) : WGM;
        u.pm = fm + ((wgid % nig) % gsz); u.pn = (wgid % nig) / gsz; u.pb = u.pn; u.pa = u.pm; return true;
    }
};
struct MoeOrder {
    int tile_lo, ntile, nN, G, c; const LAS int* texp;
    __device__ bool next(int i, Unit& u) const {
        const long L = (long)i * G + c; if (L >= (long)ntile * nN) return false;
        const int t = (int)(L / nN); u.pn = (int)(L % nN); u.pm = tile_lo + t; u.pa = t; u.pb = __builtin_amdgcn_readfirstlane(texp[u.pm]) * nN + u.pn; return true;
    }
};

__device__ __forceinline__ unsigned cvt_pk_bf16(float lo, float hi) { unsigned r; asm volatile("v_cvt_pk_bf16_f32 %0, %1, %2" : "=v"(r) : "v"(lo), "v"(hi)); return r; }

template <class Epi, class Sched, bool GATHER>
__device__ __forceinline__ void gemm_phase(LAS unsigned char* lds, LAS unsigned char* auxb, const Gemm g, const Sched& S, const Epi& E) {
    constexpr int NAUX = Epi::NAUX;
    const int tid = threadIdx.x, wid = __builtin_amdgcn_readfirstlane(tid >> 6), lane = tid & 63, wr = wid >> 2, wc = wid & 3, fr = lane & 15, fq = lane >> 4;
    const int K = g.K, nt = K / BK;
    unsigned voffB[2]; int Rr[2], Cc[2];
#pragma unroll
    for (int i = 0; i < 2; ++i) { int R, C; stage_rc(tid * 16 + i * 8192, R, C); const int Rb = Epi::PERM ? ((R & ~31) + perm32(R & 31)) : R;
        Rr[i] = R; Cc[i] = C; voffB[i] = (unsigned)(Rb * K + C) * 2u; }
    const size_t kstep = (size_t)(BK * 2);
    const size_t hstep = (size_t)HALF * K * 2;
    const size_t tstep = 2 * hstep;
    const unsigned ldsw = (unsigned)wid * 1024u;
    const int aoff = lds_byte(wr * 64 + fr, fq * 8), boff = lds_byte(wc * 32 + fr, fq * 8);
#define PG8_SA(b, h) (((b) * 2 + (h)) * HTB)
#define PG8_SB(b, h) ((4 + (b) * 2 + (h)) * HTB)
#define PG8_STAGE(bufoff, gbase, voff) do { _Pragma("unroll") for (int _i = 0; _i < 2; ++_i) \
        __builtin_amdgcn_global_load_lds((const unsigned*)((const char*)(gbase) + (voff)[_i]), (LAS unsigned*)(lds + (bufoff) + ldsw + _i * 8192), 16, 0, 0); } while (0)
#define PG8_LDA(dst, b, h) do { _Pragma("unroll") for (int m = 0; m < 4; ++m) _Pragma("unroll") for (int k = 0; k < 2; ++k) dst[m][k] = *(const LAS bf16x8*)(lds + PG8_SA(b, h) + aoff + m * 2048 + k * 1024); } while (0)
#define PG8_LDB(dst, b, h) do { _Pragma("unroll") for (int n = 0; n < 2; ++n) _Pragma("unroll") for (int k = 0; k < 2; ++k) dst[n][k] = *(const LAS bf16x8*)(lds + PG8_SB(b, h) + boff + n * 2048 + k * 1024); } while (0)
#define PG8_MMA(ai, bj, At, Bt) do { __builtin_amdgcn_s_setprio(1); _Pragma("unroll") for (int m = 0; m < 4; ++m) _Pragma("unroll") for (int n = 0; n < 2; ++n) _Pragma("unroll") for (int k = 0; k < 2; ++k) \
        acc[ai][bj][m][n] = __builtin_amdgcn_mfma_f32_16x16x32_bf16(Bt[n][k], At[m][k], acc[ai][bj][m][n], 0, 0, 0); __builtin_amdgcn_s_setprio(0); } while (0)
#define PG8_WAIT_V(n) asm volatile("s_waitcnt vmcnt(" #n ")" ::: "memory")
#define PG8_WAIT_L(n) asm volatile("s_waitcnt lgkmcnt(" #n ")" ::: "memory")
#define PG8_BAR __builtin_amdgcn_s_barrier()
#define PG8_SCHED __builtin_amdgcn_sched_barrier(0)
#define PG8_VA(dst, par) do { _Pragma("unroll") for (int _h = 0; _h < 2; ++_h) _Pragma("unroll") for (int _i = 0; _i < 2; ++_i) { \
        if constexpr (GATHER) { const int _ix = ((const LAS int*)(auxb + (size_t)(par) * NAUX * 1024))[_h * HALF + Rr[_i]]; dst[_h][_i] = (unsigned)_ix * (unsigned)(K * 2) + (unsigned)(Cc[_i] * 2); } \
        else dst[_h][_i] = (unsigned)((_h * HALF + Rr[_i]) * K + Cc[_i]) * 2u; } } while (0)
#define PG8_AUX(un, par) do { if constexpr (NAUX > 0) { const unsigned* _src = (const unsigned*)((const char*)E.aux_src(un) + lane * 16); LAS unsigned* _dst = (LAS unsigned*)(auxb + (size_t)((par) * NAUX) * 1024); \
        _Pragma("unroll") for (int _p = 0; _p < NAUX; ++_p) { __builtin_amdgcn_global_load_lds(_src, _dst, 16, 0, 0); _src += 256; _dst += 256; asm volatile("" : "+v"(_src)); } } } while (0)
    Unit cur, nxt, prv; int ui = 0;
    if (!S.next(0, cur)) return;
    prv = cur;
    f32x4 acc[2][2][4][2];
#pragma unroll
    for (int a = 0; a < 2; ++a)
#pragma unroll
        for (int b = 0; b < 2; ++b)
#pragma unroll
            for (int m = 0; m < 4; ++m)
#pragma unroll
                for (int n = 0; n < 2; ++n) acc[a][b][m][n] = (f32x4){0.f, 0.f, 0.f, 0.f};
    bf16x8 At[4][2], B0[2][2], B1[2][2];
    unsigned vAc[2][2], vAn[2][2];
    if constexpr (NAUX > 0) { if (wid == 0) PG8_AUX(cur, 0); PG8_WAIT_V(0); PG8_BAR; }
    PG8_VA(vAc, 0);
#pragma unroll
    for (int h = 0; h < 2; ++h)
#pragma unroll
        for (int i = 0; i < 2; ++i) vAn[h][i] = vAc[h][i];
    const char* cA = GATHER ? (const char*)g.A : (const char*)g.A + (size_t)cur.pa * tstep; const char* cB = (const char*)g.Bt + (size_t)cur.pb * tstep;
    PG8_STAGE(PG8_SB(0, 0), cB, voffB); PG8_STAGE(PG8_SB(0, 1), cB + hstep, voffB); PG8_STAGE(PG8_SA(0, 0), cA, vAc[0]); PG8_STAGE(PG8_SA(0, 1), cA, vAc[1]);
    if (wr == 1) PG8_BAR;
    PG8_WAIT_V(2); PG8_BAR;
    PG8_STAGE(PG8_SB(1, 0), cB + kstep, voffB); PG8_STAGE(PG8_SA(1, 0), cA + kstep, vAc[0]); PG8_STAGE(PG8_SB(1, 1), cB + hstep + kstep, voffB);
    PG8_WAIT_V(6); PG8_BAR;
    for (;;) {
        const bool has_next = S.next(ui + 1, nxt);
        const char* nA = has_next ? (GATHER ? (const char*)g.A : (const char*)g.A + (size_t)nxt.pa * tstep) : cA; const char* nB = has_next ? (const char*)g.Bt + (size_t)nxt.pb * tstep : cB;
        for (int t = 0; t < nt; t += 2) {
            const bool last = (t == nt - 2);
            if constexpr (NAUX > 0) { if (t == 2 && has_next && wid == 4) PG8_AUX(nxt, (ui + 1) & 1); }
            if (last && has_next) { PG8_VA(vAn, (ui + 1) & 1); }
            const char* a1 = cA + (size_t)(t + 1) * kstep;
            const char* a2 = last ? nA : cA + (size_t)(t + 2) * kstep; const char* b2 = last ? nB : cB + (size_t)(t + 2) * kstep;
            const char* a3 = a2 + kstep; const char* b3 = b2 + kstep;
            unsigned v2[2][2];
#pragma unroll
            for (int h = 0; h < 2; ++h)
#pragma unroll
                for (int i = 0; i < 2; ++i) v2[h][i] = (last && has_next) ? vAn[h][i] : vAc[h][i];
            PG8_LDB(B0, 0, 0); PG8_LDB(B1, 0, 1); PG8_SCHED; PG8_LDA(At, 0, 0); PG8_STAGE(PG8_SA(1, 1), a1, vAc[1]);
            PG8_WAIT_V(8); PG8_WAIT_L(0); PG8_BAR; PG8_MMA(0, 0, At, B0); PG8_MMA(0, 1, At, B1); PG8_BAR; PG8_SCHED;
            PG8_LDA(At, 0, 1); PG8_STAGE(PG8_SB(0, 0), b2, voffB); PG8_STAGE(PG8_SB(0, 1), b2 + hstep, voffB); PG8_STAGE(PG8_SA(0, 0), a2, v2[0]);
            PG8_WAIT_V(8); PG8_WAIT_L(0); PG8_BAR; PG8_MMA(1, 0, At, B0); PG8_MMA(1, 1, At, B1); PG8_BAR; PG8_SCHED;
            PG8_LDB(B0, 1, 0); PG8_LDB(B1, 1, 1); PG8_SCHED; PG8_LDA(At, 1, 0); PG8_STAGE(PG8_SA(0, 1), a2, v2[1]);
            PG8_WAIT_V(8); PG8_WAIT_L(0); PG8_BAR; PG8_MMA(0, 0, At, B0); PG8_MMA(0, 1, At, B1); PG8_BAR; PG8_SCHED;
            PG8_LDA(At, 1, 1); PG8_STAGE(PG8_SB(1, 0), b3, voffB); PG8_STAGE(PG8_SB(1, 1), b3 + hstep, voffB); PG8_STAGE(PG8_SA(1, 0), a3, v2[0]);
            PG8_WAIT_V(8); PG8_WAIT_L(0); PG8_BAR; PG8_MMA(1, 0, At, B0); PG8_MMA(1, 1, At, B1); PG8_BAR; PG8_SCHED;
        }
        if (wr == 0) PG8_BAR;
        E(acc, cur, wr, wc, fr, fq, (const LAS unsigned char*)(auxb + (size_t)(ui & 1) * NAUX * 1024), ui, prv);
        if (!has_next) break;
#pragma unroll
        for (int a = 0; a < 2; ++a)
#pragma unroll
            for (int b = 0; b < 2; ++b)
#pragma unroll
                for (int m = 0; m < 4; ++m)
#pragma unroll
                    for (int n = 0; n < 2; ++n) acc[a][b][m][n] = (f32x4){0.f, 0.f, 0.f, 0.f};
        prv = cur; cur = nxt; cA = nA; cB = nB; ++ui;
#pragma unroll
        for (int h = 0; h < 2; ++h)
#pragma unroll
            for (int i = 0; i < 2; ++i) vAc[h][i] = vAn[h][i];
        if (wr == 1) PG8_BAR;
    }
    PG8_WAIT_V(0); PG8_WAIT_L(0);
    PG8_BAR;
    E.finish(cur, ui);
#undef PG8_SA
#undef PG8_SB
#undef PG8_STAGE
#undef PG8_LDA
#undef PG8_LDB
#undef PG8_MMA
#undef PG8_WAIT_V
#undef PG8_WAIT_L
#undef PG8_BAR
#undef PG8_SCHED
#undef PG8_VA
#undef PG8_AUX
}
}
namespace pg8 {
__device__ __forceinline__ float sigmoid_fast(float x) { return __builtin_amdgcn_rcpf(1.0f + __builtin_amdgcn_exp2f(-LOG2E * x)); }
template <int NP> __device__ __forceinline__ float row_rs(const LAS unsigned char* aux, int rl) {
    const LAS float* ax = (const LAS float*)aux; float ss = ax[rl];
#pragma unroll
    for (int p = 1; p < NP; ++p) ss += ax[p * 256 + rl];
    return rsqrtf(ss * (1.0f / DM) + EPS);
}
__device__ __forceinline__ u32x4 pack8(const f32x4 a, const f32x4 b) { u32x4 w; w.x = cvt_pk_bf16(a[0], a[1]); w.y = cvt_pk_bf16(a[2], a[3]); w.z = cvt_pk_bf16(b[0], b[1]); w.w = cvt_pk_bf16(b[2], b[3]); return w; }

struct EpiProj {
    static constexpr bool PERM = true; static constexpr int NAUX = 1;
    bf16_t* Q; bf16_t* Kk; bf16_t* V; bf16_t* OG; const float* ss0;
    __device__ __forceinline__ const void* aux_src(const Unit& u) const { return ss0 + (size_t)u.pm * 256; }
    __device__ __forceinline__ void operator()(const f32x4 (&acc)[2][2][4][2], const Unit& u, int wr, int wc, int fr, int fq, const LAS unsigned char* aux, int, const Unit&) const {
        asm volatile("" : "+v"(fr), "+v"(fq));
        bf16_t* base; int ldc, colt; bool sig = false; const int pn = u.pn;
        if (pn < 2) { base = Q; ldc = 512; colt = pn * 256; } else if (pn < 4) { base = Kk; ldc = 512; colt = (pn - 2) * 256; }
        else if (pn < 8) { base = V; ldc = 1024; colt = (pn - 4) * 256; } else { base = OG; ldc = 1024; colt = (pn - 8) * 256; sig = true; }
#pragma unroll
        for (int ai = 0; ai < 2; ++ai)
#pragma unroll
            for (int m = 0; m < 4; ++m) { const int rl = ai * HALF + wr * 64 + m * 16 + fr; const float rs = row_rs<1>(aux, rl);
                bf16_t* rowp = base + (size_t)(u.pm * BM + rl) * ldc + colt + wc * 32 + 8 * fq;
#pragma unroll
                for (int bj = 0; bj < 2; ++bj) { f32x4 v0 = acc[ai][bj][m][0] * rs, v1 = acc[ai][bj][m][1] * rs;
                    if (sig) {
#pragma unroll
                        for (int j = 0; j < 4; ++j) { v0[j] = sigmoid_fast(v0[j]); v1[j] = sigmoid_fast(v1[j]); } }
                    *(u32x4*)(rowp + bj * HALF) = pack8(v0, v1); }
                asm volatile("" ::: "memory"); }
    }
    __device__ __forceinline__ void finish(const Unit&, int) const {}
};

struct EpiRes {
    static constexpr bool PERM = true; static constexpr int NAUX = 0;
    const float* base; float* out; bf16_t* xb; float* ssp; LAS float* red;
    __device__ __forceinline__ const void* aux_src(const Unit&) const { return nullptr; }
    __device__ __forceinline__ void flush(const Unit& p, int par) const {
        if (threadIdx.x < 256) { const LAS float* r = red + par * 1024; const int row = threadIdx.x; ssp[((size_t)p.pm * 4 + p.pn) * 256 + row] = (r[row] + r[256 + row]) + (r[512 + row] + r[768 + row]); } }
    __device__ __forceinline__ void operator()(const f32x4 (&acc)[2][2][4][2], const Unit& u, int wr, int wc, int fr, int fq, const LAS unsigned char*, int ui, const Unit& prv) const {
        asm volatile("" : "+v"(fr), "+v"(fq));
        if (ssp && ui > 0) flush(prv, (ui - 1) & 1);
#pragma unroll
        for (int ai = 0; ai < 2; ++ai)
#pragma unroll
            for (int m = 0; m < 4; ++m) { const int rl = ai * HALF + wr * 64 + m * 16 + fr; const size_t off = (size_t)(u.pm * BM + rl) * DM + u.pn * BM + wc * 32 + 8 * fq; float ss = 0.f;
#pragma unroll
                for (int bj = 0; bj < 2; ++bj) { const f32x4 b0 = *(const f32x4*)(base + off + bj * HALF), b1 = *(const f32x4*)(base + off + bj * HALF + 4);
                    const f32x4 v0 = acc[ai][bj][m][0] + b0, v1 = acc[ai][bj][m][1] + b1;
                    *(f32x4*)(out + off + bj * HALF) = v0; *(f32x4*)(out + off + bj * HALF + 4) = v1; *(u32x4*)(xb + off + bj * HALF) = pack8(v0, v1);
                    ss += (v0[0] * v0[0] + v0[1] * v0[1]) + (v0[2] * v0[2] + v0[3] * v0[3]) + (v1[0] * v1[0] + v1[1] * v1[1]) + (v1[2] * v1[2] + v1[3] * v1[3]); }
                if (ssp) { ss += __shfl_xor(ss, 16); ss += __shfl_xor(ss, 32); if (fq == 0) red[(ui & 1) * 1024 + wc * 256 + rl] = ss; }
                asm volatile("" ::: "memory"); }
    }
    __device__ __forceinline__ void finish(const Unit& last, int ui) const { if (ssp) flush(last, ui & 1); }
};

template <bool MOE> struct EpiGu {
    static constexpr bool PERM = true; static constexpr int NAUX = MOE ? 3 : 4;
    bf16_t* H; int ldh; const float* ssp;
    __device__ __forceinline__ const void* aux_src(const Unit& u) const { return ssp + (size_t)u.pm * 1024; }
    __device__ __forceinline__ void operator()(const f32x4 (&acc)[2][2][4][2], const Unit& u, int wr, int wc, int fr, int fq, const LAS unsigned char* aux, int, const Unit&) const {
        asm volatile("" : "+v"(fr), "+v"(fq));
#pragma unroll
        for (int ai = 0; ai < 2; ++ai)
#pragma unroll
            for (int m = 0; m < 4; ++m) { const int rl = ai * HALF + wr * 64 + m * 16 + fr; float rs, w = 1.f;
                if constexpr (MOE) { rs = ((const LAS float*)(aux + 1024))[rl]; w = ((const LAS float*)(aux + 2048))[rl]; } else rs = row_rs<4>(aux, rl);
                bf16_t* rowp = H + (size_t)(u.pa * BM + rl) * ldh + u.pn * HALF + wc * 32 + 8 * fq;
                f32x4 h[2];
#pragma unroll
                for (int n = 0; n < 2; ++n) { const f32x4 gg = acc[ai][0][m][n] * rs, uu = acc[ai][1][m][n] * rs;
#pragma unroll
                    for (int j = 0; j < 4; ++j) h[n][j] = gg[j] * sigmoid_fast(gg[j]) * uu[j] * w; }
                *(u32x4*)rowp = pack8(h[0], h[1]);
                asm volatile("" ::: "memory"); }
    }
    __device__ __forceinline__ void finish(const Unit&, int) const {}
};

struct EpiKvq {
    static constexpr bool PERM = true; static constexpr int NAUX = 4;
    bf16_t* Kb; bf16_t* Vt; bf16_t* Qb; const float* ssp; const LAS float* gk;
    __device__ __forceinline__ const void* aux_src(const Unit& u) const { return ssp + (size_t)u.pm * 1024; }
    __device__ __forceinline__ void operator()(const f32x4 (&acc)[2][2][4][2], const Unit& u, int wr, int wc, int fr, int fq, const LAS unsigned char* aux, int, const Unit&) const {
        asm volatile("" : "+v"(fr), "+v"(fq));
        const int kind = u.pn >> 2, hd = (u.pn & 3) * 4 + wc;
#pragma unroll
        for (int ai = 0; ai < 2; ++ai)
#pragma unroll
            for (int m = 0; m < 4; ++m) { const int rl = ai * HALF + wr * 64 + m * 16 + fr; const float rs = row_rs<4>(aux, rl); const int row = u.pm * BM + rl;
                f32x4 y[2][2]; float ssq = 0.f;
#pragma unroll
                for (int bj = 0; bj < 2; ++bj)
#pragma unroll
                    for (int n = 0; n < 2; ++n) { y[bj][n] = acc[ai][bj][m][n] * rs; const f32x4 t = y[bj][n]; ssq += (t[0] * t[0] + t[1] * t[1]) + (t[2] * t[2] + t[3] * t[3]); }
                if (kind != 1) {
                    ssq += __shfl_xor(ssq, 16); ssq += __shfl_xor(ssq, 32);
                    const float rinv = rsqrtf(ssq * (1.0f / 64.0f) + EPS) * (kind == 2 ? LOG2E * 0.125f : 1.0f);
                    const LAS float* g = gk + (kind == 2 ? 64 : 0);
                    bf16_t* dst = (kind == 2 ? Qb : Kb) + (size_t)row * 1024 + hd * 64;
#pragma unroll
                    for (int bj = 0; bj < 2; ++bj) { const int pos0 = 32 * bj + 8 * fq; const f32x4 g0 = *(const LAS f32x4*)(g + pos0), g1 = *(const LAS f32x4*)(g + pos0 + 4);
                        *(u32x4*)(dst + pos0) = pack8(y[bj][0] * rinv * g0, y[bj][1] * rinv * g1); }
                } else {
                    const int b = row >> 12, t = row & 4095; bf16_t* dst = Vt + ((size_t)(b * 16 + hd) * 64) * 4096 + t;
#pragma unroll
                    for (int bj = 0; bj < 2; ++bj)
#pragma unroll
                        for (int n = 0; n < 2; ++n)
#pragma unroll
                            for (int j = 0; j < 4; ++j) dst[(size_t)(32 * bj + 8 * fq + 4 * n + j) * 4096] = (bf16_t)(cvt_pk_bf16(y[bj][n][j], 0.f) & 0xffffu);
                }
                asm volatile("" ::: "memory"); }
    }
    __device__ __forceinline__ void finish(const Unit&, int) const {}
};

struct EpiMoeDn {
    static constexpr bool PERM = true; static constexpr int NAUX = 1;
    bf16_t* Y; const int* slot;
    __device__ __forceinline__ const void* aux_src(const Unit& u) const { return slot + (size_t)u.pm * 1024 + 768; }
    __device__ __forceinline__ void operator()(const f32x4 (&acc)[2][2][4][2], const Unit& u, int wr, int wc, int fr, int fq, const LAS unsigned char* aux, int, const Unit&) const {
        asm volatile("" : "+v"(fr), "+v"(fq));
#pragma unroll
        for (int ai = 0; ai < 2; ++ai)
#pragma unroll
            for (int m = 0; m < 4; ++m) { const int rl = ai * HALF + wr * 64 + m * 16 + fr; const int yr = ((const LAS int*)aux)[rl];
                if (yr >= 0) { bf16_t* rowp = Y + (size_t)yr * DM + u.pn * BM + wc * 32 + 8 * fq;
#pragma unroll
                    for (int bj = 0; bj < 2; ++bj) *(u32x4*)(rowp + bj * HALF) = pack8(acc[ai][bj][m][0], acc[ai][bj][m][1]); }
                asm volatile("" ::: "memory"); }
    }
    __device__ __forceinline__ void finish(const Unit&, int) const {}
};
}
constexpr size_t MiB = 1u << 20;
constexpr size_t WS_CTL = 0, CTL_ZERO_BYTES = 64 * 1024;
constexpr size_t WS_WIN = 1 * MiB, WS_WOUT = 7 * MiB, WS_WGU = 9 * MiB, WS_WD = 20 * MiB, WS_WKVQ = 26 * MiB, WS_WO = 32 * MiB, WS_WMGU = 34 * MiB, WS_WMD = 146 * MiB;
constexpr size_t WS_TAB = 202 * MiB;
constexpr size_t T_SS0 = WS_TAB, T_SSP = WS_TAB + 128 * 1024, T_GATES = WS_TAB + 1 * MiB, T_SELE = WS_TAB + 3 * MiB, T_SELW1 = T_SELE + 128 * 1024, T_SELW2 = T_SELE + 256 * 1024, T_SELRS = T_SELE + 384 * 1024;
constexpr size_t T_SLOT = WS_TAB + 4 * MiB;
constexpr size_t WS_A = 208 * MiB;
constexpr size_t WS_B = 272 * MiB;
constexpr size_t B_Q = WS_B, B_K = WS_B + 32 * MiB, B_V = WS_B + 64 * MiB, B_OG = WS_B + 128 * MiB, B_HN = WS_B + 192 * MiB;
constexpr size_t B_HF = WS_B;
constexpr size_t B_SBK = WS_B, B_SBVT = WS_B + 64 * MiB, B_SBQ = WS_B + 128 * MiB;
constexpr size_t B_HM = WS_B;
constexpr size_t WS_END = 528 * MiB;
static_assert((size_t)MAXTILES * 4096 <= 2 * MiB && B_HM + (size_t)(MAXTILES - HALF0_TILES) * 256 * EDIM * 2 <= WS_END && B_HN + (size_t)MTOK * DM * 2 <= WS_END, "d_ws map");
constexpr int CW_TMO = 0, CW_BAR = 4096, CW_CNT = 8192, CW_MOE = 12288, CW_TEXP = CW_MOE + 64;
constexpr int RING_OFF = 0, RING_BYTES = 131072;
constexpr int AUX_OFF = RING_BYTES, AUX_BYTES = 8192;
constexpr int RED_OFF = AUX_OFF + AUX_BYTES, RED_BYTES = 8192;
constexpr int TEX_OFF = RED_OFF + RED_BYTES, TEX_BYTES = 2048;
constexpr int MISC_OFF = TEX_OFF + TEX_BYTES;
constexpr int LDS_BYTES = MISC_OFF + 128;
static_assert(LDS_BYTES <= 160 * 1024 && LDS_BYTES > 80 * 1024, "LDS map: one workgroup per CU");

#define XB_TMO      128
#define XB_XCNT(j)  (256  + 64 * (j))
#define XB_XSUB(j)  (1280 + 64 * (j))
#define XB_XGEN(j)  (2304 + 64 * (j))
#define XB_TOP      3328
#define XB_TOPGEN   3392
#define XCD_BAR_WORDS 3456
#define XB_SPIN_CAP (1u << 18)
__device__ __forceinline__ unsigned xb_ld(unsigned* p)              { return __hip_atomic_load(p, __ATOMIC_RELAXED, __HIP_MEMORY_SCOPE_AGENT); }
__device__ __forceinline__ unsigned xb_add(unsigned* p, unsigned v) { return __hip_atomic_fetch_add(p, v, __ATOMIC_RELAXED, __HIP_MEMORY_SCOPE_AGENT); }
__device__ __forceinline__ unsigned xb_xcc_id() { return (unsigned)__builtin_amdgcn_s_getreg((3 << 11) | 20) & 0xFu; }
#define XB_SPIN(cond, bar) do { unsigned _sp = 0; while (cond) { __builtin_amdgcn_s_sleep(1); \
    if ((++_sp & 255u) == 0u) { if (xb_ld(&(bar)[XB_TMO])) break; if (_sp > XB_SPIN_CAP) { atomicAdd(&(bar)[XB_TMO], 1u); break; } } } } while (0)
struct XcdBarrier { unsigned* bar; unsigned x; volatile LAS unsigned* st; };
__device__ __forceinline__ XcdBarrier xcd_barrier_post(unsigned* bar, volatile LAS unsigned* st) {
    XcdBarrier b; b.bar = bar; b.x = xb_xcc_id(); b.st = st;
    if (threadIdx.x == 0) (void)xb_add(&bar[XB_XCNT(b.x)], 1u);
    return b;
}
__device__ __forceinline__ void xcd_barrier_complete(unsigned* bar, unsigned x, unsigned& nloc, unsigned& nx) {
    const unsigned G = gridDim.x * gridDim.y * gridDim.z;
    unsigned sum, cnt, mine, sp = 0u;
    for (;;) {
        sum = 0u; cnt = 0u; mine = 0u;
#pragma unroll
        for (unsigned j = 0; j < 16; ++j) { const unsigned c = xb_ld(&bar[XB_XCNT(j)]); sum += c; cnt += (c > 0u) ? 1u : 0u; mine = (j == x) ? c : mine; }
        if (sum == G) break;
        __builtin_amdgcn_s_sleep(1);
        if ((++sp & 255u) == 0u) { if (xb_ld(&bar[XB_TMO])) break; if (sp > XB_SPIN_CAP) { atomicAdd(&bar[XB_TMO], 1u); break; } }
    }
    nloc = mine > 0u ? mine : 1u; nx = cnt > 0u ? cnt : 1u;
}
__device__ __forceinline__ void xcd_barrier(const XcdBarrier& b) {
    asm volatile("s_waitcnt vmcnt(0)" ::: "memory");
    __syncthreads();
    if (threadIdx.x == 0) {
        unsigned* bar = b.bar;
        __builtin_amdgcn_s_waitcnt(0);
        unsigned nloc = b.st[0], nx = b.st[1];
        if (nloc == 0u) { xcd_barrier_complete(bar, b.x, nloc, nx); b.st[0] = nloc; b.st[1] = nx; }
        const unsigned old = xb_add(&bar[XB_XSUB(b.x)], 1u);
        const unsigned gen = old / nloc;
        if (old + 1u == (gen + 1u) * nloc) {
            __builtin_amdgcn_fence(__ATOMIC_RELEASE, "agent");
            asm volatile("s_waitcnt vmcnt(0)" ::: "memory");
            const unsigned og = xb_add(&bar[XB_TOP], 1u);
            const unsigned tg = og / nx;
            if (og + 1u == (tg + 1u) * nx) xb_add(&bar[XB_TOPGEN], 1u);
            else XB_SPIN(xb_ld(&bar[XB_TOPGEN]) == tg, bar);
            __builtin_amdgcn_fence(__ATOMIC_ACQUIRE, "agent");
            xb_add(&bar[XB_XGEN(b.x)], 1u);
            asm volatile("s_waitcnt vmcnt(0)" ::: "memory");
        } else {
            XB_SPIN(xb_ld(&bar[XB_XGEN(b.x)]) == gen, bar);
            __builtin_amdgcn_fence(__ATOMIC_ACQUIRE, "agent");
            asm volatile("s_waitcnt vmcnt(0)" ::: "memory");
        }
    }
    __syncthreads();
}

struct Args { const float* in[21]; float* out; unsigned char* ws; int ph_lo, ph_hi; };
struct Frame {
    LAS unsigned char* lds;
    volatile LAS unsigned* MISC;
    unsigned* ctl;
    int tid, lane, wave, vcu, G;
    float* out; unsigned char* ws;
};
enum { I_X = 0, I_MIXN, I_FFNN, I_WIN, I_BI, I_BF, I_GH, I_WOUT, I_KVN, I_WKV, I_GK, I_WQ, I_GQ, I_WO, I_FG, I_FU, I_FD, I_WR, I_MG, I_MU, I_MD };
__device__ __forceinline__ unsigned f2bf(float f) { unsigned u = __builtin_bit_cast(unsigned, f); return (u + 0x7fffu + ((u >> 16) & 1u)) >> 16; }
__device__ __forceinline__ unsigned pk2(float lo, float hi) { return f2bf(lo) | (f2bf(hi) << 16); }
__device__ __forceinline__ float bf2f(unsigned short b) { return __builtin_bit_cast(float, (unsigned)b << 16); }
__device__ __forceinline__ float wave_sum(float v) {
#pragma unroll
    for (int o = 1; o < 64; o <<= 1) v += __shfl_xor(v, o);
    return v;
}

struct Job { const float* src; int ldw, col0, ncols, K; const float* gain; float scale; bf16* dst; int type, roff; };
__device__ __forceinline__ int rowmap(int type, int roff, int n) {
    if (type == 0) return roff + n;
    if (type == 1) return 256 * (n >> 7) + (n & 127) + roff;
    return roff + 256 * (n >> 8) + 128 * ((n & 63) >> 5) + 32 * ((n & 255) >> 6) + (n & 31);
}
constexpr int SMALL_ITEMS = 256 + 256 + 1024 + 512 + 1408 * 3 + 512 * 4, MOE_ITEMS = 1792, P0_ITEMS = SMALL_ITEMS + 24 * MOE_ITEMS;
__device__ __forceinline__ void get_job(const Args& A, Frame& F, int it, Job& jb, int& local) {
    unsigned char* ws = F.ws;
    if (it >= SMALL_ITEMS) { const int r = it - SMALL_ITEMS, j = r / MOE_ITEMS; local = r % MOE_ITEMS; const int kind = j >> 3, e = j & 7;
        if (kind == 0)      jb = Job{A.in[I_MG] + (size_t)e * DM * EDIM, EDIM, 0, EDIM, DM, A.in[I_FFNN] + DM, 1.f, (bf16*)(ws + WS_WMGU) + (size_t)e * 2 * EDIM * DM, 1, 0};
        else if (kind == 1) jb = Job{A.in[I_MU] + (size_t)e * DM * EDIM, EDIM, 0, EDIM, DM, A.in[I_FFNN] + DM, 1.f, (bf16*)(ws + WS_WMGU) + (size_t)e * 2 * EDIM * DM, 1, 128};
        else                jb = Job{A.in[I_MD] + (size_t)e * EDIM * DM, DM, 0, DM, EDIM, nullptr, 1.f, (bf16*)(ws + WS_WMD) + (size_t)e * DM * EDIM, 0, 0};
        return; }
    int r = it;
    if (r < 256)  { local = r; jb = Job{A.in[I_WIN], MPROJ, 0, 512, DM, A.in[I_MIXN], 1.f, (bf16*)(ws + WS_WIN), 0, 0}; return; } r -= 256;
    if (r < 256)  { local = r; jb = Job{A.in[I_WIN], MPROJ, 512, 512, DM, A.in[I_MIXN], 0.125f, (bf16*)(ws + WS_WIN), 0, 512}; return; } r -= 256;
    if (r < 1024) { local = r; jb = Job{A.in[I_WIN], MPROJ, 1024, 2048, DM, A.in[I_MIXN], 1.f, (bf16*)(ws + WS_WIN), 0, 1024}; return; } r -= 1024;
    if (r < 512)  { local = r; jb = Job{A.in[I_WOUT], DM, 0, DM, DM, nullptr, 1.f, (bf16*)(ws + WS_WOUT), 0, 0}; return; } r -= 512;
    if (r < 1408) { local = r; jb = Job{A.in[I_FG], FFN, 0, FFN, DM, A.in[I_FFNN], 1.f, (bf16*)(ws + WS_WGU), 1, 0}; return; } r -= 1408;
    if (r < 1408) { local = r; jb = Job{A.in[I_FU], FFN, 0, FFN, DM, A.in[I_FFNN], 1.f, (bf16*)(ws + WS_WGU), 1, 128}; return; } r -= 1408;
    if (r < 1408) { local = r; jb = Job{A.in[I_FD], DM, 0, DM, FFN, nullptr, 1.f, (bf16*)(ws + WS_WD), 0, 0}; return; } r -= 1408;
    if (r < 512)  { local = r; jb = Job{A.in[I_WKV], 2 * DM, 0, DM, DM, A.in[I_KVN], 1.f, (bf16*)(ws + WS_WKVQ), 2, 0}; return; } r -= 512;
    if (r < 512)  { local = r; jb = Job{A.in[I_WKV], 2 * DM, DM, DM, DM, A.in[I_KVN], 1.f, (bf16*)(ws + WS_WKVQ), 2, 1024}; return; } r -= 512;
    if (r < 512)  { local = r; jb = Job{A.in[I_WQ], DM, 0, DM, DM, A.in[I_MIXN] + DM, 1.f, (bf16*)(ws + WS_WKVQ), 2, 2048}; return; } r -= 512;
    local = r; jb = Job{A.in[I_WO], DM, 0, DM, DM, nullptr, 1.f, (bf16*)(ws + WS_WO), 0, 0};
}
__device__ __forceinline__ void p0_item(const Job& jb, int item, LAS float* scr, int lane) {
    const int nnb = jb.ncols / 32, kb = item / nnb, nb = item % nnb, k0 = 64 * kb, n0 = 32 * nb;
#pragma unroll
    for (int i = 0; i < 8; ++i) { const int kk = 8 * i + (lane >> 3); const float gsc = (jb.gain ? jb.gain[k0 + kk] : 1.f) * jb.scale;
        const f32x4 v = *(const GAS f32x4*)(jb.src + (size_t)(k0 + kk) * jb.ldw + jb.col0 + n0 + 4 * (lane & 7));
        LAS float* d = scr + kk * 33 + 4 * (lane & 7); d[0] = v[0] * gsc; d[1] = v[1] * gsc; d[2] = v[2] * gsc; d[3] = v[3] * gsc; }
    LDS_WAIT(); asm volatile("" ::: "memory");
    const int c = lane & 7;
#pragma unroll
    for (int j = 0; j < 4; ++j) { const int n = (lane >> 3) + 8 * j; const LAS float* s = scr + (8 * c) * 33 + n;
        u32x4 o; o.x = pk2(s[0 * 33], s[1 * 33]); o.y = pk2(s[2 * 33], s[3 * 33]); o.z = pk2(s[4 * 33], s[5 * 33]); o.w = pk2(s[6 * 33], s[7 * 33]);
        *(GAS u32x4*)(jb.dst + (size_t)rowmap(jb.type, jb.roff, n0 + n) * jb.K + k0 + 8 * c) = o; }
    LDS_WAIT(); asm volatile("" ::: "memory");
}
__device__ __forceinline__ float softcap(float z) { return SOFTCAP * tanhf(z * (1.0f / SOFTCAP)); }
__device__ __forceinline__ void p0_prologue(const Args& A, Frame& F) {
    const int gw = F.vcu * NWAVES + F.wave, NGW = F.G * NWAVES;
    {   LAS float* scr = (LAS float*)(F.lds + RING_OFF + F.wave * 16384);
        for (int it = gw; it < P0_ITEMS; it += NGW) { Job jb; int local; get_job(A, F, it, jb, local); p0_item(jb, local, scr, F.lane); } }
    __syncthreads();
    LAS float* Wg = (LAS float*)(F.lds + RING_OFF);
    for (int i = F.tid; i < DM * 16; i += NWAVES * 64) { const int k = i >> 4, j = i & 15; Wg[i] = A.in[I_WIN][(size_t)k * MPROJ + MPROJ_MAIN + j] * A.in[I_MIXN][k]; }
    __syncthreads();
    bf16* xb = (bf16*)(F.ws + WS_A); float* ss0 = (float*)(F.ws + T_SS0); float* gates = (float*)(F.ws + T_GATES);
    for (int row = gw; row < MTOK; row += NGW) {
        const GAS f32x4* xr = (const GAS f32x4*)(A.in[I_X] + (size_t)row * DM) + F.lane;
        f32x4 v[4]; float s[17];
#pragma unroll
        for (int g = 0; g < 17; ++g) s[g] = 0.f;
#pragma unroll
        for (int j = 0; j < 4; ++j) { v[j] = xr[64 * j]; s[16] += (v[j][0] * v[j][0] + v[j][1] * v[j][1]) + (v[j][2] * v[j][2] + v[j][3] * v[j][3]); }
#pragma unroll
        for (int j = 0; j < 4; ++j)
#pragma unroll
            for (int c = 0; c < 4; ++c) { const LAS f32x4* wp = (const LAS f32x4*)(Wg + (size_t)(4 * F.lane + 256 * j + c) * 16); const float xv = v[j][c];
#pragma unroll
                for (int q = 0; q < 4; ++q) { const f32x4 w = wp[q]; s[4 * q] += xv * w[0]; s[4 * q + 1] += xv * w[1]; s[4 * q + 2] += xv * w[2]; s[4 * q + 3] += xv * w[3]; }
                if (c & 1) asm volatile("" ::: "memory"); }
#pragma unroll
        for (int g = 0; g < 17; ++g) s[g] = wave_sum(s[g]);
        const float rs = rsqrtf(s[16] * (1.0f / DM) + EPS);
        float mine = 0.f;
#pragma unroll
        for (int g = 0; g < 16; ++g) mine = (F.lane == g) ? s[g] : mine;
        if (F.lane < 16) { const int h = F.lane & 7; float z = mine * rs + (F.lane < 8 ? A.in[I_BI][h] : A.in[I_BF][h]); z = softcap(z);
            if (F.lane >= 8) z = -log1pf(expf(-z));
            gates[(size_t)row * 16 + F.lane] = z; }
        if (F.lane == 0) ss0[row] = s[16];
        GAS unsigned long long* o8 = (GAS unsigned long long*)(xb + (size_t)row * DM) + F.lane;
#pragma unroll
        for (int j = 0; j < 4; ++j) o8[64 * j] = (unsigned long long)pk2(v[j][0], v[j][1]) | ((unsigned long long)pk2(v[j][2], v[j][3]) << 32);
    }
}
__device__ __forceinline__ void mlstm_simple(const Args& A, Frame& F) {
    LAS float* Lq = (LAS float*)(F.lds + RING_OFF);
    LAS float* Lk = Lq + 4096;
    LAS float* Lv = Lk + 4096;
    LAS float* Lh = Lv + 8192;
    LAS float* Lg = Lh + 8192;
    const bf16* Q = (const bf16*)(F.ws + B_Q); const bf16* Kk = (const bf16*)(F.ws + B_K); const bf16* V = (const bf16*)(F.ws + B_V); const bf16* OG = (const bf16*)(F.ws + B_OG);
    bf16* HN = (bf16*)(F.ws + B_HN); const float* gates = (const float*)(F.ws + T_GATES); const float* gh = A.in[I_GH];
    const int tid = F.tid, v = tid >> 2, qd = tid & 3;
    for (int u = blockIdx.x; u < NBATCH * MH; u += F.G) {
        const int b = u >> 3, h = u & 7;
        float C[16], n[16];
#pragma unroll
        for (int j = 0; j < 16; ++j) { C[j] = 0.f; n[j] = 0.f; }
        for (int c = 0; c < SEQ / 64; ++c) {
            const size_t row0 = (size_t)b * SEQ + c * 64;
            { const int r = tid >> 3, cc = (tid & 7) * 8;
              const u32x4 a = *(const GAS u32x4*)(Q + (row0 + r) * 512 + h * 64 + cc), bb = *(const GAS u32x4*)(Kk + (row0 + r) * 512 + h * 64 + cc);
#pragma unroll
              for (int i = 0; i < 4; ++i) { Lq[r * 64 + cc + 2 * i] = bf2f((unsigned short)(a[i] & 0xffff)); Lq[r * 64 + cc + 2 * i + 1] = bf2f((unsigned short)(a[i] >> 16));
                                            Lk[r * 64 + cc + 2 * i] = bf2f((unsigned short)(bb[i] & 0xffff)); Lk[r * 64 + cc + 2 * i + 1] = bf2f((unsigned short)(bb[i] >> 16)); } }
#pragma unroll
            for (int j = 0; j < 2; ++j) { const int idx = tid + 512 * j, r = idx >> 4, cc = (idx & 15) * 8; const u32x4 a = *(const GAS u32x4*)(V + (row0 + r) * 1024 + h * 128 + cc);
#pragma unroll
              for (int i = 0; i < 4; ++i) { Lv[r * 128 + cc + 2 * i] = bf2f((unsigned short)(a[i] & 0xffff)); Lv[r * 128 + cc + 2 * i + 1] = bf2f((unsigned short)(a[i] >> 16)); } }
            if (tid < 64) { Lg[tid * 2] = expf(gates[(row0 + tid) * 16 + h]); Lg[tid * 2 + 1] = expf(gates[(row0 + tid) * 16 + 8 + h]); }
            __syncthreads();
            for (int t = 0; t < 64; ++t) {
                const float ii = Lg[2 * t], ff = Lg[2 * t + 1], vv = Lv[t * 128 + v] * ii;
                float num = 0.f, den = 0.f;
#pragma unroll
                for (int j4 = 0; j4 < 4; ++j4) { const f32x4 k4 = *(const LAS f32x4*)(Lk + t * 64 + 16 * qd + 4 * j4), q4 = *(const LAS f32x4*)(Lq + t * 64 + 16 * qd + 4 * j4);
#pragma unroll
                    for (int j = 0; j < 4; ++j) { const int jj = 4 * j4 + j; C[jj] = ff * C[jj] + vv * k4[j]; n[jj] = ff * n[jj] + ii * k4[j]; num += C[jj] * q4[j]; den += n[jj] * q4[j]; } }
                num += __shfl_xor(num, 1); num += __shfl_xor(num, 2); den += __shfl_xor(den, 1); den += __shfl_xor(den, 2);
                if (qd == 0) Lh[t * 128 + v] = num / fmaxf(fabsf(den), 1.0f);
            }
            __syncthreads();
#pragma unroll 1
            for (int tt = 0; tt < 8; ++tt) { const int t = F.wave * 8 + tt; const float a0 = Lh[t * 128 + F.lane], a1 = Lh[t * 128 + 64 + F.lane];
                const float rinv = rsqrtf(wave_sum(a0 * a0 + a1 * a1) * (1.0f / 128.0f) + EPS);
                const size_t o = (row0 + t) * 1024 + h * 128 + F.lane;
                HN[o] = (bf16)f2bf(a0 * rinv * gh[h * 128 + F.lane] * bf2f(OG[o])); HN[o + 64] = (bf16)f2bf(a1 * rinv * gh[h * 128 + 64 + F.lane] * bf2f(OG[o + 64])); }
            __syncthreads();
        }
    }
}

__device__ __forceinline__ void sb_simple(Frame& F) {
    const bf16* Kb = (const bf16*)(F.ws + B_SBK); const bf16* Vt = (const bf16*)(F.ws + B_SBVT); bf16* QO = (bf16*)(F.ws + B_SBQ);
    const int gw = F.vcu * NWAVES + F.wave, NGW = F.G * NWAVES;
    for (int item = gw; item < NBATCH * SBH * (SEQ / 64); item += NGW) {
        const int bh = item >> 6, tb = item & 63, b = bh >> 4, h = bh & 15, t = tb * 64 + F.lane; const size_t row = (size_t)b * SEQ + t;
        float q[64], o[64];
#pragma unroll
        for (int c = 0; c < 8; ++c) { const u32x4 a = *(const GAS u32x4*)(QO + row * 1024 + h * 64 + 8 * c);
#pragma unroll
            for (int i = 0; i < 4; ++i) { q[8 * c + 2 * i] = bf2f((unsigned short)(a[i] & 0xffff)); q[8 * c + 2 * i + 1] = bf2f((unsigned short)(a[i] >> 16)); } }
#pragma unroll
        for (int d = 0; d < 64; ++d) o[d] = 0.f;
        float carry = 0.f;
        for (int s8 = tb * 64 + 56; s8 >= 0; s8 -= 8) {
            float aa[8];
#pragma unroll
            for (int kk = 7; kk >= 0; --kk) { const int s = s8 + kk; const GAS u32x4* kr = (const GAS u32x4*)(Kb + ((size_t)b * SEQ + s) * 1024 + h * 64);
                float z = 0.f;
#pragma unroll
                for (int c = 0; c < 8; ++c) { const u32x4 a = kr[c];
#pragma unroll
                    for (int i = 0; i < 4; ++i) { z += q[8 * c + 2 * i] * bf2f((unsigned short)(a[i] & 0xffff)); z += q[8 * c + 2 * i + 1] * bf2f((unsigned short)(a[i] >> 16)); } }
                const bool valid = s < t; const float l1p = log2f(1.0f + exp2f(z));
                aa[kk] = valid ? exp2f(z - l1p + carry) : 0.f; carry += valid ? -l1p : 0.f; }
#pragma unroll
            for (int d = 0; d < 64; ++d) { const u32x4 a = *(const GAS u32x4*)(Vt + ((size_t)bh * 64 + d) * SEQ + s8); float acc = o[d];
#pragma unroll
                for (int i = 0; i < 4; ++i) { acc += aa[2 * i] * bf2f((unsigned short)(a[i] & 0xffff)); acc += aa[2 * i + 1] * bf2f((unsigned short)(a[i] >> 16)); }
                o[d] = acc; }
        }
#pragma unroll
        for (int c = 0; c < 8; ++c) { u32x4 w; w.x = pk2(o[8 * c], o[8 * c + 1]); w.y = pk2(o[8 * c + 2], o[8 * c + 3]); w.z = pk2(o[8 * c + 4], o[8 * c + 5]); w.w = pk2(o[8 * c + 6], o[8 * c + 7]);
            *(GAS u32x4*)(QO + row * 1024 + h * 64 + 8 * c) = w; }
    }
}

__device__ __forceinline__ void router_phase(const Args& A, Frame& F) {
    LAS float* Wr = (LAS float*)(F.lds + RING_OFF);
    LAS int* hist = (LAS int*)(F.lds + RING_OFF + 32768);
    for (int i = F.tid; i < DM * NEXP; i += NWAVES * 64) Wr[i] = A.in[I_WR][i] * A.in[I_FFNN][DM + (i >> 3)];
    if (F.tid < NEXP) hist[F.tid] = 0;
    __syncthreads();
    int* sele = (int*)(F.ws + T_SELE); float* selw1 = (float*)(F.ws + T_SELW1); float* selw2 = (float*)(F.ws + T_SELW2); float* selrs = (float*)(F.ws + T_SELRS);
    const int TPW = MTOK / F.G;
    for (int i = F.wave; i < TPW; i += NWAVES) {
        const int tok = blockIdx.x * TPW + i;
        const GAS f32x4* xr = (const GAS f32x4*)(F.out + (size_t)tok * DM) + F.lane;
        float s[9];
#pragma unroll
        for (int g = 0; g < 9; ++g) s[g] = 0.f;
#pragma unroll
        for (int j = 0; j < 4; ++j) { const f32x4 v = xr[64 * j]; s[8] += (v[0] * v[0] + v[1] * v[1]) + (v[2] * v[2] + v[3] * v[3]);
#pragma unroll
            for (int c = 0; c < 4; ++c) { const LAS f32x4* wp = (const LAS f32x4*)(Wr + (size_t)(4 * F.lane + 256 * j + c) * 8); const f32x4 w0 = wp[0], w1 = wp[1]; const float xv = v[c];
                s[0] += xv * w0[0]; s[1] += xv * w0[1]; s[2] += xv * w0[2]; s[3] += xv * w0[3]; s[4] += xv * w1[0]; s[5] += xv * w1[1]; s[6] += xv * w1[2]; s[7] += xv * w1[3]; } }
#pragma unroll
        for (int g = 0; g < 9; ++g) s[g] = wave_sum(s[g]);
        const float rs = rsqrtf(s[8] * (1.0f / DM) + EPS);
        float b1 = s[0]; int i1 = 0;
#pragma unroll
        for (int e = 1; e < 8; ++e) if (s[e] > b1) { b1 = s[e]; i1 = e; }
        float b2 = -3.0e38f; int i2 = 0;
#pragma unroll
        for (int e = 0; e < 8; ++e) if (e != i1 && s[e] > b2) { b2 = s[e]; i2 = e; }
        const float w1 = 1.0f / (1.0f + expf((b2 - b1) * rs)), w2 = 1.0f - w1;
        if (F.lane == 0) { sele[tok] = i1 | (i2 << 8); selw1[tok] = w1; selw2[tok] = w2; selrs[tok] = rs; __hip_atomic_fetch_add(hist + i1, 1, __ATOMIC_RELAXED, __HIP_MEMORY_SCOPE_WORKGROUP); __hip_atomic_fetch_add(hist + i2, 1, __ATOMIC_RELAXED, __HIP_MEMORY_SCOPE_WORKGROUP); }
    }
    __syncthreads();
    if (F.tid < NEXP) ((int*)(F.ctl + CW_CNT))[blockIdx.x * NEXP + F.tid] = hist[F.tid];
}
__device__ __forceinline__ void slots_phase(Frame& F) {
    LAS int* cn = (LAS int*)(F.lds + RING_OFF);
    LAS int* tot = cn + 2048; LAS int* pre = tot + 8; LAS int* sst = pre + 8; LAS int* tst = sst + 8; LAS int* ntl = tst + 8; LAS int* le = ntl + 16;
    const int TPW = MTOK / F.G; const int w = blockIdx.x;
    for (int i = F.tid; i < F.G * NEXP; i += NWAVES * 64) cn[i] = ((const int*)(F.ctl + CW_CNT))[i];
    __syncthreads();
    if (F.tid < NEXP) { int t = 0, p = 0; for (int ww = 0; ww < F.G; ++ww) { const int c = cn[ww * NEXP + F.tid]; t += c; if (ww < w) p += c; } tot[F.tid] = t; pre[F.tid] = p; }
    __syncthreads();
    if (F.tid == 0) { int ts = 0; for (int e = 0; e < NEXP; ++e) { const int nt = (tot[e] + 255) >> 8; tst[e] = ts; sst[e] = ts * 256; ntl[e] = nt; ts += nt; } ntl[8] = ts; }
    const int* sele = (const int*)(F.ws + T_SELE); const float* selw1 = (const float*)(F.ws + T_SELW1); const float* selw2 = (const float*)(F.ws + T_SELW2); const float* selrs = (const float*)(F.ws + T_SELRS);
    int* slt = (int*)(F.ws + T_SLOT);
#define SL_TOK(s) slt[((s) >> 8) * 1024 + ((s) & 255)]
#define SL_RS(s) ((float*)slt)[((s) >> 8) * 1024 + 256 + ((s) & 255)]
#define SL_W(s) ((float*)slt)[((s) >> 8) * 1024 + 512 + ((s) & 255)]
#define SL_YROW(s) slt[((s) >> 8) * 1024 + 768 + ((s) & 255)]
    if (F.tid < TPW) le[F.tid] = sele[w * TPW + F.tid];
    __syncthreads();
    if (F.tid < 2 * TPW) { const int tl = F.tid >> 1, j = F.tid & 1, mine = le[tl], e = j ? (mine >> 8) : (mine & 255); int rank = 0;
        for (int t2 = 0; t2 < tl; ++t2) { const int o = le[t2]; rank += ((o & 255) == e || (o >> 8) == e) ? 1 : 0; }
        const int slot = sst[e] + pre[e] + rank, token = w * TPW + tl;
        SL_TOK(slot) = token; SL_YROW(slot) = 2 * token + j; SL_RS(slot) = selrs[token]; SL_W(slot) = j ? selw2[token] : selw1[token]; }
    if (w < NEXP) { const int e = w, lo = sst[e] + tot[e], hi = sst[e] + 256 * ntl[e]; for (int s = lo + F.tid; s < hi; s += NWAVES * 64) { SL_TOK(s) = 0; SL_YROW(s) = -1; SL_RS(s) = 0.f; SL_W(s) = 0.f; } }
    if (w == 0) { if (F.tid == 0) ((int*)(F.ctl + CW_MOE))[0] = ntl[8];
        for (int e = 0; e < NEXP; ++e) for (int t = F.tid; t < ntl[e]; t += NWAVES * 64) ((int*)(F.ctl + CW_TEXP))[tst[e] + t] = e; }
}
__device__ __forceinline__ void combine_phase(Frame& F) {
    const bf16* x3b = (const bf16*)(F.ws + WS_A);
    const int gw = F.vcu * NWAVES + F.wave, NGW = F.G * NWAVES;
    for (int tokn = gw; tokn < MTOK; tokn += NGW) {
        const GAS u32x4* yp = (const GAS u32x4*)((const unsigned char*)F.out + (size_t)tokn * 4096); const GAS u32x4* xp = (const GAS u32x4*)(x3b + (size_t)tokn * DM);
        u32x4 y0[2], y1[2], xx[2];
#pragma unroll
        for (int p = 0; p < 2; ++p) { y0[p] = yp[64 * p + F.lane]; y1[p] = yp[128 + 64 * p + F.lane]; xx[p] = xp[64 * p + F.lane]; }
        asm volatile("s_waitcnt vmcnt(0)" ::: "memory");
        GAS f32x4* op = (GAS f32x4*)((unsigned char*)F.out + (size_t)tokn * 4096);
#pragma unroll
        for (int p = 0; p < 2; ++p) { f32x4 r0, r1;
#pragma unroll
            for (int i = 0; i < 2; ++i) { r0[2 * i] = bf2f((unsigned short)(xx[p][i] & 0xffff)) + bf2f((unsigned short)(y0[p][i] & 0xffff)) + bf2f((unsigned short)(y1[p][i] & 0xffff));
                r0[2 * i + 1] = bf2f((unsigned short)(xx[p][i] >> 16)) + bf2f((unsigned short)(y0[p][i] >> 16)) + bf2f((unsigned short)(y1[p][i] >> 16));
                r1[2 * i] = bf2f((unsigned short)(xx[p][i + 2] & 0xffff)) + bf2f((unsigned short)(y0[p][i + 2] & 0xffff)) + bf2f((unsigned short)(y1[p][i + 2] & 0xffff));
                r1[2 * i + 1] = bf2f((unsigned short)(xx[p][i + 2] >> 16)) + bf2f((unsigned short)(y0[p][i + 2] >> 16)) + bf2f((unsigned short)(y1[p][i + 2] >> 16)); }
            op[128 * p + 2 * F.lane] = r0; op[128 * p + 2 * F.lane + 1] = r1; }
    }
}
constexpr int N_PHASES = 16;
__device__ __forceinline__ void mkframe(const Args& args, Frame& F, LAS unsigned char* lds) {
    F.lds = lds; F.MISC = (volatile LAS unsigned*)(lds + MISC_OFF);
    F.tid = threadIdx.x; F.lane = F.tid & 63; F.wave = __builtin_amdgcn_readfirstlane(F.tid >> 6);
    F.G = gridDim.x; { const int bx = blockIdx.x; F.vcu = (F.G % 8 == 0) ? (bx % 8) * (F.G / 8) + bx / 8 : bx; }
    unsigned char* ws = args.ws; float* out = args.out; asm volatile("" : "+s"(ws), "+s"(out));
    F.ws = ws; F.out = out; F.ctl = (unsigned*)(ws + WS_CTL);
}
__device__ __forceinline__ void grid_barrier(const Args& args, LAS unsigned char* lds) {
    unsigned char* ws = args.ws; asm volatile("" : "+s"(ws));
    XcdBarrier bar; bar.bar = (unsigned*)(ws + WS_CTL) + CW_BAR; bar.x = xb_xcc_id(); bar.st = (volatile LAS unsigned*)(lds + MISC_OFF) + 8;
    xcd_barrier(bar);
}
#ifndef PHASE_MASK
#define PHASE_MASK 0xffff
#endif
template <int LO, int HI>
__global__ void __launch_bounds__(NWAVES * 64, 2) fwd_kernel(Args args) {
    extern __shared__ __attribute__((aligned(16))) unsigned char lds_raw[];
    LAS unsigned char* lds = (LAS unsigned char*)lds_raw;
    for (int u = threadIdx.x; u < (LDS_BYTES - AUX_OFF) / 4; u += NWAVES * 64) ((LAS unsigned*)(lds + AUX_OFF))[u] = 0u;
    __syncthreads();
    if constexpr (HI - LO > 1) { unsigned char* ws = args.ws; (void)xcd_barrier_post((unsigned*)(ws + WS_CTL) + CW_BAR, (volatile LAS unsigned*)(lds + MISC_OFF) + 8); }
#define IN(k) (((PHASE_MASK >> (k)) & 1) && LO <= (k) && (k) < HI)
#define SEAM(k) do { if constexpr (IN(k) && IN((k) + 1)) grid_barrier(args, lds); } while (0)
#define RING (F.lds + RING_OFF)
#define AUXB (F.lds + AUX_OFF)
#define RED ((LAS float*)(F.lds + RED_OFF))
#define SSP ((float*)(F.ws + T_SSP))
#define XBUF ((bf16*)(F.ws + WS_A))
    if constexpr (IN(0)) { Frame F; mkframe(args, F, lds); p0_prologue(args, F); } SEAM(0);
    if constexpr (IN(1)) {
        Frame F; mkframe(args, F, lds);
        pg8::Gemm g{XBUF, (const bf16*)(F.ws + WS_WIN), DM}; pg8::StaticOrder S; S.init(MTOK, MPROJ_MAIN, F.G, (int)blockIdx.x);
        pg8::EpiProj E{(bf16*)(F.ws + B_Q), (bf16*)(F.ws + B_K), (bf16*)(F.ws + B_V), (bf16*)(F.ws + B_OG), (const float*)(F.ws + T_SS0)};
        pg8::gemm_phase<pg8::EpiProj, pg8::StaticOrder, false>(RING, AUXB, g, S, E);
    } SEAM(1);
    if constexpr (IN(2)) { Frame F; mkframe(args, F, lds); mlstm_simple(args, F); } SEAM(2);
    if constexpr (IN(3)) {
        Frame F; mkframe(args, F, lds);
        pg8::Gemm g{(const bf16*)(F.ws + B_HN), (const bf16*)(F.ws + WS_WOUT), DM}; pg8::StaticOrder S; S.init(MTOK, DM, F.G, (int)blockIdx.x);
        pg8::EpiRes E{args.in[I_X], F.out, XBUF, SSP, RED};
        pg8::gemm_phase<pg8::EpiRes, pg8::StaticOrder, false>(RING, AUXB, g, S, E);
    } SEAM(3);
    if constexpr (IN(4)) {
        Frame F; mkframe(args, F, lds);
        pg8::Gemm g{XBUF, (const bf16*)(F.ws + WS_WGU), DM}; pg8::StaticOrder S; S.init(MTOK, 2 * FFN, F.G, (int)blockIdx.x);
        pg8::EpiGu<false> E{(bf16*)(F.ws + B_HF), FFN, SSP};
        pg8::gemm_phase<pg8::EpiGu<false>, pg8::StaticOrder, false>(RING, AUXB, g, S, E);
    } SEAM(4);
    if constexpr (IN(5)) {
        Frame F; mkframe(args, F, lds);
        pg8::Gemm g{(const bf16*)(F.ws + B_HF), (const bf16*)(F.ws + WS_WD), FFN}; pg8::StaticOrder S; S.init(MTOK, DM, F.G, (int)blockIdx.x);
        pg8::EpiRes E{F.out, F.out, XBUF, SSP, RED};
        pg8::gemm_phase<pg8::EpiRes, pg8::StaticOrder, false>(RING, AUXB, g, S, E);
    } SEAM(5);
    if constexpr (IN(6)) {
        Frame F; mkframe(args, F, lds);
        LAS float* gkq = (LAS float*)(F.lds + TEX_OFF);
        if (F.tid < 64) gkq[F.tid] = args.in[I_GK][F.tid]; else if (F.tid < 128) gkq[F.tid] = args.in[I_GQ][F.tid - 64];
        __syncthreads();
        pg8::Gemm g{XBUF, (const bf16*)(F.ws + WS_WKVQ), DM}; pg8::StaticOrder S; S.init(MTOK, 3 * DM, F.G, (int)blockIdx.x);
        pg8::EpiKvq E{(bf16*)(F.ws + B_SBK), (bf16*)(F.ws + B_SBVT), (bf16*)(F.ws + B_SBQ), SSP, gkq};
        pg8::gemm_phase<pg8::EpiKvq, pg8::StaticOrder, false>(RING, AUXB, g, S, E);
    } SEAM(6);
    if constexpr (IN(7)) { Frame F; mkframe(args, F, lds); sb_simple(F); } SEAM(7);
    if constexpr (IN(8)) {
        Frame F; mkframe(args, F, lds);
        pg8::Gemm g{(const bf16*)(F.ws + B_SBQ), (const bf16*)(F.ws + WS_WO), DM}; pg8::StaticOrder S; S.init(MTOK, DM, F.G, (int)blockIdx.x);
        pg8::EpiRes E{F.out, F.out, XBUF, nullptr, RED};
        pg8::gemm_phase<pg8::EpiRes, pg8::StaticOrder, false>(RING, AUXB, g, S, E);
    } SEAM(8);
    if constexpr (IN(9)) { Frame F; mkframe(args, F, lds); router_phase(args, F); } SEAM(9);
    if constexpr (IN(10)) { Frame F; mkframe(args, F, lds); slots_phase(F); } SEAM(10);
#define MOE_SETUP(half) \
        Frame F; mkframe(args, F, lds); LAS int* tex = (LAS int*)(F.lds + TEX_OFF); \
        __syncthreads(); \
        const int ntl = __builtin_amdgcn_readfirstlane(((const int*)(F.ctl + CW_MOE))[0]); \
        for (int i = F.tid; i < MAXTILES; i += NWAVES * 64) tex[i] = i < ntl ? ((const int*)(F.ctl + CW_TEXP))[i] : 0; \
        __syncthreads(); \
        const int tlo = (half) ? HALF0_TILES : 0, nth = (half) ? (ntl > HALF0_TILES ? ntl - HALF0_TILES : 0) : (ntl < HALF0_TILES ? ntl : HALF0_TILES);
#define MOE_GU(half) { MOE_SETUP(half) \
        pg8::Gemm g{XBUF, (const bf16*)(F.ws + WS_WMGU), DM}; pg8::MoeOrder S{tlo, nth, 2 * EDIM / 256, F.G, (int)blockIdx.x, tex}; \
        pg8::EpiGu<true> E{(bf16*)(F.ws + B_HM), EDIM, (const float*)(F.ws + T_SLOT)}; \
        pg8::gemm_phase<pg8::EpiGu<true>, pg8::MoeOrder, true>(RING, AUXB, g, S, E); }
#define MOE_DN(half) { MOE_SETUP(half) \
        pg8::Gemm g{(const bf16*)(F.ws + B_HM), (const bf16*)(F.ws + WS_WMD), EDIM}; pg8::MoeOrder S{tlo, nth, DM / 256, F.G, (int)blockIdx.x, tex}; \
        pg8::EpiMoeDn E{(bf16*)F.out, (const int*)(F.ws + T_SLOT)}; \
        pg8::gemm_phase<pg8::EpiMoeDn, pg8::MoeOrder, false>(RING, AUXB, g, S, E); }
    if constexpr (IN(11)) MOE_GU(0) SEAM(11);
    if constexpr (IN(12)) MOE_DN(0) SEAM(12);
    if constexpr (IN(13)) MOE_GU(1) SEAM(13);
    if constexpr (IN(14)) MOE_DN(1) SEAM(14);
    if constexpr (IN(15)) { Frame F; mkframe(args, F, lds); combine_phase(F); }
#undef IN
#undef SEAM
}

#ifndef LAST_PHASE
#define LAST_PHASE 15
#endif
#ifndef ONE_LAUNCH
#define ONE_LAUNCH 0
#endif
typedef void (*kern_t)(Args);
template <int P> struct PhaseTab { static void fill(kern_t* t) { t[P] = fwd_kernel<P, P + 1>; PhaseTab<P - 1>::fill(t); } };
template <> struct PhaseTab<-1> { static void fill(kern_t*) {} };
extern "C" void kernel_launch(void* const* d_in, const int* in_sizes, int n_in, void* d_out, int out_size, void* d_ws, size_t ws_size, hipStream_t stream) {
    static int grid = 0; static kern_t tab[N_PHASES + 1];
    if (grid == 0) {
        if (n_in != 21 || in_sizes[0] != MTOK * DM || out_size != MTOK * DM || ws_size < WS_END) { fprintf(stderr, "kernel_launch: unexpected shapes / workspace (%d inputs, ws %zu); nothing launched\n", n_in, ws_size); grid = -1; return; }
        int dev = 0, cus = 0;
        if (hipGetDevice(&dev) != hipSuccess || hipDeviceGetAttribute(&cus, hipDeviceAttributeMultiprocessorCount, dev) != hipSuccess) { grid = -1; return; }
#if ONE_LAUNCH
        tab[N_PHASES] = fwd_kernel<0, LAST_PHASE + 1>;
        if (hipFuncSetAttribute((const void*)tab[N_PHASES], hipFuncAttributeMaxDynamicSharedMemorySize, LDS_BYTES) != hipSuccess) { fprintf(stderr, "kernel_launch: hipFuncSetAttribute failed\n"); grid = -1; return; }
        int per_cu = 0;
        if (hipOccupancyMaxActiveBlocksPerMultiprocessor(&per_cu, (const void*)tab[N_PHASES], NWAVES * 64, LDS_BYTES) != hipSuccess || per_cu < 1) fprintf(stderr, "kernel_launch: note: occupancy query reports %d workgroups per CU\n", per_cu);
#else
        PhaseTab<N_PHASES - 1>::fill(tab);
        for (int p = 0; p < N_PHASES; ++p) if (hipFuncSetAttribute((const void*)tab[p], hipFuncAttributeMaxDynamicSharedMemorySize, LDS_BYTES) != hipSuccess) { fprintf(stderr, "kernel_launch: hipFuncSetAttribute failed\n"); grid = -1; return; }
#endif
        (void)hipGetLastError();
        grid = cus;
        if (grid != 256) fprintf(stderr, "kernel_launch: built for 256 CUs, found %d\n", grid);
    }
    if (grid < 0) return;
    if (hipMemsetAsync((char*)d_ws + WS_CTL, 0, CTL_ZERO_BYTES, stream) != hipSuccess) return;
    Args a{};
    for (int i = 0; i < 21; ++i) a.in[i] = (const float*)d_in[i];
    a.out = (float*)d_out; a.ws = (unsigned char*)d_ws; a.ph_lo = 0; a.ph_hi = LAST_PHASE + 1;
#if ONE_LAUNCH
    hipLaunchKernelGGL(tab[N_PHASES], dim3(grid), dim3(NWAVES * 64), LDS_BYTES, stream, a);
#else
    for (int p = 0; p <= LAST_PHASE; ++p) hipLaunchKernelGGL(tab[p], dim3(grid), dim3(NWAVES * 64), LDS_BYTES, stream, a);
#endif
}
```

```cpp
#include <hip/hip_runtime.h>
#include <cstdio>
#include <cstdint>
#define GAS __attribute__((address_space(1)))
#define LAS __attribute__((address_space(3)))
typedef unsigned short bf16;
typedef unsigned short bf16_t;
typedef short bf16x8 __attribute__((ext_vector_type(8)));
typedef float f32x4 __attribute__((ext_vector_type(4)));
typedef float f32x2 __attribute__((ext_vector_type(2)));
typedef float f32x16 __attribute__((ext_vector_type(16)));
typedef unsigned u32x4 __attribute__((ext_vector_type(4)));
typedef unsigned u32x2 __attribute__((ext_vector_type(2)));
typedef GAS unsigned gu32;
#define RLX_AGENT __ATOMIC_RELAXED, __HIP_MEMORY_SCOPE_AGENT
#define LDS_WAIT() asm volatile("s_waitcnt lgkmcnt(0)" ::: "memory")
#define VM_WAIT() asm volatile("s_waitcnt vmcnt(0)" ::: "memory")

constexpr int DM = 1024, NBATCH = 8, SEQ = 4096, MTOK = NBATCH * SEQ;
constexpr int MH = 8, MDK = 64, MDV = 128, MPROJ = 3088, MPROJ_MAIN = 3072;
constexpr int SBH = 16, SBD = 64;
constexpr int FFN = 2816, NEXP = 8, EDIM = 3584;
constexpr float EPS = 1e-6f, SOFTCAP = 15.0f;
constexpr float LOG2E = 1.4426950408889634f;
constexpr int NWAVES = 8;
constexpr int MAXTILES = 264;
constexpr int HALF0_TILES = 128;
namespace pg8 {
constexpr int BM = 256, BK = 64, HALF = 128, HTB = HALF * BK * 2  , STAGE_BYTES = 8 * HTB, NXCD = 8, WGM = 8;

__host__ __device__ __forceinline__ int lds_byte(int r, int c) { const int st = (r >> 4) * 2 + (c >> 5), rr = r & 15, cc = c & 31, ob = rr * 64 + cc * 2; return st * 1024 + (ob ^ (((ob >> 9) & 1) << 5)); }
__host__ __device__ __forceinline__ void stage_rc(int b, int& R, int& C) { const int st = b / 1024, sb = b % 1024, swz = sb ^ (((sb >> 9) & 1) << 5); R = (st >> 1) * 16 + swz / 64; C = (st & 1) * 32 + (swz % 64) / 2; }
__host__ __device__ __forceinline__ int perm32(int rho) { const int n = rho >> 4, i = rho & 15; return 8 * (i >> 2) + 4 * n + (i & 3); }

struct Unit { int pm, pn, pb, pa; };
struct Gemm { const bf16_t* A; const bf16_t* Bt; int K; };

struct StaticOrder {
    int nM, nN, nwg, G, c;
    __device__ void init(int M, int N, int G_, int c_) { nM = M / BM; nN = N / BM; nwg = nM * nN; G = G_; c = c_; }
    __device__ bool next(int i, Unit& u) const {
        const long L = (long)i * G + c; if (L >= nwg) return false;
        int wgid = (int)L; { const int q = nwg / NXCD, r = nwg % NXCD, xcd = wgid % NXCD, off = wgid / NXCD; wgid = (xcd < r ? xcd * (q + 1) : r * (q + 1) + (xcd - r) * q) + off; }
        const int nig = WGM * nN, gid = wgid / nig, fm = gid * WGM, gsz = (nM - fm) < WGM ? (nM - fm) : WGM;
        u.pm = fm + ((wgid % nig) % gsz); u.pn = (wgid % nig) / gsz; u.pb = u.pn; u.pa = u.pm; return true;
    }
};
struct MoeOrder {
    int tile_lo, ntile, nN, G, c; const LAS int* texp;
    __device__ bool next(int i, Unit& u) const {
        const long L = (long)i * G + c; if (L >= (long)ntile * nN) return false;
        const int t = (int)(L / nN); u.pn = (int)(L % nN); u.pm = tile_lo + t; u.pa = t; u.pb = __builtin_amdgcn_readfirstlane(texp[u.pm]) * nN + u.pn; return true;
    }
};

__device__ __forceinline__ unsigned cvt_pk_bf16(float lo, float hi) { unsigned r; asm volatile("v_cvt_pk_bf16_f32 %0, %1, %2" : "=v"(r) : "v"(lo), "v"(hi)); return r; }

template <class Epi, class Sched, bool GATHER>
__device__ __forceinline__ void gemm_phase(LAS unsigned char* lds, LAS unsigned char* auxb, const Gemm g, const Sched& S, const Epi& E) {
    constexpr int NAUX = Epi::NAUX;
    int tid_ = threadIdx.x; asm volatile("" : "+v"(tid_));
    const int tid = tid_, wid = __builtin_amdgcn_readfirstlane(tid >> 6), lane = tid & 63, wr = wid >> 2, wc = wid & 3, fr = lane & 15, fq = lane >> 4;
    const int K = g.K, nt = K / BK;
    unsigned voffB[2]; int Rr[2], Cc[2];
#pragma unroll
    for (int i = 0; i < 2; ++i) { int R, C; stage_rc(tid * 16 + i * 8192, R, C); const int Rb = Epi::PERM ? ((R & ~31) + perm32(R & 31)) : R;
        Rr[i] = R; Cc[i] = C; voffB[i] = (unsigned)(Rb * K + C) * 2u; }
    const size_t kstep = (size_t)(BK * 2);
    const size_t hstep = (size_t)HALF * K * 2;
    const size_t tstep = 2 * hstep;
    const unsigned ldsw = (unsigned)wid * 1024u;
    const int aoff = lds_byte(wr * 64 + fr, fq * 8), boff = lds_byte(wc * 32 + fr, fq * 8);
#define PG8_SA(b, h) (((b) * 2 + (h)) * HTB)
#define PG8_SB(b, h) ((4 + (b) * 2 + (h)) * HTB)
#define PG8_STAGE(bufoff, gbase, voff) do { _Pragma("unroll") for (int _i = 0; _i < 2; ++_i) \
        __builtin_amdgcn_global_load_lds((const unsigned*)((const char*)(gbase) + (voff)[_i]), (LAS unsigned*)(lds + (bufoff) + ldsw + _i * 8192), 16, 0, 0); } while (0)
#define PG8_LDA(dst, b, h) do { _Pragma("unroll") for (int m = 0; m < 4; ++m) _Pragma("unroll") for (int k = 0; k < 2; ++k) dst[m][k] = *(const LAS bf16x8*)(lds + PG8_SA(b, h) + aoff + m * 2048 + k * 1024); } while (0)
#define PG8_LDB(dst, b, h) do { _Pragma("unroll") for (int n = 0; n < 2; ++n) _Pragma("unroll") for (int k = 0; k < 2; ++k) dst[n][k] = *(const LAS bf16x8*)(lds + PG8_SB(b, h) + boff + n * 2048 + k * 1024); } while (0)
#define PG8_MMA(ai, bj, At, Bt) do { __builtin_amdgcn_s_setprio(1); _Pragma("unroll") for (int m = 0; m < 4; ++m) _Pragma("unroll") for (int n = 0; n < 2; ++n) _Pragma("unroll") for (int k = 0; k < 2; ++k) \
        acc[ai][bj][m][n] = __builtin_amdgcn_mfma_f32_16x16x32_bf16(Bt[n][k], At[m][k], acc[ai][bj][m][n], 0, 0, 0); __builtin_amdgcn_s_setprio(0); } while (0)
#define PG8_WAIT_V(n) asm volatile("s_waitcnt vmcnt(" #n ")" ::: "memory")
#define PG8_WAIT_L(n) asm volatile("s_waitcnt lgkmcnt(" #n ")" ::: "memory")
#define PG8_BAR __builtin_amdgcn_s_barrier()
#define PG8_SCHED __builtin_amdgcn_sched_barrier(0)
#define PG8_VA(dst, par) do { _Pragma("unroll") for (int _h = 0; _h < 2; ++_h) _Pragma("unroll") for (int _i = 0; _i < 2; ++_i) { \
        if constexpr (GATHER) { const int _ix = ((const LAS int*)(auxb + (size_t)(par) * NAUX * 1024))[_h * HALF + Rr[_i]]; dst[_h][_i] = (unsigned)_ix * (unsigned)(K * 2) + (unsigned)(Cc[_i] * 2); } \
        else dst[_h][_i] = (unsigned)((_h * HALF + Rr[_i]) * K + Cc[_i]) * 2u; } } while (0)
#define PG8_AUX(un, par) do { if constexpr (NAUX > 0) { const unsigned* _src = (const unsigned*)((const char*)E.aux_src(un) + lane * 16); LAS unsigned* _dst = (LAS unsigned*)(auxb + (size_t)((par) * NAUX) * 1024); \
        _Pragma("unroll") for (int _p = 0; _p < NAUX; ++_p) { __builtin_amdgcn_global_load_lds(_src, _dst, 16, 0, 0); _src += 256; _dst += 256; asm volatile("" : "+v"(_src)); } } } while (0)
    Unit cur, nxt, prv; int ui = 0;
    if (!S.next(0, cur)) return;
    prv = cur;
    f32x4 acc[2][2][4][2];
#pragma unroll
    for (int a = 0; a < 2; ++a)
#pragma unroll
        for (int b = 0; b < 2; ++b)
#pragma unroll
            for (int m = 0; m < 4; ++m)
#pragma unroll
                for (int n = 0; n < 2; ++n) acc[a][b][m][n] = (f32x4){0.f, 0.f, 0.f, 0.f};
    bf16x8 At[4][2], B0[2][2], B1[2][2];
    unsigned vAc[2][2], vAn[2][2];
    if constexpr (NAUX > 0) { if (wid == 0) PG8_AUX(cur, 0); PG8_WAIT_V(0); PG8_BAR; }
    PG8_VA(vAc, 0);
#pragma unroll
    for (int h = 0; h < 2; ++h)
#pragma unroll
        for (int i = 0; i < 2; ++i) vAn[h][i] = vAc[h][i];
    const char* cA = GATHER ? (const char*)g.A : (const char*)g.A + (size_t)cur.pa * tstep; const char* cB = (const char*)g.Bt + (size_t)cur.pb * tstep;
    PG8_STAGE(PG8_SB(0, 0), cB, voffB); PG8_STAGE(PG8_SB(0, 1), cB + hstep, voffB); PG8_STAGE(PG8_SA(0, 0), cA, vAc[0]); PG8_STAGE(PG8_SA(0, 1), cA, vAc[1]);
    if (wr == 1) PG8_BAR;
    PG8_WAIT_V(2); PG8_BAR;
    PG8_STAGE(PG8_SB(1, 0), cB + kstep, voffB); PG8_STAGE(PG8_SA(1, 0), cA + kstep, vAc[0]); PG8_STAGE(PG8_SB(1, 1), cB + hstep + kstep, voffB);
    PG8_WAIT_V(6); PG8_BAR;
    for (;;) {
        const bool has_next = S.next(ui + 1, nxt);
        const char* nA = has_next ? (GATHER ? (const char*)g.A : (const char*)g.A + (size_t)nxt.pa * tstep) : cA; const char* nB = has_next ? (const char*)g.Bt + (size_t)nxt.pb * tstep : cB;
        for (int t = 0; t < nt; t += 2) {
            const bool last = (t == nt - 2);
            if constexpr (NAUX > 0) { if (t == 2 && has_next && wid == 4) PG8_AUX(nxt, (ui + 1) & 1); }
            if (last && has_next) { PG8_VA(vAn, (ui + 1) & 1); }
            const char* a1 = cA + (size_t)(t + 1) * kstep;
            const char* a2 = last ? nA : cA + (size_t)(t + 2) * kstep; const char* b2 = last ? nB : cB + (size_t)(t + 2) * kstep;
            const char* a3 = a2 + kstep; const char* b3 = b2 + kstep;
            unsigned v2[2][2];
#pragma unroll
            for (int h = 0; h < 2; ++h)
#pragma unroll
                for (int i = 0; i < 2; ++i) v2[h][i] = (last && has_next) ? vAn[h][i] : vAc[h][i];
            PG8_LDB(B0, 0, 0); PG8_LDB(B1, 0, 1); PG8_SCHED; PG8_LDA(At, 0, 0); PG8_STAGE(PG8_SA(1, 1), a1, vAc[1]);
            PG8_WAIT_V(8); PG8_WAIT_L(0); PG8_BAR; PG8_MMA(0, 0, At, B0); PG8_MMA(0, 1, At, B1); PG8_BAR; PG8_SCHED;
            PG8_LDA(At, 0, 1); PG8_STAGE(PG8_SB(0, 0), b2, voffB); PG8_STAGE(PG8_SB(0, 1), b2 + hstep, voffB); PG8_STAGE(PG8_SA(0, 0), a2, v2[0]);
            PG8_WAIT_V(8); PG8_WAIT_L(0); PG8_BAR; PG8_MMA(1, 0, At, B0); PG8_MMA(1, 1, At, B1); PG8_BAR; PG8_SCHED;
            PG8_LDB(B0, 1, 0); PG8_LDB(B1, 1, 1); PG8_SCHED; PG8_LDA(At, 1, 0); PG8_STAGE(PG8_SA(0, 1), a2, v2[1]);
            PG8_WAIT_V(8); PG8_WAIT_L(0); PG8_BAR; PG8_MMA(0, 0, At, B0); PG8_MMA(0, 1, At, B1); PG8_BAR; PG8_SCHED;
            PG8_LDA(At, 1, 1); PG8_STAGE(PG8_SB(1, 0), b3, voffB); PG8_STAGE(PG8_SB(1, 1), b3 + hstep, voffB); PG8_STAGE(PG8_SA(1, 0), a3, v2[0]);
            PG8_WAIT_V(8); PG8_WAIT_L(0); PG8_BAR; PG8_MMA(1, 0, At, B0); PG8_MMA(1, 1, At, B1); PG8_BAR; PG8_SCHED;
        }
        if (wr == 0) PG8_BAR;
        E(acc, cur, wr, wc, fr, fq, (const LAS unsigned char*)(auxb + (size_t)(ui & 1) * NAUX * 1024), ui, prv);
        if (!has_next) break;
#pragma unroll
        for (int a = 0; a < 2; ++a)
#pragma unroll
            for (int b = 0; b < 2; ++b)
#pragma unroll
                for (int m = 0; m < 4; ++m)
#pragma unroll
                    for (int n = 0; n < 2; ++n) acc[a][b][m][n] = (f32x4){0.f, 0.f, 0.f, 0.f};
        prv = cur; cur = nxt; cA = nA; cB = nB; ++ui;
#pragma unroll
        for (int h = 0; h < 2; ++h)
#pragma unroll
            for (int i = 0; i < 2; ++i) vAc[h][i] = vAn[h][i];
        if (wr == 1) PG8_BAR;
    }
    PG8_WAIT_V(0); PG8_WAIT_L(0);
    PG8_BAR;
    E.finish(cur, ui);
#undef PG8_SA
#undef PG8_SB
#undef PG8_STAGE
#undef PG8_LDA
#undef PG8_LDB
#undef PG8_MMA
#undef PG8_WAIT_V
#undef PG8_WAIT_L
#undef PG8_BAR
#undef PG8_SCHED
#undef PG8_VA
#undef PG8_AUX
}
}
namespace pg8 {
__device__ __forceinline__ float sigmoid_fast(float x) { return __builtin_amdgcn_rcpf(1.0f + __builtin_amdgcn_exp2f(-LOG2E * x)); }
template <int NP> __device__ __forceinline__ float row_rs(const LAS unsigned char* aux, int rl) {
    const LAS float* ax = (const LAS float*)aux; float ss = ax[rl];
#pragma unroll
    for (int p = 1; p < NP; ++p) ss += ax[p * 256 + rl];
    return rsqrtf(ss * (1.0f / DM) + EPS);
}
__device__ __forceinline__ u32x4 pack8(const f32x4 a, const f32x4 b) { u32x4 w; w.x = cvt_pk_bf16(a[0], a[1]); w.y = cvt_pk_bf16(a[2], a[3]); w.z = cvt_pk_bf16(b[0], b[1]); w.w = cvt_pk_bf16(b[2], b[3]); return w; }

struct EpiProj {
    static constexpr bool PERM = true; static constexpr int NAUX = 1;
    bf16_t* Q; bf16_t* Kk; bf16_t* Kt; bf16_t* Vt; bf16_t* OG; const float* ss0;
    __device__ __forceinline__ const void* aux_src(const Unit& u) const { return ss0 + (size_t)u.pm * 256; }
    __device__ __forceinline__ void operator()(const f32x4 (&acc)[2][2][4][2], const Unit& u, int wr, int wc, int fr, int fq, const LAS unsigned char* aux, int, const Unit&) const {
        asm volatile("" : "+v"(fr), "+v"(fq));
        const int pn = u.pn;
        if (pn < 4 || pn >= 8) {
            bf16_t* base; int ldc, colt; bool sig = false;
            if (pn < 2) { base = Q; ldc = 512; colt = pn * 256; } else if (pn < 4) { base = Kk; ldc = 512; colt = (pn - 2) * 256; } else { base = OG; ldc = 1024; colt = (pn - 8) * 256; sig = true; }
#pragma unroll
            for (int ai = 0; ai < 2; ++ai)
#pragma unroll
                for (int m = 0; m < 4; ++m) { const int rl = ai * HALF + wr * 64 + m * 16 + fr; const float rs = row_rs<1>(aux, rl);
                    bf16_t* rowp = base + (size_t)(u.pm * BM + rl) * ldc + colt + wc * 32 + 8 * fq;
#pragma unroll
                    for (int bj = 0; bj < 2; ++bj) { f32x4 v0 = acc[ai][bj][m][0] * rs, v1 = acc[ai][bj][m][1] * rs;
                        if (sig) {
#pragma unroll
                            for (int j = 0; j < 4; ++j) { v0[j] = sigmoid_fast(v0[j]); v1[j] = sigmoid_fast(v1[j]); } }
                        *(u32x4*)(rowp + bj * HALF) = pack8(v0, v1); }
                    asm volatile("" ::: "memory"); }
        }
        if (pn >= 2 && pn < 8) {
            const bool isk = pn < 4; const int colt = isk ? (pn - 2) * 256 : (pn - 4) * 256; bf16_t* tb = isk ? Kt : Vt; const int hshift = isk ? 6 : 7;
#pragma unroll
            for (int ai = 0; ai < 2; ++ai)
#pragma unroll
                for (int m = 0; m < 4; ++m) { const int rl = ai * HALF + wr * 64 + m * 16 + fr; const float rs = row_rs<1>(aux, rl); const int row = u.pm * BM + rl, b = row >> 12, t = row & 4095;
#pragma unroll
                    for (int bj = 0; bj < 2; ++bj)
#pragma unroll
                        for (int n = 0; n < 2; ++n)
#pragma unroll
                            for (int j = 0; j < 4; ++j) { const int col = colt + bj * HALF + wc * 32 + 8 * fq + 4 * n + j, hd = col >> hshift, cc = col & ((1 << hshift) - 1);
                                tb[((size_t)((b * MH + hd) << hshift) + cc) * SEQ + t] = (bf16_t)(cvt_pk_bf16(acc[ai][bj][m][n][j] * rs, 0.f) & 0xffffu); }
                    asm volatile("" ::: "memory"); }
        }
    }
    __device__ __forceinline__ void finish(const Unit&, int) const {}
};

struct EpiRes {
    static constexpr bool PERM = true; static constexpr int NAUX = 0;
    const float* base; float* out; bf16_t* xb; float* ssp; LAS float* red;
    __device__ __forceinline__ const void* aux_src(const Unit&) const { return nullptr; }
    __device__ __forceinline__ void flush(const Unit& p, int par) const {
        if (threadIdx.x < 256) { const LAS float* r = red + par * 1024; const int row = threadIdx.x; ssp[((size_t)p.pm * 4 + p.pn) * 256 + row] = (r[row] + r[256 + row]) + (r[512 + row] + r[768 + row]); } }
    __device__ __forceinline__ void operator()(const f32x4 (&acc)[2][2][4][2], const Unit& u, int wr, int wc, int fr, int fq, const LAS unsigned char*, int ui, const Unit& prv) const {
        asm volatile("" : "+v"(fr), "+v"(fq));
        if (ssp && ui > 0) flush(prv, (ui - 1) & 1);
#pragma unroll
        for (int ai = 0; ai < 2; ++ai)
#pragma unroll
            for (int m = 0; m < 4; ++m) { const int rl = ai * HALF + wr * 64 + m * 16 + fr; const size_t off = (size_t)(u.pm * BM + rl) * DM + u.pn * BM + wc * 32 + 8 * fq; float ss = 0.f;
#pragma unroll
                for (int bj = 0; bj < 2; ++bj) { const f32x4 b0 = *(const f32x4*)(base + off + bj * HALF), b1 = *(const f32x4*)(base + off + bj * HALF + 4);
                    const f32x4 v0 = acc[ai][bj][m][0] + b0, v1 = acc[ai][bj][m][1] + b1;
                    *(f32x4*)(out + off + bj * HALF) = v0; *(f32x4*)(out + off + bj * HALF + 4) = v1; *(u32x4*)(xb + off + bj * HALF) = pack8(v0, v1);
                    ss += (v0[0] * v0[0] + v0[1] * v0[1]) + (v0[2] * v0[2] + v0[3] * v0[3]) + (v1[0] * v1[0] + v1[1] * v1[1]) + (v1[2] * v1[2] + v1[3] * v1[3]); }
                if (ssp) { ss += __shfl_xor(ss, 16); ss += __shfl_xor(ss, 32); if (fq == 0) red[(ui & 1) * 1024 + wc * 256 + rl] = ss; }
                asm volatile("" ::: "memory"); }
    }
    __device__ __forceinline__ void finish(const Unit& last, int ui) const { if (ssp) flush(last, ui & 1); }
};

template <bool MOE> struct EpiGu {
    static constexpr bool PERM = true; static constexpr int NAUX = MOE ? 3 : 4;
    bf16_t* H; int ldh; const float* ssp;
    __device__ __forceinline__ const void* aux_src(const Unit& u) const { return ssp + (size_t)u.pm * 1024; }
    __device__ __forceinline__ void operator()(const f32x4 (&acc)[2][2][4][2], const Unit& u, int wr, int wc, int fr, int fq, const LAS unsigned char* aux, int, const Unit&) const {
        asm volatile("" : "+v"(fr), "+v"(fq));
#pragma unroll
        for (int ai = 0; ai < 2; ++ai)
#pragma unroll
            for (int m = 0; m < 4; ++m) { const int rl = ai * HALF + wr * 64 + m * 16 + fr; float rs, w = 1.f;
                if constexpr (MOE) { rs = ((const LAS float*)(aux + 1024))[rl]; w = ((const LAS float*)(aux + 2048))[rl]; } else rs = row_rs<4>(aux, rl);
                bf16_t* rowp = H + (size_t)(u.pa * BM + rl) * ldh + u.pn * HALF + wc * 32 + 8 * fq;
                f32x4 h[2];
#pragma unroll
                for (int n = 0; n < 2; ++n) { const f32x4 gg = acc[ai][0][m][n] * rs, uu = acc[ai][1][m][n] * rs;
#pragma unroll
                    for (int j = 0; j < 4; ++j) h[n][j] = gg[j] * sigmoid_fast(gg[j]) * uu[j] * w; }
                *(u32x4*)rowp = pack8(h[0], h[1]);
                asm volatile("" ::: "memory"); }
    }
    __device__ __forceinline__ void finish(const Unit&, int) const {}
};

struct EpiKvq {
    static constexpr bool PERM = true; static constexpr int NAUX = 4;
    bf16_t* Kb; bf16_t* Vt; bf16_t* Qb; const float* ssp; const LAS float* gk;
    __device__ __forceinline__ const void* aux_src(const Unit& u) const { return ssp + (size_t)u.pm * 1024; }
    __device__ __forceinline__ void operator()(const f32x4 (&acc)[2][2][4][2], const Unit& u, int wr, int wc, int fr, int fq, const LAS unsigned char* aux, int, const Unit&) const {
        asm volatile("" : "+v"(fr), "+v"(fq));
        const int kind = u.pn >> 2, hd = (u.pn & 3) * 4 + wc;
#pragma unroll
        for (int ai = 0; ai < 2; ++ai)
#pragma unroll
            for (int m = 0; m < 4; ++m) { const int rl = ai * HALF + wr * 64 + m * 16 + fr; const float rs = row_rs<4>(aux, rl); const int row = u.pm * BM + rl;
                f32x4 y[2][2]; float ssq = 0.f;
#pragma unroll
                for (int bj = 0; bj < 2; ++bj)
#pragma unroll
                    for (int n = 0; n < 2; ++n) { y[bj][n] = acc[ai][bj][m][n] * rs; const f32x4 t = y[bj][n]; ssq += (t[0] * t[0] + t[1] * t[1]) + (t[2] * t[2] + t[3] * t[3]); }
                if (kind != 1) {
                    ssq += __shfl_xor(ssq, 16); ssq += __shfl_xor(ssq, 32);
                    const float rinv = rsqrtf(ssq * (1.0f / 64.0f) + EPS) * (kind == 2 ? LOG2E * 0.125f : 1.0f);
                    const LAS float* g = gk + (kind == 2 ? 64 : 0);
                    bf16_t* dst = (kind == 2 ? Qb : Kb) + (size_t)row * 1024 + hd * 64;
#pragma unroll
                    for (int bj = 0; bj < 2; ++bj) { const int pos0 = 32 * bj + 8 * fq; const f32x4 g0 = *(const LAS f32x4*)(g + pos0), g1 = *(const LAS f32x4*)(g + pos0 + 4);
                        *(u32x4*)(dst + pos0) = pack8(y[bj][0] * rinv * g0, y[bj][1] * rinv * g1); }
                } else {
                    const int b = row >> 12, t = row & 4095; bf16_t* dst = Vt + ((size_t)(b * 16 + hd) * 64) * 4096 + t;
#pragma unroll
                    for (int bj = 0; bj < 2; ++bj)
#pragma unroll
                        for (int n = 0; n < 2; ++n)
#pragma unroll
                            for (int j = 0; j < 4; ++j) dst[(size_t)(32 * bj + 8 * fq + 4 * n + j) * 4096] = (bf16_t)(cvt_pk_bf16(y[bj][n][j], 0.f) & 0xffffu);
                }
                asm volatile("" ::: "memory"); }
    }
    __device__ __forceinline__ void finish(const Unit&, int) const {}
};

struct EpiMoeDn {
    static constexpr bool PERM = true; static constexpr int NAUX = 1;
    bf16_t* Y; const int* slot;
    __device__ __forceinline__ const void* aux_src(const Unit& u) const { return slot + (size_t)u.pm * 1024 + 768; }
    __device__ __forceinline__ void operator()(const f32x4 (&acc)[2][2][4][2], const Unit& u, int wr, int wc, int fr, int fq, const LAS unsigned char* aux, int, const Unit&) const {
        asm volatile("" : "+v"(fr), "+v"(fq));
#pragma unroll
        for (int ai = 0; ai < 2; ++ai)
#pragma unroll
            for (int m = 0; m < 4; ++m) { const int rl = ai * HALF + wr * 64 + m * 16 + fr; const int yr = ((const LAS int*)aux)[rl];
                if (yr >= 0) { bf16_t* rowp = Y + (size_t)yr * DM + u.pn * BM + wc * 32 + 8 * fq;
#pragma unroll
                    for (int bj = 0; bj < 2; ++bj) *(u32x4*)(rowp + bj * HALF) = pack8(acc[ai][bj][m][0], acc[ai][bj][m][1]); }
                asm volatile("" ::: "memory"); }
    }
    __device__ __forceinline__ void finish(const Unit&, int) const {}
};
}
constexpr size_t MiB = 1u << 20;
constexpr size_t WS_CTL = 0, CTL_ZERO_BYTES = 64 * 1024;
constexpr size_t WS_WIN = 1 * MiB, WS_WOUT = 7 * MiB, WS_WGU = 9 * MiB, WS_WD = 20 * MiB, WS_WKVQ = 26 * MiB, WS_WO = 32 * MiB, WS_WMGU = 34 * MiB, WS_WMD = 146 * MiB;
constexpr size_t WS_TAB = 202 * MiB;
constexpr size_t T_SS0 = WS_TAB, T_SSP = WS_TAB + 128 * 1024, T_GATES = WS_TAB + 1 * MiB, T_SELE = WS_TAB + 3 * MiB, T_SELW1 = T_SELE + 128 * 1024, T_SELW2 = T_SELE + 256 * 1024, T_SELRS = T_SELE + 384 * 1024;
constexpr size_t T_SLOT = WS_TAB + 4 * MiB;
constexpr size_t WS_A = 208 * MiB;
constexpr size_t WS_B = 272 * MiB;
constexpr size_t B_Q = WS_B, B_K = WS_B + 32 * MiB, B_VT = WS_B + 64 * MiB, B_OG = WS_B + 128 * MiB, B_HN = WS_B + 192 * MiB;
constexpr size_t B_HF = WS_B;
constexpr size_t B_SBK = WS_B, B_SBVT = WS_B + 64 * MiB, B_SBQ = WS_B + 128 * MiB;
constexpr size_t B_HM = WS_B;
constexpr size_t WS_END = 528 * MiB;
static_assert((size_t)MAXTILES * 4096 <= 2 * MiB && B_HM + (size_t)(MAXTILES - HALF0_TILES) * 256 * EDIM * 2 <= WS_END && B_HN + (size_t)MTOK * DM * 2 <= WS_END, "d_ws map");
constexpr int CW_TMO = 0, CW_BAR = 4096, CW_CNT = 8192, CW_MOE = 12288, CW_TEXP = CW_MOE + 64;
constexpr int RING_OFF = 0, RING_BYTES = 131072;
constexpr int AUX_OFF = RING_BYTES, AUX_BYTES = 8192;
constexpr int RED_OFF = AUX_OFF + AUX_BYTES, RED_BYTES = 8192;
constexpr int TEX_OFF = RED_OFF + RED_BYTES, TEX_BYTES = 2048;
constexpr int MISC_OFF = TEX_OFF + TEX_BYTES;
constexpr int LDS_BYTES = MISC_OFF + 128;
static_assert(LDS_BYTES <= 160 * 1024 && LDS_BYTES > 80 * 1024, "LDS map: one workgroup per CU");

#define XB_TMO      128
#define XB_XCNT(j)  (256  + 64 * (j))
#define XB_XSUB(j)  (1280 + 64 * (j))
#define XB_XGEN(j)  (2304 + 64 * (j))
#define XB_TOP      3328
#define XB_TOPGEN   3392
#define XCD_BAR_WORDS 3456
#define XB_SPIN_CAP (1u << 18)
__device__ __forceinline__ unsigned xb_ld(unsigned* p)              { return __hip_atomic_load(p, __ATOMIC_RELAXED, __HIP_MEMORY_SCOPE_AGENT); }
__device__ __forceinline__ unsigned xb_add(unsigned* p, unsigned v) { return __hip_atomic_fetch_add(p, v, __ATOMIC_RELAXED, __HIP_MEMORY_SCOPE_AGENT); }
__device__ __forceinline__ unsigned xb_xcc_id() { return (unsigned)__builtin_amdgcn_s_getreg((3 << 11) | 20) & 0xFu; }
#define XB_SPIN(cond, bar) do { unsigned _sp = 0; while (cond) { __builtin_amdgcn_s_sleep(1); \
    if ((++_sp & 255u) == 0u) { if (xb_ld(&(bar)[XB_TMO])) break; if (_sp > XB_SPIN_CAP) { atomicAdd(&(bar)[XB_TMO], 1u); break; } } } } while (0)
struct XcdBarrier { unsigned* bar; unsigned x; volatile LAS unsigned* st; };
__device__ __forceinline__ XcdBarrier xcd_barrier_post(unsigned* bar, volatile LAS unsigned* st) {
    XcdBarrier b; b.bar = bar; b.x = xb_xcc_id(); b.st = st;
    if (threadIdx.x == 0) (void)xb_add(&bar[XB_XCNT(b.x)], 1u);
    return b;
}
__device__ __forceinline__ void xcd_barrier_complete(unsigned* bar, unsigned x, unsigned& nloc, unsigned& nx) {
    const unsigned G = gridDim.x * gridDim.y * gridDim.z;
    unsigned sum, cnt, mine, sp = 0u;
    for (;;) {
        sum = 0u; cnt = 0u; mine = 0u;
#pragma unroll
        for (unsigned j = 0; j < 16; ++j) { const unsigned c = xb_ld(&bar[XB_XCNT(j)]); sum += c; cnt += (c > 0u) ? 1u : 0u; mine = (j == x) ? c : mine; }
        if (sum == G) break;
        __builtin_amdgcn_s_sleep(1);
        if ((++sp & 255u) == 0u) { if (xb_ld(&bar[XB_TMO])) break; if (sp > XB_SPIN_CAP) { atomicAdd(&bar[XB_TMO], 1u); break; } }
    }
    nloc = mine > 0u ? mine : 1u; nx = cnt > 0u ? cnt : 1u;
}
__device__ __forceinline__ void xcd_barrier(const XcdBarrier& b) {
    asm volatile("s_waitcnt vmcnt(0)" ::: "memory");
    __syncthreads();
    if (threadIdx.x == 0) {
        unsigned* bar = b.bar;
        __builtin_amdgcn_s_waitcnt(0);
        unsigned nloc = b.st[0], nx = b.st[1];
        if (nloc == 0u) { xcd_barrier_complete(bar, b.x, nloc, nx); b.st[0] = nloc; b.st[1] = nx; }
        const unsigned old = xb_add(&bar[XB_XSUB(b.x)], 1u);
        const unsigned gen = old / nloc;
        if (old + 1u == (gen + 1u) * nloc) {
            __builtin_amdgcn_fence(__ATOMIC_RELEASE, "agent");
            asm volatile("s_waitcnt vmcnt(0)" ::: "memory");
            const unsigned og = xb_add(&bar[XB_TOP], 1u);
            const unsigned tg = og / nx;
            if (og + 1u == (tg + 1u) * nx) xb_add(&bar[XB_TOPGEN], 1u);
            else XB_SPIN(xb_ld(&bar[XB_TOPGEN]) == tg, bar);
            __builtin_amdgcn_fence(__ATOMIC_ACQUIRE, "agent");
            xb_add(&bar[XB_XGEN(b.x)], 1u);
            asm volatile("s_waitcnt vmcnt(0)" ::: "memory");
        } else {
            XB_SPIN(xb_ld(&bar[XB_XGEN(b.x)]) == gen, bar);
            __builtin_amdgcn_fence(__ATOMIC_ACQUIRE, "agent");
            asm volatile("s_waitcnt vmcnt(0)" ::: "memory");
        }
    }
    __syncthreads();
}

struct Args { const float* in[21]; float* out; unsigned char* ws; int ph_lo, ph_hi; };
struct Frame {
    LAS unsigned char* lds;
    volatile LAS unsigned* MISC;
    unsigned* ctl;
    int tid, lane, wave, vcu, G;
    float* out; unsigned char* ws;
};
enum { I_X = 0, I_MIXN, I_FFNN, I_WIN, I_BI, I_BF, I_GH, I_WOUT, I_KVN, I_WKV, I_GK, I_WQ, I_GQ, I_WO, I_FG, I_FU, I_FD, I_WR, I_MG, I_MU, I_MD };
__device__ __forceinline__ unsigned f2bf(float f) { unsigned u = __builtin_bit_cast(unsigned, f); return (u + 0x7fffu + ((u >> 16) & 1u)) >> 16; }
__device__ __forceinline__ unsigned pk2(float lo, float hi) { return f2bf(lo) | (f2bf(hi) << 16); }
__device__ __forceinline__ float bf2f(unsigned short b) { return __builtin_bit_cast(float, (unsigned)b << 16); }
__device__ __forceinline__ float wave_sum(float v) {
#pragma unroll
    for (int o = 1; o < 64; o <<= 1) v += __shfl_xor(v, o);
    return v;
}

struct Job { const float* src; int ldw, col0, ncols, K; const float* gain; float scale; bf16* dst; int type, roff; };
__device__ __forceinline__ int rowmap(int type, int roff, int n) {
    if (type == 0) return roff + n;
    if (type == 1) return 256 * (n >> 7) + (n & 127) + roff;
    return roff + 256 * (n >> 8) + 128 * ((n & 63) >> 5) + 32 * ((n & 255) >> 6) + (n & 31);
}
constexpr int SMALL_ITEMS = 256 + 256 + 1024 + 512 + 1408 * 3 + 512 * 4, MOE_ITEMS = 1792, P0_ITEMS = SMALL_ITEMS + 24 * MOE_ITEMS;
__device__ __forceinline__ void get_job(const Args& A, Frame& F, int it, Job& jb, int& local) {
    unsigned char* ws = F.ws;
    if (it >= SMALL_ITEMS) { const int r = it - SMALL_ITEMS, j = r / MOE_ITEMS; local = r % MOE_ITEMS; const int kind = j >> 3, e = j & 7;
        if (kind == 0)      jb = Job{A.in[I_MG] + (size_t)e * DM * EDIM, EDIM, 0, EDIM, DM, A.in[I_FFNN] + DM, 1.f, (bf16*)(ws + WS_WMGU) + (size_t)e * 2 * EDIM * DM, 1, 0};
        else if (kind == 1) jb = Job{A.in[I_MU] + (size_t)e * DM * EDIM, EDIM, 0, EDIM, DM, A.in[I_FFNN] + DM, 1.f, (bf16*)(ws + WS_WMGU) + (size_t)e * 2 * EDIM * DM, 1, 128};
        else                jb = Job{A.in[I_MD] + (size_t)e * EDIM * DM, DM, 0, DM, EDIM, nullptr, 1.f, (bf16*)(ws + WS_WMD) + (size_t)e * DM * EDIM, 0, 0};
        return; }
    int r = it;
    if (r < 256)  { local = r; jb = Job{A.in[I_WIN], MPROJ, 0, 512, DM, A.in[I_MIXN], 1.f, (bf16*)(ws + WS_WIN), 0, 0}; return; } r -= 256;
    if (r < 256)  { local = r; jb = Job{A.in[I_WIN], MPROJ, 512, 512, DM, A.in[I_MIXN], 0.125f, (bf16*)(ws + WS_WIN), 0, 512}; return; } r -= 256;
    if (r < 1024) { local = r; jb = Job{A.in[I_WIN], MPROJ, 1024, 2048, DM, A.in[I_MIXN], 1.f, (bf16*)(ws + WS_WIN), 0, 1024}; return; } r -= 1024;
    if (r < 512)  { local = r; jb = Job{A.in[I_WOUT], DM, 0, DM, DM, nullptr, 1.f, (bf16*)(ws + WS_WOUT), 0, 0}; return; } r -= 512;
    if (r < 1408) { local = r; jb = Job{A.in[I_FG], FFN, 0, FFN, DM, A.in[I_FFNN], 1.f, (bf16*)(ws + WS_WGU), 1, 0}; return; } r -= 1408;
    if (r < 1408) { local = r; jb = Job{A.in[I_FU], FFN, 0, FFN, DM, A.in[I_FFNN], 1.f, (bf16*)(ws + WS_WGU), 1, 128}; return; } r -= 1408;
    if (r < 1408) { local = r; jb = Job{A.in[I_FD], DM, 0, DM, FFN, nullptr, 1.f, (bf16*)(ws + WS_WD), 0, 0}; return; } r -= 1408;
    if (r < 512)  { local = r; jb = Job{A.in[I_WKV], 2 * DM, 0, DM, DM, A.in[I_KVN], 1.f, (bf16*)(ws + WS_WKVQ), 2, 0}; return; } r -= 512;
    if (r < 512)  { local = r; jb = Job{A.in[I_WKV], 2 * DM, DM, DM, DM, A.in[I_KVN], 1.f, (bf16*)(ws + WS_WKVQ), 2, 1024}; return; } r -= 512;
    if (r < 512)  { local = r; jb = Job{A.in[I_WQ], DM, 0, DM, DM, A.in[I_MIXN] + DM, 1.f, (bf16*)(ws + WS_WKVQ), 2, 2048}; return; } r -= 512;
    local = r; jb = Job{A.in[I_WO], DM, 0, DM, DM, nullptr, 1.f, (bf16*)(ws + WS_WO), 0, 0};
}
__device__ __forceinline__ void p0_item(const Job& jb, int item, LAS float* scr, int lane) {
    const int nnb = jb.ncols / 32, kb = item / nnb, nb = item % nnb, k0 = 64 * kb, n0 = 32 * nb;
#pragma unroll
    for (int i = 0; i < 8; ++i) { const int kk = 8 * i + (lane >> 3); const float gsc = (jb.gain ? jb.gain[k0 + kk] : 1.f) * jb.scale;
        const f32x4 v = *(const GAS f32x4*)(jb.src + (size_t)(k0 + kk) * jb.ldw + jb.col0 + n0 + 4 * (lane & 7));
        LAS float* d = scr + kk * 33 + 4 * (lane & 7); d[0] = v[0] * gsc; d[1] = v[1] * gsc; d[2] = v[2] * gsc; d[3] = v[3] * gsc; }
    LDS_WAIT(); asm volatile("" ::: "memory");
    const int c = lane & 7;
#pragma unroll
    for (int j = 0; j < 4; ++j) { const int n = (lane >> 3) + 8 * j; const LAS float* s = scr + (8 * c) * 33 + n;
        u32x4 o; o.x = pk2(s[0 * 33], s[1 * 33]); o.y = pk2(s[2 * 33], s[3 * 33]); o.z = pk2(s[4 * 33], s[5 * 33]); o.w = pk2(s[6 * 33], s[7 * 33]);
        *(GAS u32x4*)(jb.dst + (size_t)rowmap(jb.type, jb.roff, n0 + n) * jb.K + k0 + 8 * c) = o; }
    LDS_WAIT(); asm volatile("" ::: "memory");
}
__device__ __forceinline__ float softcap(float z) { return SOFTCAP * tanhf(z * (1.0f / SOFTCAP)); }
__device__ __forceinline__ void p0_prologue(const Args& A, Frame& F) {
    const int gw = F.vcu * NWAVES + F.wave, NGW = F.G * NWAVES;
    {   LAS float* scr = (LAS float*)(F.lds + RING_OFF + F.wave * 16384);
        for (int it = gw; it < P0_ITEMS; it += NGW) { Job jb; int local; get_job(A, F, it, jb, local); p0_item(jb, local, scr, F.lane); } }
    __syncthreads();
    LAS float* Wg = (LAS float*)(F.lds + RING_OFF);
    for (int i = F.tid; i < DM * 16; i += NWAVES * 64) { const int k = i >> 4, j = i & 15; Wg[i] = A.in[I_WIN][(size_t)k * MPROJ + MPROJ_MAIN + j] * A.in[I_MIXN][k]; }
    __syncthreads();
    bf16* xb = (bf16*)(F.ws + WS_A); float* ss0 = (float*)(F.ws + T_SS0); float* gates = (float*)(F.ws + T_GATES);
    for (int row = gw; row < MTOK; row += NGW) {
        const GAS f32x4* xr = (const GAS f32x4*)(A.in[I_X] + (size_t)row * DM) + F.lane;
        f32x4 v[4]; float s[17];
#pragma unroll
        for (int g = 0; g < 17; ++g) s[g] = 0.f;
#pragma unroll
        for (int j = 0; j < 4; ++j) { v[j] = xr[64 * j]; s[16] += (v[j][0] * v[j][0] + v[j][1] * v[j][1]) + (v[j][2] * v[j][2] + v[j][3] * v[j][3]); }
#pragma unroll
        for (int j = 0; j < 4; ++j)
#pragma unroll
            for (int c = 0; c < 4; ++c) { const LAS f32x4* wp = (const LAS f32x4*)(Wg + (size_t)(4 * F.lane + 256 * j + c) * 16); const float xv = v[j][c];
#pragma unroll
                for (int q = 0; q < 4; ++q) { const f32x4 w = wp[q]; s[4 * q] += xv * w[0]; s[4 * q + 1] += xv * w[1]; s[4 * q + 2] += xv * w[2]; s[4 * q + 3] += xv * w[3]; }
                if (c & 1) asm volatile("" ::: "memory"); }
#pragma unroll
        for (int g = 0; g < 17; ++g) s[g] = wave_sum(s[g]);
        const float rs = rsqrtf(s[16] * (1.0f / DM) + EPS);
        float mine = 0.f;
#pragma unroll
        for (int g = 0; g < 16; ++g) mine = (F.lane == g) ? s[g] : mine;
        if (F.lane < 16) { const int h = F.lane & 7; float z = mine * rs + (F.lane < 8 ? A.in[I_BI][h] : A.in[I_BF][h]); z = softcap(z);
            if (F.lane >= 8) z = -log1pf(expf(-z));
            gates[(size_t)row * 16 + F.lane] = z; }
        if (F.lane == 0) ss0[row] = s[16];
        GAS unsigned long long* o8 = (GAS unsigned long long*)(xb + (size_t)row * DM) + F.lane;
#pragma unroll
        for (int j = 0; j < 4; ++j) o8[64 * j] = (unsigned long long)pk2(v[j][0], v[j][1]) | ((unsigned long long)pk2(v[j][2], v[j][3]) << 32);
    }
}
__device__ __forceinline__ void mlstm_simple(const Args& A, Frame& F) {
    LAS float* Lq = (LAS float*)(F.lds + RING_OFF);
    LAS float* Lk = Lq + 4096;
    LAS float* Lv = Lk + 4096;
    LAS float* Lh = Lv + 8192;
    LAS float* Lg = Lh + 8192;
    const bf16* Q = (const bf16*)(F.ws + B_Q); const bf16* Kk = (const bf16*)(F.ws + B_K); const bf16* VT = (const bf16*)(F.ws + B_VT); const bf16* OG = (const bf16*)(F.ws + B_OG);
    bf16* HN = (bf16*)(F.ws + B_HN); const float* gates = (const float*)(F.ws + T_GATES); const float* gh = A.in[I_GH];
    const int tid = F.tid, v = tid >> 2, qd = tid & 3;
    for (int u = blockIdx.x; u < NBATCH * MH; u += F.G) {
        const int b = u >> 3, h = u & 7;
        float C[16], n[16];
#pragma unroll
        for (int j = 0; j < 16; ++j) { C[j] = 0.f; n[j] = 0.f; }
        for (int c = 0; c < SEQ / 64; ++c) {
            const size_t row0 = (size_t)b * SEQ + c * 64;
            { const int r = tid >> 3, cc = (tid & 7) * 8;
              const u32x4 a = *(const GAS u32x4*)(Q + (row0 + r) * 512 + h * 64 + cc), bb = *(const GAS u32x4*)(Kk + (row0 + r) * 512 + h * 64 + cc);
#pragma unroll
              for (int i = 0; i < 4; ++i) { Lq[r * 64 + cc + 2 * i] = bf2f((unsigned short)(a[i] & 0xffff)); Lq[r * 64 + cc + 2 * i + 1] = bf2f((unsigned short)(a[i] >> 16));
                                            Lk[r * 64 + cc + 2 * i] = bf2f((unsigned short)(bb[i] & 0xffff)); Lk[r * 64 + cc + 2 * i + 1] = bf2f((unsigned short)(bb[i] >> 16)); } }
#pragma unroll
            for (int j = 0; j < 2; ++j) { const int idx = tid + 512 * j, dv = idx >> 3, tc = (idx & 7) * 8; const u32x4 a = *(const GAS u32x4*)(VT + ((size_t)(b * MH + h) * MDV + dv) * SEQ + c * 64 + tc);
#pragma unroll
              for (int i = 0; i < 4; ++i) { Lv[(tc + 2 * i) * 128 + dv] = bf2f((unsigned short)(a[i] & 0xffff)); Lv[(tc + 2 * i + 1) * 128 + dv] = bf2f((unsigned short)(a[i] >> 16)); } }
            if (tid < 64) { Lg[tid * 2] = expf(gates[(row0 + tid) * 16 + h]); Lg[tid * 2 + 1] = expf(gates[(row0 + tid) * 16 + 8 + h]); }
            __syncthreads();
            for (int t = 0; t < 64; ++t) {
                const float ii = Lg[2 * t], ff = Lg[2 * t + 1], vv = Lv[t * 128 + v] * ii;
                float num = 0.f, den = 0.f;
#pragma unroll
                for (int j4 = 0; j4 < 4; ++j4) { const f32x4 k4 = *(const LAS f32x4*)(Lk + t * 64 + 16 * qd + 4 * j4), q4 = *(const LAS f32x4*)(Lq + t * 64 + 16 * qd + 4 * j4);
#pragma unroll
                    for (int j = 0; j < 4; ++j) { const int jj = 4 * j4 + j; C[jj] = ff * C[jj] + vv * k4[j]; n[jj] = ff * n[jj] + ii * k4[j]; num += C[jj] * q4[j]; den += n[jj] * q4[j]; } }
                num += __shfl_xor(num, 1); num += __shfl_xor(num, 2); den += __shfl_xor(den, 1); den += __shfl_xor(den, 2);
                if (qd == 0) Lh[t * 128 + v] = num / fmaxf(fabsf(den), 1.0f);
            }
            __syncthreads();
#pragma unroll 1
            for (int tt = 0; tt < 8; ++tt) { const int t = F.wave * 8 + tt; const float a0 = Lh[t * 128 + F.lane], a1 = Lh[t * 128 + 64 + F.lane];
                const float rinv = rsqrtf(wave_sum(a0 * a0 + a1 * a1) * (1.0f / 128.0f) + EPS);
                const size_t o = (row0 + t) * 1024 + h * 128 + F.lane;
                HN[o] = (bf16)f2bf(a0 * rinv * gh[h * 128 + F.lane] * bf2f(OG[o])); HN[o + 64] = (bf16)f2bf(a1 * rinv * gh[h * 128 + 64 + F.lane] * bf2f(OG[o + 64])); }
            __syncthreads();
        }
    }
}

__device__ __forceinline__ void sb_simple(Frame& F) {
    const bf16* Kb = (const bf16*)(F.ws + B_SBK); const bf16* Vt = (const bf16*)(F.ws + B_SBVT); bf16* QO = (bf16*)(F.ws + B_SBQ);
    const int gw = F.vcu * NWAVES + F.wave, NGW = F.G * NWAVES;
    for (int item = gw; item < NBATCH * SBH * (SEQ / 64); item += NGW) {
        const int bh = item >> 6, tb = item & 63, b = bh >> 4, h = bh & 15, t = tb * 64 + F.lane; const size_t row = (size_t)b * SEQ + t;
        float q[64], o[64];
#pragma unroll
        for (int c = 0; c < 8; ++c) { const u32x4 a = *(const GAS u32x4*)(QO + row * 1024 + h * 64 + 8 * c);
#pragma unroll
            for (int i = 0; i < 4; ++i) { q[8 * c + 2 * i] = bf2f((unsigned short)(a[i] & 0xffff)); q[8 * c + 2 * i + 1] = bf2f((unsigned short)(a[i] >> 16)); } }
#pragma unroll
        for (int d = 0; d < 64; ++d) o[d] = 0.f;
        float carry = 0.f;
        for (int s8 = tb * 64 + 56; s8 >= 0; s8 -= 8) {
            float aa[8];
#pragma unroll
            for (int kk = 7; kk >= 0; --kk) { const int s = s8 + kk; const GAS u32x4* kr = (const GAS u32x4*)(Kb + ((size_t)b * SEQ + s) * 1024 + h * 64);
                float z = 0.f;
#pragma unroll
                for (int c = 0; c < 8; ++c) { const u32x4 a = kr[c];
#pragma unroll
                    for (int i = 0; i < 4; ++i) { z += q[8 * c + 2 * i] * bf2f((unsigned short)(a[i] & 0xffff)); z += q[8 * c + 2 * i + 1] * bf2f((unsigned short)(a[i] >> 16)); } }
                const bool valid = s < t; const float l1p = log2f(1.0f + exp2f(z));
                aa[kk] = valid ? exp2f(z - l1p + carry) : 0.f; carry += valid ? -l1p : 0.f; }
#pragma unroll
            for (int d = 0; d < 64; ++d) { const u32x4 a = *(const GAS u32x4*)(Vt + ((size_t)bh * 64 + d) * SEQ + s8); float acc = o[d];
#pragma unroll
                for (int i = 0; i < 4; ++i) { acc += aa[2 * i] * bf2f((unsigned short)(a[i] & 0xffff)); acc += aa[2 * i + 1] * bf2f((unsigned short)(a[i] >> 16)); }
                o[d] = acc; }
        }
#pragma unroll
        for (int c = 0; c < 8; ++c) { u32x4 w; w.x = pk2(o[8 * c], o[8 * c + 1]); w.y = pk2(o[8 * c + 2], o[8 * c + 3]); w.z = pk2(o[8 * c + 4], o[8 * c + 5]); w.w = pk2(o[8 * c + 6], o[8 * c + 7]);
            *(GAS u32x4*)(QO + row * 1024 + h * 64 + 8 * c) = w; }
    }
}

__device__ __forceinline__ void router_phase(const Args& A, Frame& F) {
    LAS float* Wr = (LAS float*)(F.lds + RING_OFF);
    LAS int* hist = (LAS int*)(F.lds + RING_OFF + 32768);
    for (int i = F.tid; i < DM * NEXP; i += NWAVES * 64) Wr[i] = A.in[I_WR][i] * A.in[I_FFNN][DM + (i >> 3)];
    if (F.tid < NEXP) hist[F.tid] = 0;
    __syncthreads();
    int* sele = (int*)(F.ws + T_SELE); float* selw1 = (float*)(F.ws + T_SELW1); float* selw2 = (float*)(F.ws + T_SELW2); float* selrs = (float*)(F.ws + T_SELRS);
    const int TPW = MTOK / F.G;
    for (int i = F.wave; i < TPW; i += NWAVES) {
        const int tok = blockIdx.x * TPW + i;
        const GAS f32x4* xr = (const GAS f32x4*)(F.out + (size_t)tok * DM) + F.lane;
        float s[9];
#pragma unroll
        for (int g = 0; g < 9; ++g) s[g] = 0.f;
#pragma unroll
        for (int j = 0; j < 4; ++j) { const f32x4 v = xr[64 * j]; s[8] += (v[0] * v[0] + v[1] * v[1]) + (v[2] * v[2] + v[3] * v[3]);
#pragma unroll
            for (int c = 0; c < 4; ++c) { const LAS f32x4* wp = (const LAS f32x4*)(Wr + (size_t)(4 * F.lane + 256 * j + c) * 8); const f32x4 w0 = wp[0], w1 = wp[1]; const float xv = v[c];
                s[0] += xv * w0[0]; s[1] += xv * w0[1]; s[2] += xv * w0[2]; s[3] += xv * w0[3]; s[4] += xv * w1[0]; s[5] += xv * w1[1]; s[6] += xv * w1[2]; s[7] += xv * w1[3]; } }
#pragma unroll
        for (int g = 0; g < 9; ++g) s[g] = wave_sum(s[g]);
        const float rs = rsqrtf(s[8] * (1.0f / DM) + EPS);
        float b1 = s[0]; int i1 = 0;
#pragma unroll
        for (int e = 1; e < 8; ++e) if (s[e] > b1) { b1 = s[e]; i1 = e; }
        float b2 = -3.0e38f; int i2 = 0;
#pragma unroll
        for (int e = 0; e < 8; ++e) if (e != i1 && s[e] > b2) { b2 = s[e]; i2 = e; }
        const float w1 = 1.0f / (1.0f + expf((b2 - b1) * rs)), w2 = 1.0f - w1;
        if (F.lane == 0) { sele[tok] = i1 | (i2 << 8); selw1[tok] = w1; selw2[tok] = w2; selrs[tok] = rs; __hip_atomic_fetch_add(hist + i1, 1, __ATOMIC_RELAXED, __HIP_MEMORY_SCOPE_WORKGROUP); __hip_atomic_fetch_add(hist + i2, 1, __ATOMIC_RELAXED, __HIP_MEMORY_SCOPE_WORKGROUP); }
    }
    __syncthreads();
    if (F.tid < NEXP) ((int*)(F.ctl + CW_CNT))[blockIdx.x * NEXP + F.tid] = hist[F.tid];
}
__device__ __forceinline__ void slots_phase(Frame& F) {
    LAS int* cn = (LAS int*)(F.lds + RING_OFF);
    LAS int* tot = cn + 2048; LAS int* pre = tot + 8; LAS int* sst = pre + 8; LAS int* tst = sst + 8; LAS int* ntl = tst + 8; LAS int* le = ntl + 16;
    const int TPW = MTOK / F.G; const int w = blockIdx.x;
    for (int i = F.tid; i < F.G * NEXP; i += NWAVES * 64) cn[i] = ((const int*)(F.ctl + CW_CNT))[i];
    __syncthreads();
    if (F.tid < NEXP) { int t = 0, p = 0; for (int ww = 0; ww < F.G; ++ww) { const int c = cn[ww * NEXP + F.tid]; t += c; if (ww < w) p += c; } tot[F.tid] = t; pre[F.tid] = p; }
    __syncthreads();
    if (F.tid == 0) { int ts = 0; for (int e = 0; e < NEXP; ++e) { const int nt = (tot[e] + 255) >> 8; tst[e] = ts; sst[e] = ts * 256; ntl[e] = nt; ts += nt; } ntl[8] = ts; }
    const int* sele = (const int*)(F.ws + T_SELE); const float* selw1 = (const float*)(F.ws + T_SELW1); const float* selw2 = (const float*)(F.ws + T_SELW2); const float* selrs = (const float*)(F.ws + T_SELRS);
    int* slt = (int*)(F.ws + T_SLOT);
#define SL_TOK(s) slt[((s) >> 8) * 1024 + ((s) & 255)]
#define SL_RS(s) ((float*)slt)[((s) >> 8) * 1024 + 256 + ((s) & 255)]
#define SL_W(s) ((float*)slt)[((s) >> 8) * 1024 + 512 + ((s) & 255)]
#define SL_YROW(s) slt[((s) >> 8) * 1024 + 768 + ((s) & 255)]
    if (F.tid < TPW) le[F.tid] = sele[w * TPW + F.tid];
    __syncthreads();
    if (F.tid < 2 * TPW) { const int tl = F.tid >> 1, j = F.tid & 1, mine = le[tl], e = j ? (mine >> 8) : (mine & 255); int rank = 0;
        for (int t2 = 0; t2 < tl; ++t2) { const int o = le[t2]; rank += ((o & 255) == e || (o >> 8) == e) ? 1 : 0; }
        const int slot = sst[e] + pre[e] + rank, token = w * TPW + tl;
        SL_TOK(slot) = token; SL_YROW(slot) = 2 * token + j; SL_RS(slot) = selrs[token]; SL_W(slot) = j ? selw2[token] : selw1[token]; }
    if (w < NEXP) { const int e = w, lo = sst[e] + tot[e], hi = sst[e] + 256 * ntl[e]; for (int s = lo + F.tid; s < hi; s += NWAVES * 64) { SL_TOK(s) = 0; SL_YROW(s) = -1; SL_RS(s) = 0.f; SL_W(s) = 0.f; } }
    if (w == 0) { if (F.tid == 0) ((int*)(F.ctl + CW_MOE))[0] = ntl[8];
        for (int e = 0; e < NEXP; ++e) for (int t = F.tid; t < ntl[e]; t += NWAVES * 64) ((int*)(F.ctl + CW_TEXP))[tst[e] + t] = e; }
}
__device__ __forceinline__ void combine_phase(Frame& F) {
    const bf16* x3b = (const bf16*)(F.ws + WS_A);
    const int gw = F.vcu * NWAVES + F.wave, NGW = F.G * NWAVES;
    for (int tokn = gw; tokn < MTOK; tokn += NGW) {
        const GAS u32x4* yp = (const GAS u32x4*)((const unsigned char*)F.out + (size_t)tokn * 4096); const GAS u32x4* xp = (const GAS u32x4*)(x3b + (size_t)tokn * DM);
        u32x4 y0[2], y1[2], xx[2];
#pragma unroll
        for (int p = 0; p < 2; ++p) { y0[p] = yp[64 * p + F.lane]; y1[p] = yp[128 + 64 * p + F.lane]; xx[p] = xp[64 * p + F.lane]; }
        asm volatile("s_waitcnt vmcnt(0)" ::: "memory");
        GAS f32x4* op = (GAS f32x4*)((unsigned char*)F.out + (size_t)tokn * 4096);
#pragma unroll
        for (int p = 0; p < 2; ++p) { f32x4 r0, r1;
#pragma unroll
            for (int i = 0; i < 2; ++i) { r0[2 * i] = bf2f((unsigned short)(xx[p][i] & 0xffff)) + bf2f((unsigned short)(y0[p][i] & 0xffff)) + bf2f((unsigned short)(y1[p][i] & 0xffff));
                r0[2 * i + 1] = bf2f((unsigned short)(xx[p][i] >> 16)) + bf2f((unsigned short)(y0[p][i] >> 16)) + bf2f((unsigned short)(y1[p][i] >> 16));
                r1[2 * i] = bf2f((unsigned short)(xx[p][i + 2] & 0xffff)) + bf2f((unsigned short)(y0[p][i + 2] & 0xffff)) + bf2f((unsigned short)(y1[p][i + 2] & 0xffff));
                r1[2 * i + 1] = bf2f((unsigned short)(xx[p][i + 2] >> 16)) + bf2f((unsigned short)(y0[p][i + 2] >> 16)) + bf2f((unsigned short)(y1[p][i + 2] >> 16)); }
            op[128 * p + 2 * F.lane] = r0; op[128 * p + 2 * F.lane + 1] = r1; }
    }
}
typedef __bf16 bf16x2_t __attribute__((ext_vector_type(2)));
__device__ __forceinline__ unsigned cvtpk(float lo, float hi) { f32x2 v = {lo, hi}; return __builtin_bit_cast(unsigned, __builtin_convertvector(v, bf16x2_t)); }
__device__ __forceinline__ void sb_fast(Frame& F) {
    const bf16* Kb = (const bf16*)(F.ws + B_SBK); const bf16* Vt = (const bf16*)(F.ws + B_SBVT); bf16* QO = (bf16*)(F.ws + B_SBQ);
    const int lane = F.lane, c = lane & 31, h = lane >> 5;
    const int pic = (c & 16) + ((c >> 2) & 1) * 8 + ((c >> 3) & 1) * 4 + (c & 3);
    for (int chunk = F.vcu; chunk < NBATCH * SBH * (SEQ / 32) / NWAVES; chunk += F.G) {
        const int item = chunk * NWAVES + F.wave, bh = item >> 7, qb = item & 127, b = bh >> 4, hd = bh & 15, t0 = qb * 32;
        bf16* qp = QO + ((size_t)(b * SEQ + t0 + c) * 1024 + hd * 64 + 8 * h);
        bf16x8 qf[4];
#pragma unroll
        for (int ks = 0; ks < 4; ++ks) qf[ks] = *(const GAS bf16x8*)(qp + 16 * ks);
        f32x16 O0, O1;
#pragma unroll
        for (int i = 0; i < 16; ++i) { O0[i] = 0.f; O1[i] = 0.f; }
        float carry = 1.0f;
        const bf16* kbase = Kb + ((size_t)(b * SEQ + pic) * 1024 + hd * 64 + 8 * h);
        const bf16* vbase = Vt + ((size_t)(bh * 64 + c) * SEQ + 8 * h);
        bf16x8 kf[4], vf[4];
#define SB_LOAD(KF, VF, KB) do { const bf16* _k = kbase + (size_t)(KB) * 32 * 1024; const bf16* _v = vbase + (KB) * 32; \
            _Pragma("unroll") for (int ks = 0; ks < 4; ++ks) KF[ks] = *(const GAS bf16x8*)(_k + 16 * ks); \
            _Pragma("unroll") for (int dt = 0; dt < 2; ++dt) _Pragma("unroll") for (int s = 0; s < 2; ++s) VF[dt * 2 + s] = *(const GAS bf16x8*)(_v + (size_t)dt * 32 * SEQ + 16 * s); } while (0)
        int kb = qb;
        SB_LOAD(kf, vf, kb);
        for (;;) {
            bf16x8 kn[4], vn[4];
#pragma unroll
            for (int i = 0; i < 4; ++i) { kn[i] = kf[i]; vn[i] = vf[i]; }
            if (kb > 0) SB_LOAD(kn, vn, kb - 1);
            f32x16 X;
#pragma unroll
            for (int i = 0; i < 16; ++i) X[i] = 0.f;
#pragma unroll
            for (int ks = 0; ks < 4; ++ks) X = __builtin_amdgcn_mfma_f32_32x32x16_bf16(kf[ks], qf[ks], X, 0, 0, 0);
            float e[16], r[16];
#pragma unroll
            for (int i = 0; i < 16; ++i) e[i] = __builtin_amdgcn_exp2f(X[i]);
            if (kb == qb) {
#pragma unroll
                for (int i = 0; i < 16; ++i) { const int ko = 16 * (i >> 3) + 8 * h + (i & 7); e[i] = ko < c ? e[i] : 0.f; } }
#pragma unroll
            for (int i = 0; i < 16; ++i) r[i] = __builtin_amdgcn_rcpf(1.0f + e[i]);
            float EA[8], EB[8]; EA[7] = 1.0f; EB[7] = 1.0f;
#pragma unroll
            for (int i = 6; i >= 0; --i) { EA[i] = EA[i + 1] * r[i + 1]; EB[i] = EB[i + 1] * r[8 + i + 1]; }
            const float GA = EA[0] * r[0], GB = EB[0] * r[8];
            const float pGA = __shfl_xor(GA, 32), pGB = __shfl_xor(GB, 32);
            const float TB = h ? carry : carry * pGB;
            const float TA = (carry * pGB) * GB * (h ? 1.0f : pGA);
            carry = ((carry * GA) * GB) * (pGA * pGB);
            float a[16];
#pragma unroll
            for (int i = 0; i < 8; ++i) { a[i] = (EA[i] * TA) * (e[i] * r[i]); a[8 + i] = (EB[i] * TB) * (e[8 + i] * r[8 + i]); }
            u32x4 p0, p1;
            p0.x = cvtpk(a[0], a[1]); p0.y = cvtpk(a[2], a[3]); p0.z = cvtpk(a[4], a[5]); p0.w = cvtpk(a[6], a[7]);
            p1.x = cvtpk(a[8], a[9]); p1.y = cvtpk(a[10], a[11]); p1.z = cvtpk(a[12], a[13]); p1.w = cvtpk(a[14], a[15]);
            const bf16x8 af0 = __builtin_bit_cast(bf16x8, p0), af1 = __builtin_bit_cast(bf16x8, p1);
            O0 = __builtin_amdgcn_mfma_f32_32x32x16_bf16(vf[0], af0, O0, 0, 0, 0); O0 = __builtin_amdgcn_mfma_f32_32x32x16_bf16(vf[1], af1, O0, 0, 0, 0);
            O1 = __builtin_amdgcn_mfma_f32_32x32x16_bf16(vf[2], af0, O1, 0, 0, 0); O1 = __builtin_amdgcn_mfma_f32_32x32x16_bf16(vf[3], af1, O1, 0, 0, 0);
            if (kb == 0) break;
            if (!__any(carry >= 1.17549435e-38f)) break;
            --kb;
#pragma unroll
            for (int i = 0; i < 4; ++i) { kf[i] = kn[i]; vf[i] = vn[i]; }
        }
#undef SB_LOAD
#pragma unroll
        for (int g = 0; g < 4; ++g) {
            u32x2 w0, w1; w0.x = cvtpk(O0[4 * g], O0[4 * g + 1]); w0.y = cvtpk(O0[4 * g + 2], O0[4 * g + 3]); w1.x = cvtpk(O1[4 * g], O1[4 * g + 1]); w1.y = cvtpk(O1[4 * g + 2], O1[4 * g + 3]);
            *(GAS u32x2*)(qp - 8 * h + 8 * g + 4 * h) = w0; *(GAS u32x2*)(qp - 8 * h + 32 + 8 * g + 4 * h) = w1; }
    }
}
constexpr int ML_SEG0 = 0, ML_SEG1 = 19, ML_SEG2 = 36, ML_SEG3 = 51, ML_SEG4 = 64;
constexpr int ML_U = 0, ML_MM = 16384, ML_NB = 32768, ML_OM = 49152, ML_MC = 65536, ML_MS = 65792, ML_BL = 66048, ML_UX = 66304, ML_P = 66560, ML_QW = ML_P + 2 * 9216, ML_DEN = ML_QW + 2 * 9216, ML_SS = ML_DEN + 512, ML_END = ML_SS + 4096;
static_assert(ML_END <= RING_BYTES, "mLSTM LDS map");
__device__ __forceinline__ bf16x8 pack_frag(const f32x4 a, const f32x4 b) { u32x4 w; w.x = cvtpk(a[0], a[1]); w.y = cvtpk(a[2], a[3]); w.z = cvtpk(b[0], b[1]); w.w = cvtpk(b[2], b[3]); return __builtin_bit_cast(bf16x8, w); }
__device__ __forceinline__ bf16x8 scale_frag(const bf16x8 v, const f32x4 w0, const f32x4 w1) {
    const u32x4 x = __builtin_bit_cast(u32x4, v); f32x4 a, b;
    a[0] = __builtin_bit_cast(float, x[0] << 16) * w0[0]; a[1] = __builtin_bit_cast(float, x[0] & 0xffff0000u) * w0[1]; a[2] = __builtin_bit_cast(float, x[1] << 16) * w0[2]; a[3] = __builtin_bit_cast(float, x[1] & 0xffff0000u) * w0[3];
    b[0] = __builtin_bit_cast(float, x[2] << 16) * w1[0]; b[1] = __builtin_bit_cast(float, x[2] & 0xffff0000u) * w1[1]; b[2] = __builtin_bit_cast(float, x[3] << 16) * w1[2]; b[3] = __builtin_bit_cast(float, x[3] & 0xffff0000u) * w1[3];
    return pack_frag(a, b);
}
#define ML_MFMA(a, b, c) __builtin_amdgcn_mfma_f32_16x16x32_bf16((a), (b), (c), 0, 0, 0)
__device__ __forceinline__ void mlstm_fast(const Args& A, Frame& F) {
    LAS unsigned char* L = F.lds + RING_OFF;
    const bf16* Qm = (const bf16*)(F.ws + B_Q); const bf16* Km = (const bf16*)(F.ws + B_K); const bf16* KT = (const bf16*)F.out; const bf16* VT = (const bf16*)(F.ws + B_VT);
    const bf16* OG = (const bf16*)(F.ws + B_OG); bf16* HN = (bf16*)(F.ws + B_HN); const float* gates = (const float*)(F.ws + T_GATES);
    const int tid = F.tid, lane = F.lane, w = F.wave, c = lane & 15, q4 = lane >> 4;
    for (int unit = blockIdx.x; unit < NBATCH * MH * 4; unit += F.G) {
        const int bh = unit >> 2, seg = unit & 3, b = bh >> 3, h = bh & 7;
        const int c_full = seg == 0 ? ML_SEG0 : seg == 1 ? ML_SEG1 : seg == 2 ? ML_SEG2 : ML_SEG3, c_end = seg == 0 ? ML_SEG1 : seg == 1 ? ML_SEG2 : seg == 2 ? ML_SEG3 : ML_SEG4;
        const size_t rowb = (size_t)b * SEQ;
        __syncthreads();
        for (int cc = w; cc < c_end; cc += NWAVES) {
            const size_t row = rowb + cc * 64 + lane;
            const float ig2 = gates[row * 16 + h] * LOG2E, lf2 = gates[row * 16 + 8 + h] * LOG2E;
            float bb = lf2;
#pragma unroll
            for (int o = 1; o < 64; o <<= 1) { const float t = __shfl_up(bb, o); if (lane >= o) bb += t; }
            const float u = ig2 - bb; float pm = u;
#pragma unroll
            for (int o = 1; o < 64; o <<= 1) { const float t = __shfl_up(pm, o); if (lane >= o) pm = fmaxf(pm, t); }
            ((LAS float*)(L + ML_U))[cc * 64 + lane] = u; ((LAS float*)(L + ML_MM))[cc * 64 + lane] = pm; ((LAS float*)(L + ML_NB))[cc * 64 + lane] = -bb;
            if (lane == 63) { ((LAS float*)(L + ML_BL))[cc] = bb; ((LAS float*)(L + ML_UX))[cc] = pm; }
        }
        __syncthreads();
        if (tid == 0) { float m = -__builtin_inff(); for (int cc = 0; cc < c_end; ++cc) { ((LAS float*)(L + ML_MC))[cc] = m; const float ms = fmaxf(m, ((LAS float*)(L + ML_UX))[cc]); ((LAS float*)(L + ML_MS))[cc] = ms; m = ((LAS float*)(L + ML_BL))[cc] + ms; } }
        __syncthreads();
        for (int cc = w; cc < c_end; cc += NWAVES) {
            const float mc = ((LAS float*)(L + ML_MC))[cc], ms = ((LAS float*)(L + ML_MS))[cc];
            const float u = ((LAS float*)(L + ML_U))[cc * 64 + lane], mm = fmaxf(mc, ((LAS float*)(L + ML_MM))[cc * 64 + lane]);
            ((LAS float*)(L + ML_MM))[cc * 64 + lane] = mm; ((LAS float*)(L + ML_NB))[cc * 64 + lane] += -mm; ((LAS float*)(L + ML_OM))[cc * 64 + lane] = __builtin_amdgcn_exp2f(u - ms);
        }
        __syncthreads();
        f32x4 Ct[4], Cn[4];
#pragma unroll
        for (int i = 0; i < 4; ++i) { Ct[i] = (f32x4){0.f, 0.f, 0.f, 0.f}; Cn[i] = (f32x4){0.f, 0.f, 0.f, 0.f}; }
        const bf16* ktp = KT + ((size_t)(bh * MDK + c) * SEQ + rowb * 0 + 8 * q4);
        const bf16* vtp = VT + ((size_t)(bh * MDV + 16 * w + c) * SEQ + 8 * q4);
        const bf16x8 onesf = __builtin_bit_cast(bf16x8, (u32x4){0x3f803f80u, 0x3f803f80u, 0x3f803f80u, 0x3f803f80u});
        const bf16x8 zerof = __builtin_bit_cast(bf16x8, (u32x4){0u, 0u, 0u, 0u});
        bf16x8 kt[4][2], vt[2];
#define ML_LOADKV(KT_, VT_, CC) do { const int _t0 = (CC) * 64; _Pragma("unroll") for (int i = 0; i < 4; ++i) _Pragma("unroll") for (int ks = 0; ks < 2; ++ks) KT_[i][ks] = *(const GAS bf16x8*)(ktp + (size_t)16 * i * SEQ + _t0 + 32 * ks); \
            _Pragma("unroll") for (int ks = 0; ks < 2; ++ks) VT_[ks] = *(const GAS bf16x8*)(vtp + _t0 + 32 * ks); } while (0)
        ML_LOADKV(kt, vt, 0);
        for (int cc = 0; cc < c_end; ++cc) {
            const int par = cc & 1, t0 = cc * 64; const bool full = cc >= c_full;
            bf16x8 ktn[4][2], vtn[2];
#pragma unroll
            for (int i = 0; i < 4; ++i) { ktn[i][0] = kt[i][0]; ktn[i][1] = kt[i][1]; }
            vtn[0] = vt[0]; vtn[1] = vt[1];
            if (cc + 1 < c_end) ML_LOADKV(ktn, vtn, cc + 1);
            const float mc = ((LAS float*)(L + ML_MC))[cc], ms = ((LAS float*)(L + ML_MS))[cc];
            const float adec = __builtin_amdgcn_exp2f(mc - ms);
            LAS unsigned char* Pb = L + ML_P + par * 9216; LAS unsigned char* Qb = L + ML_QW + par * 9216;
            bf16x8 cf[2], cnf[2];
            if (full) {
#pragma unroll
                for (int ks = 0; ks < 2; ++ks) { cf[ks] = pack_frag(Ct[2 * ks], Ct[2 * ks + 1]); cnf[ks] = pack_frag(Cn[2 * ks], Cn[2 * ks + 1]); }
                { const int t = tid >> 3, ch = tid & 7; const u32x4 qv = *(const GAS u32x4*)(Qm + (rowb + t0 + t) * 512 + h * 64 + 8 * ch);
                  const float wi = __builtin_amdgcn_exp2f(mc - ((LAS float*)(L + ML_MM))[cc * 64 + t]); const f32x4 w4 = (f32x4){wi, wi, wi, wi};
                  *(LAS bf16x8*)(Qb + t * 144 + ch * 16) = scale_frag(__builtin_bit_cast(bf16x8, qv), w4, w4); }
                { const int tt = w & 3, sh = w >> 2;
                  if (2 * sh <= tt) {
                    bf16x8 qf[2];
#pragma unroll
                    for (int ks = 0; ks < 2; ++ks) qf[ks] = *(const GAS bf16x8*)(Qm + (rowb + t0 + 16 * tt + c) * 512 + h * 64 + 32 * ks + 8 * q4);
                    const float mmt = ((LAS float*)(L + ML_MM))[cc * 64 + 16 * tt + c];
#pragma unroll
                    for (int s2 = 0; s2 < 2; ++s2) { const int st = 2 * sh + s2; u32x2 pw = (u32x2){0u, 0u};
                        if (st <= tt) {
                            f32x4 sT = (f32x4){0.f, 0.f, 0.f, 0.f};
#pragma unroll
                            for (int ks = 0; ks < 2; ++ks) { const bf16x8 kf = *(const GAS bf16x8*)(Km + (rowb + t0 + 16 * st + c) * 512 + h * 64 + 32 * ks + 8 * q4); sT = ML_MFMA(kf, qf[ks], sT); }
                            const f32x4 u4 = *(const LAS f32x4*)(L + ML_U + (cc * 64 + 16 * st + 4 * q4) * 4); f32x4 p;
#pragma unroll
                            for (int r = 0; r < 4; ++r) { const bool ok = (16 * st + 4 * q4 + r) <= (16 * tt + c); p[r] = ok ? sT[r] * __builtin_amdgcn_exp2f(u4[r] - mmt) : 0.f; }
                            pw.x = cvtpk(p[0], p[1]); pw.y = cvtpk(p[2], p[3]); }
                        *(LAS u32x2*)(Pb + (16 * tt + c) * 144 + (16 * st + 4 * q4) * 2) = pw; } } }
            }
            bf16x8 vw[2], ow[2];
#pragma unroll
            for (int ks = 0; ks < 2; ++ks) { const f32x4 o0 = *(const LAS f32x4*)(L + ML_OM + (cc * 64 + 32 * ks + 8 * q4) * 4), o1 = *(const LAS f32x4*)(L + ML_OM + (cc * 64 + 32 * ks + 8 * q4 + 4) * 4);
                vw[ks] = scale_frag(vt[ks], o0, o1); ow[ks] = (c == 0) ? pack_frag(o0, o1) : zerof; }
#pragma unroll
            for (int i = 0; i < 4; ++i) { Ct[i] = Ct[i] * adec; Ct[i] = ML_MFMA(kt[i][0], vw[0], Ct[i]); Ct[i] = ML_MFMA(kt[i][1], vw[1], Ct[i]); }
            if (w == 4) {
#pragma unroll
                for (int i = 0; i < 4; ++i) { Cn[i] = Cn[i] * adec; Cn[i] = ML_MFMA(kt[i][0], ow[0], Cn[i]); Cn[i] = ML_MFMA(kt[i][1], ow[1], Cn[i]); } }
            if (full) {
                asm volatile("s_waitcnt lgkmcnt(0)" ::: "memory"); __syncthreads();
                f32x4 nT[4], dT[4];
#pragma unroll
                for (int tt = 0; tt < 4; ++tt) { nT[tt] = (f32x4){0.f, 0.f, 0.f, 0.f}; dT[tt] = (f32x4){0.f, 0.f, 0.f, 0.f}; }
#pragma unroll
                for (int tt = 0; tt < 4; ++tt) {
#pragma unroll
                    for (int ks = 0; ks < 2; ++ks) {
                        if (ks == 0 || tt >= 2) { const bf16x8 pf = *(const LAS bf16x8*)(Pb + (16 * tt + c) * 144 + (32 * ks + 8 * q4) * 2);
                            nT[tt] = ML_MFMA(vt[ks], pf, nT[tt]); if (w == 4) dT[tt] = ML_MFMA(c == 0 ? onesf : zerof, pf, dT[tt]); }
                        const u32x2 qa = *(const LAS u32x2*)(Qb + (16 * tt + c) * 144 + (32 * ks + 4 * q4) * 2), qb2 = *(const LAS u32x2*)(Qb + (16 * tt + c) * 144 + (32 * ks + 16 + 4 * q4) * 2);
                        const bf16x8 qwf = __builtin_bit_cast(bf16x8, (u32x4){qa.x, qa.y, qb2.x, qb2.y});
                        nT[tt] = ML_MFMA(cf[ks], qwf, nT[tt]); if (w == 4) dT[tt] = ML_MFMA(cnf[ks], qwf, dT[tt]); } }
                LAS float* DEN = (LAS float*)(L + ML_DEN) + par * 64; LAS float* SS = (LAS float*)(L + ML_SS) + par * 512;
#pragma unroll
                for (int tt = 0; tt < 4; ++tt) { float s = (nT[tt][0] * nT[tt][0] + nT[tt][1] * nT[tt][1]) + (nT[tt][2] * nT[tt][2] + nT[tt][3] * nT[tt][3]); s += __shfl_xor(s, 16); s += __shfl_xor(s, 32);
                    if (q4 == 0) { SS[(16 * tt + c) * 8 + w] = s; if (w == 4) DEN[16 * tt + c] = dT[tt][0]; } }
                asm volatile("s_waitcnt lgkmcnt(0)" ::: "memory"); __syncthreads();
                const f32x4 gh4 = *(const GAS f32x4*)(A.in[I_GH] + h * MDV + 16 * w + 4 * q4);
#pragma unroll
                for (int tt = 0; tt < 4; ++tt) { const int t = 16 * tt + c; const f32x4 s0 = *(const LAS f32x4*)(SS + t * 8), s1 = *(const LAS f32x4*)(SS + t * 8 + 4);
                    const float ssn = ((s0[0] + s0[1]) + (s0[2] + s0[3])) + ((s1[0] + s1[1]) + (s1[2] + s1[3]));
                    const float dn = fmaxf(fabsf(DEN[t]), __builtin_amdgcn_exp2f(((LAS float*)(L + ML_NB))[cc * 64 + t]));
                    const float rinv = rsqrtf(ssn * (1.0f / MDV) + EPS * dn * dn);
                    const size_t o = (rowb + t0 + t) * 1024 + h * MDV + 16 * w + 4 * q4; const u32x2 sg = *(const GAS u32x2*)(OG + o);
                    const float o0 = nT[tt][0] * rinv * gh4[0] * __builtin_bit_cast(float, sg.x << 16), o1 = nT[tt][1] * rinv * gh4[1] * __builtin_bit_cast(float, sg.x & 0xffff0000u);
                    const float o2 = nT[tt][2] * rinv * gh4[2] * __builtin_bit_cast(float, sg.y << 16), o3 = nT[tt][3] * rinv * gh4[3] * __builtin_bit_cast(float, sg.y & 0xffff0000u);
                    *(GAS u32x2*)(HN + o) = (u32x2){cvtpk(o0, o1), cvtpk(o2, o3)}; }
            }
#pragma unroll
            for (int i = 0; i < 4; ++i) { kt[i][0] = ktn[i][0]; kt[i][1] = ktn[i][1]; }
            vt[0] = vtn[0]; vt[1] = vtn[1];
        }
#undef ML_LOADKV
    }
}
constexpr int N_PHASES = 16;
__device__ __forceinline__ void mkframe(const Args& args, Frame& F, LAS unsigned char* lds) {
    F.lds = lds; F.MISC = (volatile LAS unsigned*)(lds + MISC_OFF);
    { int t_ = threadIdx.x; asm volatile("" : "+v"(t_)); F.tid = t_; } F.lane = F.tid & 63; F.wave = __builtin_amdgcn_readfirstlane(F.tid >> 6);
    F.G = gridDim.x; { const int bx = blockIdx.x; F.vcu = (F.G % 8 == 0) ? (bx % 8) * (F.G / 8) + bx / 8 : bx; }
    unsigned char* ws = args.ws; float* out = args.out; asm volatile("" : "+s"(ws), "+s"(out));
    F.ws = ws; F.out = out; F.ctl = (unsigned*)(ws + WS_CTL);
}
__device__ __forceinline__ void grid_barrier(const Args& args, LAS unsigned char* lds) {
    unsigned char* ws = args.ws; asm volatile("" : "+s"(ws));
    XcdBarrier bar; bar.bar = (unsigned*)(ws + WS_CTL) + CW_BAR; bar.x = xb_xcc_id(); bar.st = (volatile LAS unsigned*)(lds + MISC_OFF) + 8;
    xcd_barrier(bar);
}
#ifndef PHASE_MASK
#define PHASE_MASK 0xffff
#endif
template <int LO, int HI>
__global__ void __launch_bounds__(NWAVES * 64, 2) fwd_kernel(Args args) {
    extern __shared__ __attribute__((aligned(16))) unsigned char lds_raw[];
    LAS unsigned char* lds = (LAS unsigned char*)lds_raw;
    for (int u = threadIdx.x; u < (LDS_BYTES - AUX_OFF) / 4; u += NWAVES * 64) ((LAS unsigned*)(lds + AUX_OFF))[u] = 0u;
    __syncthreads();
    if constexpr (HI - LO > 1) { unsigned char* ws = args.ws; (void)xcd_barrier_post((unsigned*)(ws + WS_CTL) + CW_BAR, (volatile LAS unsigned*)(lds + MISC_OFF) + 8); }
#define IN(k) (((PHASE_MASK >> (k)) & 1) && LO <= (k) && (k) < HI)
#define SEAM(k) do { if constexpr (IN(k) && IN((k) + 1)) grid_barrier(args, lds); } while (0)
#define RING (F.lds + RING_OFF)
#define AUXB (F.lds + AUX_OFF)
#define RED ((LAS float*)(F.lds + RED_OFF))
#define SSP ((float*)(F.ws + T_SSP))
#define XBUF ((bf16*)(F.ws + WS_A))
    if constexpr (IN(0)) { Frame F; mkframe(args, F, lds); p0_prologue(args, F); } SEAM(0);
    if constexpr (IN(1)) {
        Frame F; mkframe(args, F, lds);
        pg8::Gemm g{XBUF, (const bf16*)(F.ws + WS_WIN), DM}; pg8::StaticOrder S; S.init(MTOK, MPROJ_MAIN, F.G, (int)blockIdx.x);
        pg8::EpiProj E{(bf16*)(F.ws + B_Q), (bf16*)(F.ws + B_K), (bf16*)F.out, (bf16*)(F.ws + B_VT), (bf16*)(F.ws + B_OG), (const float*)(F.ws + T_SS0)};
        pg8::gemm_phase<pg8::EpiProj, pg8::StaticOrder, false>(RING, AUXB, g, S, E);
    } SEAM(1);
    #ifndef ML_SIMPLE
#define ML_SIMPLE 0
#endif
    if constexpr (IN(2)) { Frame F; mkframe(args, F, lds); if constexpr (ML_SIMPLE) mlstm_simple(args, F); else mlstm_fast(args, F); } SEAM(2);
    if constexpr (IN(3)) {
        Frame F; mkframe(args, F, lds);
        pg8::Gemm g{(const bf16*)(F.ws + B_HN), (const bf16*)(F.ws + WS_WOUT), DM}; pg8::StaticOrder S; S.init(MTOK, DM, F.G, (int)blockIdx.x);
        pg8::EpiRes E{args.in[I_X], F.out, XBUF, SSP, RED};
        pg8::gemm_phase<pg8::EpiRes, pg8::StaticOrder, false>(RING, AUXB, g, S, E);
    } SEAM(3);
    if constexpr (IN(4)) {
        Frame F; mkframe(args, F, lds);
        pg8::Gemm g{XBUF, (const bf16*)(F.ws + WS_WGU), DM}; pg8::StaticOrder S; S.init(MTOK, 2 * FFN, F.G, (int)blockIdx.x);
        pg8::EpiGu<false> E{(bf16*)(F.ws + B_HF), FFN, SSP};
        pg8::gemm_phase<pg8::EpiGu<false>, pg8::StaticOrder, false>(RING, AUXB, g, S, E);
    } SEAM(4);
    if constexpr (IN(5)) {
        Frame F; mkframe(args, F, lds);
        pg8::Gemm g{(const bf16*)(F.ws + B_HF), (const bf16*)(F.ws + WS_WD), FFN}; pg8::StaticOrder S; S.init(MTOK, DM, F.G, (int)blockIdx.x);
        pg8::EpiRes E{F.out, F.out, XBUF, SSP, RED};
        pg8::gemm_phase<pg8::EpiRes, pg8::StaticOrder, false>(RING, AUXB, g, S, E);
    } SEAM(5);
    if constexpr (IN(6)) {
        Frame F; mkframe(args, F, lds);
        LAS float* gkq = (LAS float*)(F.lds + TEX_OFF);
        if (F.tid < 64) gkq[F.tid] = args.in[I_GK][F.tid]; else if (F.tid < 128) gkq[F.tid] = args.in[I_GQ][F.tid - 64];
        __syncthreads();
        pg8::Gemm g{XBUF, (const bf16*)(F.ws + WS_WKVQ), DM}; pg8::StaticOrder S; S.init(MTOK, 3 * DM, F.G, (int)blockIdx.x);
        pg8::EpiKvq E{(bf16*)(F.ws + B_SBK), (bf16*)(F.ws + B_SBVT), (bf16*)(F.ws + B_SBQ), SSP, gkq};
        pg8::gemm_phase<pg8::EpiKvq, pg8::StaticOrder, false>(RING, AUXB, g, S, E);
    } SEAM(6);
    #ifndef SB_SIMPLE
#define SB_SIMPLE 0
#endif
    if constexpr (IN(7)) { Frame F; mkframe(args, F, lds); if constexpr (SB_SIMPLE) sb_simple(F); else sb_fast(F); } SEAM(7);
    if constexpr (IN(8)) {
        Frame F; mkframe(args, F, lds);
        pg8::Gemm g{(const bf16*)(F.ws + B_SBQ), (const bf16*)(F.ws + WS_WO), DM}; pg8::StaticOrder S; S.init(MTOK, DM, F.G, (int)blockIdx.x);
        pg8::EpiRes E{F.out, F.out, XBUF, nullptr, RED};
        pg8::gemm_phase<pg8::EpiRes, pg8::StaticOrder, false>(RING, AUXB, g, S, E);
    } SEAM(8);
    if constexpr (IN(9)) { Frame F; mkframe(args, F, lds); router_phase(args, F); } SEAM(9);
    if constexpr (IN(10)) { Frame F; mkframe(args, F, lds); slots_phase(F); } SEAM(10);
#define MOE_SETUP(half) \
        Frame F; mkframe(args, F, lds); LAS int* tex = (LAS int*)(F.lds + TEX_OFF); \
        __syncthreads(); \
        const int ntl = __builtin_amdgcn_readfirstlane(((const int*)(F.ctl + CW_MOE))[0]); \
        for (int i = F.tid; i < MAXTILES; i += NWAVES * 64) tex[i] = i < ntl ? ((const int*)(F.ctl + CW_TEXP))[i] : 0; \
        __syncthreads(); \
        const int tlo = (half) ? HALF0_TILES : 0, nth = (half) ? (ntl > HALF0_TILES ? ntl - HALF0_TILES : 0) : (ntl < HALF0_TILES ? ntl : HALF0_TILES);
#define MOE_GU(half) { MOE_SETUP(half) \
        pg8::Gemm g{XBUF, (const bf16*)(F.ws + WS_WMGU), DM}; pg8::MoeOrder S{tlo, nth, 2 * EDIM / 256, F.G, (int)blockIdx.x, tex}; \
        pg8::EpiGu<true> E{(bf16*)(F.ws + B_HM), EDIM, (const float*)(F.ws + T_SLOT)}; \
        pg8::gemm_phase<pg8::EpiGu<true>, pg8::MoeOrder, true>(RING, AUXB, g, S, E); }
#define MOE_DN(half) { MOE_SETUP(half) \
        pg8::Gemm g{(const bf16*)(F.ws + B_HM), (const bf16*)(F.ws + WS_WMD), EDIM}; pg8::MoeOrder S{tlo, nth, DM / 256, F.G, (int)blockIdx.x, tex}; \
        pg8::EpiMoeDn E{(bf16*)F.out, (const int*)(F.ws + T_SLOT)}; \
        pg8::gemm_phase<pg8::EpiMoeDn, pg8::MoeOrder, false>(RING, AUXB, g, S, E); }
    if constexpr (IN(11)) MOE_GU(0) SEAM(11);
    if constexpr (IN(12)) MOE_DN(0) SEAM(12);
    if constexpr (IN(13)) MOE_GU(1) SEAM(13);
    if constexpr (IN(14)) MOE_DN(1) SEAM(14);
    if constexpr (IN(15)) { Frame F; mkframe(args, F, lds); combine_phase(F); }
#undef IN
#undef SEAM
}

#ifndef LAST_PHASE
#define LAST_PHASE 15
#endif
#ifndef ONE_LAUNCH
#define ONE_LAUNCH 1
#endif
typedef void (*kern_t)(Args);
template <int P> struct PhaseTab { static void fill(kern_t* t) { t[P] = fwd_kernel<P, P + 1>; PhaseTab<P - 1>::fill(t); } };
template <> struct PhaseTab<-1> { static void fill(kern_t*) {} };
extern "C" void kernel_launch(void* const* d_in, const int* in_sizes, int n_in, void* d_out, int out_size, void* d_ws, size_t ws_size, hipStream_t stream) {
    static int grid = 0; static kern_t tab[N_PHASES + 1];
    if (grid == 0) {
        if (n_in != 21 || in_sizes[0] != MTOK * DM || out_size != MTOK * DM || ws_size < WS_END) { fprintf(stderr, "kernel_launch: unexpected shapes / workspace (%d inputs, ws %zu); nothing launched\n", n_in, ws_size); grid = -1; return; }
        int dev = 0, cus = 0;
        if (hipGetDevice(&dev) != hipSuccess || hipDeviceGetAttribute(&cus, hipDeviceAttributeMultiprocessorCount, dev) != hipSuccess) { grid = -1; return; }
#if ONE_LAUNCH
        tab[N_PHASES] = fwd_kernel<0, LAST_PHASE + 1>;
        if (hipFuncSetAttribute((const void*)tab[N_PHASES], hipFuncAttributeMaxDynamicSharedMemorySize, LDS_BYTES) != hipSuccess) { fprintf(stderr, "kernel_launch: hipFuncSetAttribute failed\n"); grid = -1; return; }
        int per_cu = 0;
        if (hipOccupancyMaxActiveBlocksPerMultiprocessor(&per_cu, (const void*)tab[N_PHASES], NWAVES * 64, LDS_BYTES) != hipSuccess || per_cu < 1) fprintf(stderr, "kernel_launch: note: occupancy query reports %d workgroups per CU\n", per_cu);
#else
        PhaseTab<N_PHASES - 1>::fill(tab);
        for (int p = 0; p < N_PHASES; ++p) if (hipFuncSetAttribute((const void*)tab[p], hipFuncAttributeMaxDynamicSharedMemorySize, LDS_BYTES) != hipSuccess) { fprintf(stderr, "kernel_launch: hipFuncSetAttribute failed\n"); grid = -1; return; }
#endif
        (void)hipGetLastError();
        grid = cus;
        if (grid != 256) fprintf(stderr, "kernel_launch: built for 256 CUs, found %d\n", grid);
    }
    if (grid < 0) return;
    if (hipMemsetAsync((char*)d_ws + WS_CTL, 0, CTL_ZERO_BYTES, stream) != hipSuccess) return;
    Args a{};
    for (int i = 0; i < 21; ++i) a.in[i] = (const float*)d_in[i];
    a.out = (float*)d_out; a.ws = (unsigned char*)d_ws; a.ph_lo = 0; a.ph_hi = LAST_PHASE + 1;
#if ONE_LAUNCH
    hipLaunchKernelGGL(tab[N_PHASES], dim3(grid), dim3(NWAVES * 64), LDS_BYTES, stream, a);
#else
    for (int p = 0; p <= LAST_PHASE; ++p) hipLaunchKernelGGL(tab[p], dim3(grid), dim3(NWAVES * 64), LDS_BYTES, stream, a);
#endif
}
```

```cpp
#include <hip/hip_runtime.h>
#include <cstdio>
#include <cstdint>
#define GAS __attribute__((address_space(1)))
#define LAS __attribute__((address_space(3)))
typedef unsigned short bf16;
typedef unsigned short bf16_t;
typedef short bf16x8 __attribute__((ext_vector_type(8)));
typedef float f32x4 __attribute__((ext_vector_type(4)));
typedef float f32x2 __attribute__((ext_vector_type(2)));
typedef float f32x16 __attribute__((ext_vector_type(16)));
typedef unsigned u32x4 __attribute__((ext_vector_type(4)));
typedef unsigned u32x2 __attribute__((ext_vector_type(2)));
typedef GAS unsigned gu32;
#define RLX_AGENT __ATOMIC_RELAXED, __HIP_MEMORY_SCOPE_AGENT
#define LDS_WAIT() asm volatile("s_waitcnt lgkmcnt(0)" ::: "memory")
#define VM_WAIT() asm volatile("s_waitcnt vmcnt(0)" ::: "memory")

constexpr int DM = 1024, NBATCH = 8, SEQ = 4096, MTOK = NBATCH * SEQ;
constexpr int MH = 8, MDK = 64, MDV = 128, MPROJ = 3088, MPROJ_MAIN = 3072;
constexpr int SBH = 16, SBD = 64;
constexpr int FFN = 2816, NEXP = 8, EDIM = 3584;
constexpr float EPS = 1e-6f, SOFTCAP = 15.0f;
constexpr float LOG2E = 1.4426950408889634f;
constexpr int NWAVES = 8;
constexpr int MAXTILES = 264;
constexpr int HALF0_TILES = 128;
namespace pg8 {
constexpr int BM = 256, BK = 64, HALF = 128, HTB = HALF * BK * 2  , STAGE_BYTES = 8 * HTB, NXCD = 8, WGM = 8;

__host__ __device__ __forceinline__ int lds_byte(int r, int c) { const int st = (r >> 4) * 2 + (c >> 5), rr = r & 15, cc = c & 31, ob = rr * 64 + cc * 2; return st * 1024 + (ob ^ (((ob >> 9) & 1) << 5)); }
__host__ __device__ __forceinline__ void stage_rc(int b, int& R, int& C) { const int st = b / 1024, sb = b % 1024, swz = sb ^ (((sb >> 9) & 1) << 5); R = (st >> 1) * 16 + swz / 64; C = (st & 1) * 32 + (swz % 64) / 2; }
__host__ __device__ __forceinline__ int perm32(int rho) { const int n = rho >> 4, i = rho & 15; return 8 * (i >> 2) + 4 * n + (i & 3); }

struct Unit { int pm, pn, pb, pa; };
struct Gemm { const void* A; const void* Bt; int K; };

struct StaticOrder {
    int nM, nN, nwg, G, c;
    __device__ void init(int M, int N, int G_, int c_) { nM = M / BM; nN = N / BM; nwg = nM * nN; G = G_; c = c_; }
    __device__ bool next(int i, Unit& u) const {
        const long L = (long)i * G + c; if (L >= nwg) return false;
        int wgid = (int)L; { const int q = nwg / NXCD, r = nwg % NXCD, xcd = wgid % NXCD, off = wgid / NXCD; wgid = (xcd < r ? xcd * (q + 1) : r * (q + 1) + (xcd - r) * q) + off; }
        const int nig = WGM * nN, gid = wgid / nig, fm = gid * WGM, gsz = (nM - fm) < WGM ? (nM - fm) : WGM;
        u.pm = fm + ((wgid % nig) % gsz); u.pn = (wgid % nig) / gsz; u.pb = u.pn; u.pa = u.pm; return true;
    }
};
struct MoeOrder {
    int tile_lo, ntile, nN, G, c; const LAS int* texp;
    __device__ bool next(int i, Unit& u) const {
        const long L = (long)i * G + c; if (L >= (long)ntile * nN) return false;
        const int t = (int)(L / nN); u.pn = (int)(L % nN); u.pm = tile_lo + t; u.pa = t; u.pb = __builtin_amdgcn_readfirstlane(texp[u.pm]) * nN + u.pn; return true;
    }
};

typedef int v8i_t __attribute__((ext_vector_type(8)));
typedef int v4i_t __attribute__((ext_vector_type(4)));
__device__ __forceinline__ unsigned cvt_pk_bf16(float lo, float hi) { unsigned r; asm volatile("v_cvt_pk_bf16_f32 %0, %1, %2" : "=v"(r) : "v"(lo), "v"(hi)); return r; }

template <class Epi, class Sched, bool GATHER, bool FP8 = false>
__device__ __forceinline__ void gemm_phase(LAS unsigned char* lds, LAS unsigned char* auxb, const Gemm g, const Sched& S, const Epi& E) {
    constexpr int NAUX = Epi::NAUX;
    int tid_ = threadIdx.x; asm volatile("" : "+v"(tid_));
    const int tid = tid_, wid = __builtin_amdgcn_readfirstlane(tid >> 6), lane = tid & 63, wr = wid >> 2, wc = wid & 3, fr = lane & 15, fq = lane >> 4;
    const int KB = FP8 ? g.K : g.K * 2; int nt = KB / 128; asm volatile("" : "+s"(nt));
    unsigned voffB[2]; int Rr[2], Cc[2];
#pragma unroll
    for (int i = 0; i < 2; ++i) { int R, C; stage_rc(tid * 16 + i * 8192, R, C); const int Rb = Epi::PERM ? ((R & ~31) + perm32(R & 31)) : R;
        Rr[i] = R; Cc[i] = C; voffB[i] = (unsigned)(Rb * KB + C * 2); }
    const size_t kstep = (size_t)(BK * 2);
    const size_t hstep = (size_t)HALF * KB;
    const size_t tstep = 2 * hstep;
    const unsigned ldsw = (unsigned)wid * 1024u;
    const int aoff = FP8 ? lds_byte(wr * 64 + fr, (fq & 1) * 16) + (fq >> 1) * 1024 : lds_byte(wr * 64 + fr, fq * 8), boff = FP8 ? lds_byte(wc * 32 + fr, (fq & 1) * 16) + (fq >> 1) * 1024 : lds_byte(wc * 32 + fr, fq * 8);
    const int aoff2 = FP8 ? lds_byte(wr * 64 + fr, (fq & 1) * 16 + 8) + (fq >> 1) * 1024 : 0, boff2 = FP8 ? lds_byte(wc * 32 + fr, (fq & 1) * 16 + 8) + (fq >> 1) * 1024 : 0;
#define PG8_SA(b, h) (((b) * 2 + (h)) * HTB)
#define PG8_SB(b, h) ((4 + (b) * 2 + (h)) * HTB)
#define PG8_STAGE(bufoff, gbase, voff) do { _Pragma("unroll") for (int _i = 0; _i < 2; ++_i) \
        __builtin_amdgcn_global_load_lds((const unsigned*)((const char*)(gbase) + (voff)[_i]), (LAS unsigned*)(lds + (bufoff) + ldsw + _i * 8192), 16, 0, 0); } while (0)
#define PG8_LD8(p0, p1) __builtin_shufflevector(*(const LAS v4i_t*)(p0), *(const LAS v4i_t*)(p1), 0, 1, 2, 3, 4, 5, 6, 7)
#define PG8_LDA(dst, b, h) do { if constexpr (FP8) { _Pragma("unroll") for (int m = 0; m < 4; ++m) dst##8[m] = PG8_LD8(lds + PG8_SA(b, h) + aoff + m * 2048, lds + PG8_SA(b, h) + aoff2 + m * 2048); } \
        else { _Pragma("unroll") for (int m = 0; m < 4; ++m) _Pragma("unroll") for (int k = 0; k < 2; ++k) dst[m][k] = *(const LAS bf16x8*)(lds + PG8_SA(b, h) + aoff + k * 1024 + m * 2048); } } while (0)
#define PG8_LDB(dst, b, h) do { if constexpr (FP8) { _Pragma("unroll") for (int n = 0; n < 2; ++n) dst##8[n] = PG8_LD8(lds + PG8_SB(b, h) + boff + n * 2048, lds + PG8_SB(b, h) + boff2 + n * 2048); } \
        else { _Pragma("unroll") for (int n = 0; n < 2; ++n) _Pragma("unroll") for (int k = 0; k < 2; ++k) dst[n][k] = *(const LAS bf16x8*)(lds + PG8_SB(b, h) + boff + k * 1024 + n * 2048); } } while (0)
#define PG8_MMA(ai, bj, At, Bt) do { __builtin_amdgcn_s_setprio(1); _Pragma("unroll") for (int m = 0; m < 4; ++m) _Pragma("unroll") for (int n = 0; n < 2; ++n) { \
        if constexpr (FP8) asm volatile("v_mfma_scale_f32_16x16x128_f8f6f4 %0, %1, %2, %0, %3, %3 op_sel_hi:[0,0,0]" : "+v"(acc[ai][bj][m][n]) : "v"(Bt##8[n]), "v"(At##8[m]), "v"(sc1)); \
        else { _Pragma("unroll") for (int k = 0; k < 2; ++k) acc[ai][bj][m][n] = __builtin_amdgcn_mfma_f32_16x16x32_bf16(Bt[n][k], At[m][k], acc[ai][bj][m][n], 0, 0, 0); } } __builtin_amdgcn_s_setprio(0); } while (0)
#define PG8_WAIT_V(n) asm volatile("s_waitcnt vmcnt(" #n ")" ::: "memory")
#define PG8_WAIT_L(n) asm volatile("s_waitcnt lgkmcnt(" #n ")" ::: "memory")
#define PG8_BAR __builtin_amdgcn_s_barrier()
#define PG8_SCHED __builtin_amdgcn_sched_barrier(0)
#define PG8_VA(dst, par) do { _Pragma("unroll") for (int _h = 0; _h < 2; ++_h) _Pragma("unroll") for (int _i = 0; _i < 2; ++_i) { \
        if constexpr (GATHER) { const int _ix = ((const LAS int*)(auxb + (size_t)(par) * NAUX * 1024))[_h * HALF + Rr[_i]]; dst[_h][_i] = (unsigned)_ix * (unsigned)KB + (unsigned)(Cc[_i] * 2); } \
        else dst[_h][_i] = (unsigned)((_h * HALF + Rr[_i]) * KB + Cc[_i] * 2); } } while (0)
#define PG8_AUX(un, par) do { if constexpr (NAUX > 0) { const unsigned* _src = (const unsigned*)((const char*)E.aux_src(un) + lane * 16); LAS unsigned* _dst = (LAS unsigned*)(auxb + (size_t)((par) * NAUX) * 1024); \
        _Pragma("unroll") for (int _p = 0; _p < NAUX; ++_p) { __builtin_amdgcn_global_load_lds(_src, _dst, 16, 0, 0); _src += 256; _dst += 256; asm volatile("" : "+v"(_src)); } } } while (0)
    Unit cur, nxt, prv; int ui = 0;
    if (!S.next(0, cur)) return;
    prv = cur;
    f32x4 acc[2][2][4][2];
#pragma unroll
    for (int a = 0; a < 2; ++a)
#pragma unroll
        for (int b = 0; b < 2; ++b)
#pragma unroll
            for (int m = 0; m < 4; ++m)
#pragma unroll
                for (int n = 0; n < 2; ++n) acc[a][b][m][n] = (f32x4){0.f, 0.f, 0.f, 0.f};
    bf16x8 At[4][2], B0[2][2], B1[2][2];
    v8i_t At8[4], B08[2], B18[2]; const int sc1 = 0x7f7f7f7f;
    unsigned vAc[2][2], vAn[2][2];
    if constexpr (NAUX > 0) { if (wid == 0) PG8_AUX(cur, 0); PG8_WAIT_V(0); PG8_BAR; }
    PG8_VA(vAc, 0);
#pragma unroll
    for (int h = 0; h < 2; ++h)
#pragma unroll
        for (int i = 0; i < 2; ++i) vAn[h][i] = vAc[h][i];
    const char* cA = GATHER ? (const char*)g.A : (const char*)g.A + (size_t)cur.pa * tstep; const char* cB = (const char*)g.Bt + (size_t)cur.pb * tstep;
    PG8_STAGE(PG8_SB(0, 0), cB, voffB); PG8_STAGE(PG8_SB(0, 1), cB + hstep, voffB); PG8_STAGE(PG8_SA(0, 0), cA, vAc[0]); PG8_STAGE(PG8_SA(0, 1), cA, vAc[1]);
    if (wr == 1) PG8_BAR;
    PG8_WAIT_V(2); PG8_BAR;
    PG8_STAGE(PG8_SB(1, 0), cB + kstep, voffB); PG8_STAGE(PG8_SA(1, 0), cA + kstep, vAc[0]); PG8_STAGE(PG8_SB(1, 1), cB + hstep + kstep, voffB);
    PG8_WAIT_V(6); PG8_BAR;
    for (;;) {
        const bool has_next = S.next(ui + 1, nxt);
        const char* nA = has_next ? (GATHER ? (const char*)g.A : (const char*)g.A + (size_t)nxt.pa * tstep) : cA; const char* nB = has_next ? (const char*)g.Bt + (size_t)nxt.pb * tstep : cB;
#pragma clang loop unroll(disable)
        for (int t = 0; t < nt; t += 2) {
            const bool last = (t == nt - 2);
            if constexpr (NAUX > 0) { if (t == 2 && has_next && wid == 4) PG8_AUX(nxt, (ui + 1) & 1); }
            if (last && has_next) { PG8_VA(vAn, (ui + 1) & 1); }
            const char* a1 = cA + (size_t)(t + 1) * kstep;
            const char* a2 = last ? nA : cA + (size_t)(t + 2) * kstep; const char* b2 = last ? nB : cB + (size_t)(t + 2) * kstep;
            const char* a3 = a2 + kstep; const char* b3 = b2 + kstep;
            unsigned v2[2][2];
#pragma unroll
            for (int h = 0; h < 2; ++h)
#pragma unroll
                for (int i = 0; i < 2; ++i) v2[h][i] = (last && has_next) ? vAn[h][i] : vAc[h][i];
            PG8_LDB(B0, 0, 0); PG8_LDB(B1, 0, 1); PG8_SCHED; PG8_LDA(At, 0, 0); PG8_STAGE(PG8_SA(1, 1), a1, vAc[1]);
            PG8_WAIT_V(8); PG8_WAIT_L(0); PG8_BAR; PG8_MMA(0, 0, At, B0); PG8_MMA(0, 1, At, B1); PG8_BAR; PG8_SCHED;
            PG8_LDA(At, 0, 1); PG8_STAGE(PG8_SB(0, 0), b2, voffB); PG8_STAGE(PG8_SB(0, 1), b2 + hstep, voffB); PG8_STAGE(PG8_SA(0, 0), a2, v2[0]);
            PG8_WAIT_V(8); PG8_WAIT_L(0); PG8_BAR; PG8_MMA(1, 0, At, B0); PG8_MMA(1, 1, At, B1); PG8_BAR; PG8_SCHED;
            PG8_LDB(B0, 1, 0); PG8_LDB(B1, 1, 1); PG8_SCHED; PG8_LDA(At, 1, 0); PG8_STAGE(PG8_SA(0, 1), a2, v2[1]);
            PG8_WAIT_V(8); PG8_WAIT_L(0); PG8_BAR; PG8_MMA(0, 0, At, B0); PG8_MMA(0, 1, At, B1); PG8_BAR; PG8_SCHED;
            PG8_LDA(At, 1, 1); PG8_STAGE(PG8_SB(1, 0), b3, voffB); PG8_STAGE(PG8_SB(1, 1), b3 + hstep, voffB); PG8_STAGE(PG8_SA(1, 0), a3, v2[0]);
            PG8_WAIT_V(8); PG8_WAIT_L(0); PG8_BAR; PG8_MMA(1, 0, At, B0); PG8_MMA(1, 1, At, B1); PG8_BAR; PG8_SCHED;
        }
        if constexpr (FP8) asm volatile("s_nop 15\n\ts_nop 7" ::: "memory");
        if (wr == 0) PG8_BAR;
        E(acc, cur, wr, wc, fr, fq, (const LAS unsigned char*)(auxb + (size_t)(ui & 1) * NAUX * 1024), ui, prv);
        if (!has_next) break;
#pragma unroll
        for (int a = 0; a < 2; ++a)
#pragma unroll
            for (int b = 0; b < 2; ++b)
#pragma unroll
                for (int m = 0; m < 4; ++m)
#pragma unroll
                    for (int n = 0; n < 2; ++n) acc[a][b][m][n] = (f32x4){0.f, 0.f, 0.f, 0.f};
        prv = cur; cur = nxt; cA = nA; cB = nB; ++ui;
#pragma unroll
        for (int h = 0; h < 2; ++h)
#pragma unroll
            for (int i = 0; i < 2; ++i) vAc[h][i] = vAn[h][i];
        if (wr == 1) PG8_BAR;
    }
    PG8_WAIT_V(0); PG8_WAIT_L(0);
    PG8_BAR;
    E.finish(cur, ui);
#undef PG8_SA
#undef PG8_SB
#undef PG8_STAGE
#undef PG8_LDA
#undef PG8_LDB
#undef PG8_MMA
#undef PG8_WAIT_V
#undef PG8_WAIT_L
#undef PG8_BAR
#undef PG8_SCHED
#undef PG8_VA
#undef PG8_AUX
}
}
namespace pg8 {
__device__ __forceinline__ float sigmoid_fast(float x) { return __builtin_amdgcn_rcpf(1.0f + __builtin_amdgcn_exp2f(-LOG2E * x)); }
template <int NP> __device__ __forceinline__ float row_rs(const LAS unsigned char* aux, int rl) {
    const LAS float* ax = (const LAS float*)aux; float ss = ax[rl];
#pragma unroll
    for (int p = 1; p < NP; ++p) ss += ax[p * 256 + rl];
    return rsqrtf(ss * (1.0f / DM) + EPS);
}
__device__ __forceinline__ unsigned pk4_fp8(float a, float b, float c, float d) { int v = __builtin_amdgcn_cvt_pk_fp8_f32(a, b, 0, false); v = __builtin_amdgcn_cvt_pk_fp8_f32(c, d, v, true); return (unsigned)v; }
__device__ __forceinline__ u32x2 pack8_fp8(const f32x4 a, const f32x4 b) { return (u32x2){pk4_fp8(a[0], a[1], a[2], a[3]), pk4_fp8(b[0], b[1], b[2], b[3])}; }
__device__ __forceinline__ u32x4 pack8(const f32x4 a, const f32x4 b) { u32x4 w; w.x = cvt_pk_bf16(a[0], a[1]); w.y = cvt_pk_bf16(a[2], a[3]); w.z = cvt_pk_bf16(b[0], b[1]); w.w = cvt_pk_bf16(b[2], b[3]); return w; }

struct EpiProj {
    static constexpr bool PERM = true; static constexpr int NAUX = 1;
    bf16_t* Q; bf16_t* Kk; bf16_t* Kt; bf16_t* Vt; bf16_t* OG; const float* ss0;
    __device__ __forceinline__ const void* aux_src(const Unit& u) const { return ss0 + (size_t)u.pm * 256; }
    __device__ __forceinline__ void operator()(const f32x4 (&acc)[2][2][4][2], const Unit& u, int wr, int wc, int fr, int fq, const LAS unsigned char* aux, int, const Unit&) const {
        asm volatile("" : "+v"(fr), "+v"(fq));
        const int pn = u.pn;
        if (pn < 4 || pn >= 8) {
            bf16_t* base; int ldc, colt; bool sig = false;
            if (pn < 2) { base = Q; ldc = 512; colt = pn * 256; } else if (pn < 4) { base = Kk; ldc = 512; colt = (pn - 2) * 256; } else { base = OG; ldc = 1024; colt = (pn - 8) * 256; sig = true; }
#pragma unroll
            for (int ai = 0; ai < 2; ++ai)
#pragma unroll
                for (int m = 0; m < 4; ++m) { const int rl = ai * HALF + wr * 64 + m * 16 + fr; const float rs = row_rs<1>(aux, rl);
                    bf16_t* rowp = base + (size_t)(u.pm * BM + rl) * ldc + colt + wc * 32 + 8 * fq;
#pragma unroll
                    for (int bj = 0; bj < 2; ++bj) { f32x4 v0 = acc[ai][bj][m][0] * rs, v1 = acc[ai][bj][m][1] * rs;
                        if (sig) {
#pragma unroll
                            for (int j = 0; j < 4; ++j) { v0[j] = sigmoid_fast(v0[j]); v1[j] = sigmoid_fast(v1[j]); } }
                        *(u32x4*)(rowp + bj * HALF) = pack8(v0, v1); }
                    asm volatile("" ::: "memory"); }
        }
        if (pn >= 2 && pn < 8) {
            const bool isk = pn < 4; const int colt = isk ? (pn - 2) * 256 : (pn - 4) * 256; bf16_t* tb = isk ? Kt : Vt; const int hshift = isk ? 6 : 7;
#pragma unroll
            for (int ai = 0; ai < 2; ++ai)
#pragma unroll
                for (int m = 0; m < 4; ++m) { const int rl = ai * HALF + wr * 64 + m * 16 + fr; const float rs = row_rs<1>(aux, rl); const int row = u.pm * BM + rl, b = row >> 12, t = row & 4095;
#pragma unroll
                    for (int bj = 0; bj < 2; ++bj)
#pragma unroll
                        for (int n = 0; n < 2; ++n)
#pragma unroll
                            for (int j = 0; j < 4; ++j) { const int col = colt + bj * HALF + wc * 32 + 8 * fq + 4 * n + j, hd = col >> hshift, cc = col & ((1 << hshift) - 1);
                                tb[((size_t)((b * MH + hd) << hshift) + cc) * SEQ + t] = (bf16_t)(cvt_pk_bf16(acc[ai][bj][m][n][j] * rs, 0.f) & 0xffffu); }
                    asm volatile("" ::: "memory"); }
        }
    }
    __device__ __forceinline__ void finish(const Unit&, int) const {}
};

struct EpiRes {
    static constexpr bool PERM = true; static constexpr int NAUX = 0;
    const float* base; float* out; bf16_t* xb; float* ssp; LAS float* red; unsigned char* xq;
    __device__ __forceinline__ const void* aux_src(const Unit&) const { return nullptr; }
    __device__ __forceinline__ void flush(const Unit& p, int par) const {
        if (threadIdx.x < 256) { const LAS float* r = red + par * 1024; const int row = threadIdx.x; ssp[((size_t)p.pm * 4 + p.pn) * 256 + row] = (r[row] + r[256 + row]) + (r[512 + row] + r[768 + row]); } }
    __device__ __forceinline__ void operator()(const f32x4 (&acc)[2][2][4][2], const Unit& u, int wr, int wc, int fr, int fq, const LAS unsigned char*, int ui, const Unit& prv) const {
        asm volatile("" : "+v"(fr), "+v"(fq));
        if (ssp && ui > 0) flush(prv, (ui - 1) & 1);
#pragma unroll
        for (int ai = 0; ai < 2; ++ai)
#pragma unroll
            for (int m = 0; m < 4; ++m) { const int rl = ai * HALF + wr * 64 + m * 16 + fr; const size_t off = (size_t)(u.pm * BM + rl) * DM + u.pn * BM + wc * 32 + 8 * fq; float ss = 0.f;
#pragma unroll
                for (int bj = 0; bj < 2; ++bj) { const f32x4 b0 = *(const f32x4*)(base + off + bj * HALF), b1 = *(const f32x4*)(base + off + bj * HALF + 4);
                    const f32x4 v0 = acc[ai][bj][m][0] + b0, v1 = acc[ai][bj][m][1] + b1;
                    *(f32x4*)(out + off + bj * HALF) = v0; *(f32x4*)(out + off + bj * HALF + 4) = v1; *(u32x4*)(xb + off + bj * HALF) = pack8(v0, v1); if (xq) *(u32x2*)(xq + off + bj * HALF) = pack8_fp8(v0, v1);
                    ss += (v0[0] * v0[0] + v0[1] * v0[1]) + (v0[2] * v0[2] + v0[3] * v0[3]) + (v1[0] * v1[0] + v1[1] * v1[1]) + (v1[2] * v1[2] + v1[3] * v1[3]); }
                if (ssp) { ss += __shfl_xor(ss, 16); ss += __shfl_xor(ss, 32); if (fq == 0) red[(ui & 1) * 1024 + wc * 256 + rl] = ss; }
                asm volatile("" ::: "memory"); }
    }
    __device__ __forceinline__ void finish(const Unit& last, int ui) const { if (ssp) flush(last, ui & 1); }
};

constexpr float MOE_WSCALE = 32.0f, MOE_HSCALE = 8.0f;
template <bool MOE> struct EpiGu {
    static constexpr bool PERM = true; static constexpr int NAUX = MOE ? 3 : 4;
    void* H; int ldh; const float* ssp;
    __device__ __forceinline__ const void* aux_src(const Unit& u) const { return ssp + (size_t)u.pm * 1024; }
    __device__ __forceinline__ void operator()(const f32x4 (&acc)[2][2][4][2], const Unit& u, int wr, int wc, int fr, int fq, const LAS unsigned char* aux, int, const Unit&) const {
        asm volatile("" : "+v"(fr), "+v"(fq));
#pragma unroll
        for (int ai = 0; ai < 2; ++ai)
#pragma unroll
            for (int m = 0; m < 4; ++m) { const int rl = ai * HALF + wr * 64 + m * 16 + fr; float rs, w = 1.f;
                if constexpr (MOE) { rs = ((const LAS float*)(aux + 1024))[rl] * (1.0f / MOE_WSCALE); w = ((const LAS float*)(aux + 2048))[rl] * MOE_HSCALE; } else rs = row_rs<4>(aux, rl);
                const size_t eo = (size_t)(u.pa * BM + rl) * ldh + u.pn * HALF + wc * 32 + 8 * fq;
                f32x4 h[2];
#pragma unroll
                for (int n = 0; n < 2; ++n) { const f32x4 gg = acc[ai][0][m][n] * rs, uu = acc[ai][1][m][n] * rs;
#pragma unroll
                    for (int j = 0; j < 4; ++j) h[n][j] = gg[j] * sigmoid_fast(gg[j]) * uu[j] * w; }
                if constexpr (MOE) *(u32x2*)((unsigned char*)H + eo) = pack8_fp8(h[0], h[1]); else *(u32x4*)((bf16_t*)H + eo) = pack8(h[0], h[1]);
                asm volatile("" ::: "memory"); }
    }
    __device__ __forceinline__ void finish(const Unit&, int) const {}
};

struct EpiKvq {
    static constexpr bool PERM = true; static constexpr int NAUX = 4;
    bf16_t* Kb; bf16_t* Vt; bf16_t* Qb; const float* ssp; const LAS float* gk;
    __device__ __forceinline__ const void* aux_src(const Unit& u) const { return ssp + (size_t)u.pm * 1024; }
    __device__ __forceinline__ void operator()(const f32x4 (&acc)[2][2][4][2], const Unit& u, int wr, int wc, int fr, int fq, const LAS unsigned char* aux, int, const Unit&) const {
        asm volatile("" : "+v"(fr), "+v"(fq));
        const int kind = u.pn >> 2, hd = (u.pn & 3) * 4 + wc;
#pragma unroll
        for (int ai = 0; ai < 2; ++ai)
#pragma unroll
            for (int m = 0; m < 4; ++m) { const int rl = ai * HALF + wr * 64 + m * 16 + fr; const float rs = row_rs<4>(aux, rl); const int row = u.pm * BM + rl;
                f32x4 y[2][2]; float ssq = 0.f;
#pragma unroll
                for (int bj = 0; bj < 2; ++bj)
#pragma unroll
                    for (int n = 0; n < 2; ++n) { y[bj][n] = acc[ai][bj][m][n] * rs; const f32x4 t = y[bj][n]; ssq += (t[0] * t[0] + t[1] * t[1]) + (t[2] * t[2] + t[3] * t[3]); }
                if (kind != 1) {
                    ssq += __shfl_xor(ssq, 16); ssq += __shfl_xor(ssq, 32);
                    const float rinv = rsqrtf(ssq * (1.0f / 64.0f) + EPS) * (kind == 2 ? LOG2E * 0.125f : 1.0f);
                    const LAS float* g = gk + (kind == 2 ? 64 : 0);
                    bf16_t* dst = (kind == 2 ? Qb : Kb) + (size_t)row * 1024 + hd * 64;
#pragma unroll
                    for (int bj = 0; bj < 2; ++bj) { const int pos0 = 32 * bj + 8 * fq; const f32x4 g0 = *(const LAS f32x4*)(g + pos0), g1 = *(const LAS f32x4*)(g + pos0 + 4);
                        *(u32x4*)(dst + pos0) = pack8(y[bj][0] * rinv * g0, y[bj][1] * rinv * g1); }
                } else {
                    const int b = row >> 12, t = row & 4095; bf16_t* dst = Vt + ((size_t)(b * 16 + hd) * 64) * 4096 + t;
#pragma unroll
                    for (int bj = 0; bj < 2; ++bj)
#pragma unroll
                        for (int n = 0; n < 2; ++n)
#pragma unroll
                            for (int j = 0; j < 4; ++j) dst[(size_t)(32 * bj + 8 * fq + 4 * n + j) * 4096] = (bf16_t)(cvt_pk_bf16(y[bj][n][j], 0.f) & 0xffffu);
                }
                asm volatile("" ::: "memory"); }
    }
    __device__ __forceinline__ void finish(const Unit&, int) const {}
};

struct EpiMoeDn {
    static constexpr bool PERM = true; static constexpr int NAUX = 1;
    bf16_t* Y; const int* slot;
    __device__ __forceinline__ const void* aux_src(const Unit& u) const { return slot + (size_t)u.pm * 1024 + 768; }
    __device__ __forceinline__ void operator()(const f32x4 (&acc)[2][2][4][2], const Unit& u, int wr, int wc, int fr, int fq, const LAS unsigned char* aux, int, const Unit&) const {
        asm volatile("" : "+v"(fr), "+v"(fq));
#pragma unroll
        for (int ai = 0; ai < 2; ++ai)
#pragma unroll
            for (int m = 0; m < 4; ++m) { const int rl = ai * HALF + wr * 64 + m * 16 + fr; const int yr = ((const LAS int*)aux)[rl];
                if (yr >= 0) { bf16_t* rowp = Y + (size_t)yr * DM + u.pn * BM + wc * 32 + 8 * fq;
#pragma unroll
                    for (int bj = 0; bj < 2; ++bj) *(u32x4*)(rowp + bj * HALF) = pack8(acc[ai][bj][m][0] * (1.0f / (MOE_WSCALE * MOE_HSCALE)), acc[ai][bj][m][1] * (1.0f / (MOE_WSCALE * MOE_HSCALE))); }
                asm volatile("" ::: "memory"); }
    }
    __device__ __forceinline__ void finish(const Unit&, int) const {}
};
}
constexpr size_t MiB = 1u << 20;
constexpr size_t WS_CTL = 0, CTL_ZERO_BYTES = 64 * 1024;
constexpr size_t WS_WIN = 1 * MiB, WS_WOUT = 7 * MiB, WS_WGU = 9 * MiB, WS_WD = 20 * MiB, WS_WKVQ = 26 * MiB, WS_WO = 32 * MiB, WS_WMGU = 34 * MiB, WS_WMD = 90 * MiB;
constexpr size_t WS_TAB = 118 * MiB;
constexpr size_t T_SS0 = WS_TAB, T_SSP = WS_TAB + 128 * 1024, T_GATES = WS_TAB + 1 * MiB, T_SELE = WS_TAB + 3 * MiB, T_SELW1 = T_SELE + 128 * 1024, T_SELW2 = T_SELE + 256 * 1024, T_SELRS = T_SELE + 384 * 1024;
constexpr size_t T_SLOT = WS_TAB + 4 * MiB;
constexpr size_t WS_A = 124 * MiB;
constexpr size_t WS_B = 188 * MiB;
constexpr size_t B_Q = WS_B, B_K = WS_B + 32 * MiB, B_VT = WS_B + 64 * MiB, B_OG = WS_B + 128 * MiB, B_HN = WS_B + 192 * MiB;
constexpr size_t B_HF = WS_B;
constexpr size_t B_SBK = WS_B, B_SBVT = WS_B + 64 * MiB, B_SBQ = WS_B + 128 * MiB;
constexpr size_t B_X3Q = WS_B, B_HM = WS_B + 32 * MiB;
constexpr size_t WS_END = 528 * MiB;
static_assert((size_t)MAXTILES * 4096 <= 2 * MiB && B_HM + (size_t)MAXTILES * 256 * EDIM <= WS_END && B_HN + (size_t)MTOK * DM * 2 <= WS_END, "d_ws map");
constexpr int CW_TMO = 0, CW_BAR = 4096, CW_CNT = 8192, CW_MOE = 12288, CW_TEXP = CW_MOE + 64;
constexpr int RING_OFF = 0, RING_BYTES = 131072;
constexpr int AUX_OFF = RING_BYTES, AUX_BYTES = 8192;
constexpr int RED_OFF = AUX_OFF + AUX_BYTES, RED_BYTES = 8192;
constexpr int TEX_OFF = RED_OFF + RED_BYTES, TEX_BYTES = 2048;
constexpr int MISC_OFF = TEX_OFF + TEX_BYTES;
constexpr int LDS_BYTES = MISC_OFF + 128;
static_assert(LDS_BYTES <= 160 * 1024 && LDS_BYTES > 80 * 1024, "LDS map: one workgroup per CU");

#define XB_TMO      128
#define XB_XCNT(j)  (256  + 64 * (j))
#define XB_XSUB(j)  (1280 + 64 * (j))
#define XB_XGEN(j)  (2304 + 64 * (j))
#define XB_TOP      3328
#define XB_TOPGEN   3392
#define XCD_BAR_WORDS 3456
#define XB_SPIN_CAP (1u << 18)
__device__ __forceinline__ unsigned xb_ld(unsigned* p)              { return __hip_atomic_load(p, __ATOMIC_RELAXED, __HIP_MEMORY_SCOPE_AGENT); }
__device__ __forceinline__ unsigned xb_add(unsigned* p, unsigned v) { return __hip_atomic_fetch_add(p, v, __ATOMIC_RELAXED, __HIP_MEMORY_SCOPE_AGENT); }
__device__ __forceinline__ unsigned xb_xcc_id() { return (unsigned)__builtin_amdgcn_s_getreg((3 << 11) | 20) & 0xFu; }
#define XB_SPIN(cond, bar) do { unsigned _sp = 0; while (cond) { __builtin_amdgcn_s_sleep(1); \
    if ((++_sp & 255u) == 0u) { if (xb_ld(&(bar)[XB_TMO])) break; if (_sp > XB_SPIN_CAP) { atomicAdd(&(bar)[XB_TMO], 1u); break; } } } } while (0)
struct XcdBarrier { unsigned* bar; unsigned x; volatile LAS unsigned* st; };
__device__ __forceinline__ XcdBarrier xcd_barrier_post(unsigned* bar, volatile LAS unsigned* st) {
    XcdBarrier b; b.bar = bar; b.x = xb_xcc_id(); b.st = st;
    if (threadIdx.x == 0) (void)xb_add(&bar[XB_XCNT(b.x)], 1u);
    return b;
}
__device__ __forceinline__ void xcd_barrier_complete(unsigned* bar, unsigned x, unsigned& nloc, unsigned& nx) {
    const unsigned G = gridDim.x * gridDim.y * gridDim.z;
    unsigned sum, cnt, mine, sp = 0u;
    for (;;) {
        sum = 0u; cnt = 0u; mine = 0u;
#pragma unroll
        for (unsigned j = 0; j < 16; ++j) { const unsigned c = xb_ld(&bar[XB_XCNT(j)]); sum += c; cnt += (c > 0u) ? 1u : 0u; mine = (j == x) ? c : mine; }
        if (sum == G) break;
        __builtin_amdgcn_s_sleep(1);
        if ((++sp & 255u) == 0u) { if (xb_ld(&bar[XB_TMO])) break; if (sp > XB_SPIN_CAP) { atomicAdd(&bar[XB_TMO], 1u); break; } }
    }
    nloc = mine > 0u ? mine : 1u; nx = cnt > 0u ? cnt : 1u;
}
__device__ __forceinline__ void xcd_barrier(const XcdBarrier& b) {
    asm volatile("s_waitcnt vmcnt(0)" ::: "memory");
    __syncthreads();
    if (threadIdx.x == 0) {
        unsigned* bar = b.bar;
        __builtin_amdgcn_s_waitcnt(0);
        unsigned nloc = b.st[0], nx = b.st[1];
        if (nloc == 0u) { xcd_barrier_complete(bar, b.x, nloc, nx); b.st[0] = nloc; b.st[1] = nx; }
        const unsigned old = xb_add(&bar[XB_XSUB(b.x)], 1u);
        const unsigned gen = old / nloc;
        if (old + 1u == (gen + 1u) * nloc) {
            __builtin_amdgcn_fence(__ATOMIC_RELEASE, "agent");
            asm volatile("s_waitcnt vmcnt(0)" ::: "memory");
            const unsigned og = xb_add(&bar[XB_TOP], 1u);
            const unsigned tg = og / nx;
            if (og + 1u == (tg + 1u) * nx) xb_add(&bar[XB_TOPGEN], 1u);
            else XB_SPIN(xb_ld(&bar[XB_TOPGEN]) == tg, bar);
            __builtin_amdgcn_fence(__ATOMIC_ACQUIRE, "agent");
            xb_add(&bar[XB_XGEN(b.x)], 1u);
            asm volatile("s_waitcnt vmcnt(0)" ::: "memory");
        } else {
            XB_SPIN(xb_ld(&bar[XB_XGEN(b.x)]) == gen, bar);
            __builtin_amdgcn_fence(__ATOMIC_ACQUIRE, "agent");
            asm volatile("s_waitcnt vmcnt(0)" ::: "memory");
        }
    }
    __syncthreads();
}

struct Args { const float* in[21]; float* out; unsigned char* ws; int ph_lo, ph_hi; };
struct Frame {
    LAS unsigned char* lds;
    volatile LAS unsigned* MISC;
    unsigned* ctl;
    int tid, lane, wave, vcu, G;
    float* out; unsigned char* ws;
};
enum { I_X = 0, I_MIXN, I_FFNN, I_WIN, I_BI, I_BF, I_GH, I_WOUT, I_KVN, I_WKV, I_GK, I_WQ, I_GQ, I_WO, I_FG, I_FU, I_FD, I_WR, I_MG, I_MU, I_MD };
__device__ __forceinline__ unsigned f2bf(float f) { unsigned u = __builtin_bit_cast(unsigned, f); return (u + 0x7fffu + ((u >> 16) & 1u)) >> 16; }
__device__ __forceinline__ unsigned pk2(float lo, float hi) { return f2bf(lo) | (f2bf(hi) << 16); }
__device__ __forceinline__ float bf2f(unsigned short b) { return __builtin_bit_cast(float, (unsigned)b << 16); }
__device__ __forceinline__ float wave_sum(float v) {
#pragma unroll
    for (int o = 1; o < 64; o <<= 1) v += __shfl_xor(v, o);
    return v;
}

struct Job { const float* src; int ldw, col0, ncols, K; const float* gain; float scale; void* dst; int type, roff; int fp8; };
__device__ __forceinline__ int rowmap(int type, int roff, int n) {
    if (type == 0) return roff + n;
    if (type == 1) return 256 * (n >> 7) + (n & 127) + roff;
    return roff + 256 * (n >> 8) + 128 * ((n & 63) >> 5) + 32 * ((n & 255) >> 6) + (n & 31);
}
constexpr int SMALL_ITEMS = 256 + 256 + 1024 + 512 + 1408 * 3 + 512 * 4, MOE_ITEMS = 1792, P0_ITEMS = SMALL_ITEMS + 24 * MOE_ITEMS;
__device__ __forceinline__ void get_job(const Args& A, Frame& F, int it, Job& jb, int& local) {
    unsigned char* ws = F.ws;
    if (it >= SMALL_ITEMS) { const int r = it - SMALL_ITEMS, j = r / MOE_ITEMS; local = r % MOE_ITEMS; const int kind = j >> 3, e = j & 7;
        if (kind == 0)      jb = Job{A.in[I_MG] + (size_t)e * DM * EDIM, EDIM, 0, EDIM, DM, A.in[I_FFNN] + DM, 32.f, ws + WS_WMGU + (size_t)e * 2 * EDIM * DM, 1, 0, 1};
        else if (kind == 1) jb = Job{A.in[I_MU] + (size_t)e * DM * EDIM, EDIM, 0, EDIM, DM, A.in[I_FFNN] + DM, 32.f, ws + WS_WMGU + (size_t)e * 2 * EDIM * DM, 1, 128, 1};
        else                jb = Job{A.in[I_MD] + (size_t)e * EDIM * DM, DM, 0, DM, EDIM, nullptr, 32.f, ws + WS_WMD + (size_t)e * DM * EDIM, 0, 0, 1};
        return; }
    int r = it;
    if (r < 256)  { local = r; jb = Job{A.in[I_WIN], MPROJ, 0, 512, DM, A.in[I_MIXN], 1.f, (bf16*)(ws + WS_WIN), 0, 0, 0}; return; } r -= 256;
    if (r < 256)  { local = r; jb = Job{A.in[I_WIN], MPROJ, 512, 512, DM, A.in[I_MIXN], 0.125f, (bf16*)(ws + WS_WIN), 0, 512, 0}; return; } r -= 256;
    if (r < 1024) { local = r; jb = Job{A.in[I_WIN], MPROJ, 1024, 2048, DM, A.in[I_MIXN], 1.f, (bf16*)(ws + WS_WIN), 0, 1024, 0}; return; } r -= 1024;
    if (r < 512)  { local = r; jb = Job{A.in[I_WOUT], DM, 0, DM, DM, nullptr, 1.f, (bf16*)(ws + WS_WOUT), 0, 0, 0}; return; } r -= 512;
    if (r < 1408) { local = r; jb = Job{A.in[I_FG], FFN, 0, FFN, DM, A.in[I_FFNN], 1.f, (bf16*)(ws + WS_WGU), 1, 0, 0}; return; } r -= 1408;
    if (r < 1408) { local = r; jb = Job{A.in[I_FU], FFN, 0, FFN, DM, A.in[I_FFNN], 1.f, (bf16*)(ws + WS_WGU), 1, 128, 0}; return; } r -= 1408;
    if (r < 1408) { local = r; jb = Job{A.in[I_FD], DM, 0, DM, FFN, nullptr, 1.f, (bf16*)(ws + WS_WD), 0, 0, 0}; return; } r -= 1408;
    if (r < 512)  { local = r; jb = Job{A.in[I_WKV], 2 * DM, 0, DM, DM, A.in[I_KVN], 1.f, (bf16*)(ws + WS_WKVQ), 2, 0, 0}; return; } r -= 512;
    if (r < 512)  { local = r; jb = Job{A.in[I_WKV], 2 * DM, DM, DM, DM, A.in[I_KVN], 1.f, (bf16*)(ws + WS_WKVQ), 2, 1024, 0}; return; } r -= 512;
    if (r < 512)  { local = r; jb = Job{A.in[I_WQ], DM, 0, DM, DM, A.in[I_MIXN] + DM, 1.f, (bf16*)(ws + WS_WKVQ), 2, 2048, 0}; return; } r -= 512;
    local = r; jb = Job{A.in[I_WO], DM, 0, DM, DM, nullptr, 1.f, (bf16*)(ws + WS_WO), 0, 0, 0};
}
struct P0Regs { f32x4 v[8]; };
__device__ __forceinline__ void p0_load(const Job& jb, int item, int lane, P0Regs& R) {
    const int nnb = jb.ncols / 32, kb = item / nnb, nb = item % nnb, k0 = 64 * kb, n0 = 32 * nb;
#pragma unroll
    for (int i = 0; i < 8; ++i) { const int kk = 8 * i + (lane >> 3); R.v[i] = *(const GAS f32x4*)(jb.src + (size_t)(k0 + kk) * jb.ldw + jb.col0 + n0 + 4 * (lane & 7)); }
}
__device__ __forceinline__ void p0_store(const Job& jb, int item, LAS float* scr, int lane, const P0Regs& R) {
    const int nnb = jb.ncols / 32, kb = item / nnb, nb = item % nnb, k0 = 64 * kb, n0 = 32 * nb;
#pragma unroll
    for (int i = 0; i < 8; ++i) { const int kk = 8 * i + (lane >> 3); const float gsc = (jb.gain ? jb.gain[k0 + kk] : 1.f) * jb.scale;
        LAS float* d = scr + kk * 33 + 4 * (lane & 7); d[0] = R.v[i][0] * gsc; d[1] = R.v[i][1] * gsc; d[2] = R.v[i][2] * gsc; d[3] = R.v[i][3] * gsc; }
    LDS_WAIT(); asm volatile("" ::: "memory");
    const int c = lane & 7;
#pragma unroll
    for (int j = 0; j < 4; ++j) { const int n = (lane >> 3) + 8 * j; const LAS float* s = scr + (8 * c) * 33 + n;
        u32x4 o; o.x = pk2(s[0 * 33], s[1 * 33]); o.y = pk2(s[2 * 33], s[3 * 33]); o.z = pk2(s[4 * 33], s[5 * 33]); o.w = pk2(s[6 * 33], s[7 * 33]);
        const size_t eo = (size_t)rowmap(jb.type, jb.roff, n0 + n) * jb.K + k0 + 8 * c;
        if (jb.fp8) { int lo = __builtin_amdgcn_cvt_pk_fp8_f32(s[0 * 33], s[1 * 33], 0, false); lo = __builtin_amdgcn_cvt_pk_fp8_f32(s[2 * 33], s[3 * 33], lo, true);
            int hi = __builtin_amdgcn_cvt_pk_fp8_f32(s[4 * 33], s[5 * 33], 0, false); hi = __builtin_amdgcn_cvt_pk_fp8_f32(s[6 * 33], s[7 * 33], hi, true);
            *(GAS u32x2*)((unsigned char*)jb.dst + eo) = (u32x2){(unsigned)lo, (unsigned)hi}; }
        else *(GAS u32x4*)((bf16*)jb.dst + eo) = o; }
    LDS_WAIT(); asm volatile("" ::: "memory");
}
__device__ __forceinline__ float softcap(float z) { return SOFTCAP * tanhf(z * (1.0f / SOFTCAP)); }
__device__ __forceinline__ void skinny16(const float* x0, const LAS float* G, bf16* xb0, int lane, f32x4& D, float& ssq) {
    const int r = lane & 15, kq = lane >> 4;
    const GAS f32x4* xp = (const GAS f32x4*)(x0 + (size_t)r * DM) + kq; const LAS f32x4* gp = (const LAS f32x4*)G + lane;
    D = (f32x4){0.f, 0.f, 0.f, 0.f}; float ss = 0.f;
#pragma unroll 8
    for (int s = 0; s < 64; ++s) { const f32x4 a = xp[4 * s]; const f32x4 g = gp[64 * s];
        ss += (a[0] * a[0] + a[1] * a[1]) + (a[2] * a[2] + a[3] * a[3]);
        D = __builtin_amdgcn_mfma_f32_16x16x4f32(a[0], g[0], D, 0, 0, 0); D = __builtin_amdgcn_mfma_f32_16x16x4f32(a[1], g[1], D, 0, 0, 0);
        D = __builtin_amdgcn_mfma_f32_16x16x4f32(a[2], g[2], D, 0, 0, 0); D = __builtin_amdgcn_mfma_f32_16x16x4f32(a[3], g[3], D, 0, 0, 0);
        if (xb0) *(GAS u32x2*)(xb0 + (size_t)r * DM + 16 * s + 4 * kq) = (u32x2){pk2(a[0], a[1]), pk2(a[2], a[3])}; }
    ss += __shfl_xor(ss, 16); ss += __shfl_xor(ss, 32); ssq = ss;
}
__device__ __forceinline__ void p0_prologue(const Args& A, Frame& F) {
    const int gw = F.vcu * NWAVES + F.wave, NGW = F.G * NWAVES;
    {   LAS float* scr = (LAS float*)(F.lds + RING_OFF + F.wave * 16384);
        int it = gw; Job jb; int local; P0Regs R;
        if (it < P0_ITEMS) { get_job(A, F, it, jb, local); p0_load(jb, local, F.lane, R); }
        while (it < P0_ITEMS) {
            const int itn = it + NGW; Job jn = jb; int ln = local; P0Regs Rn = R;
            if (itn < P0_ITEMS) { get_job(A, F, itn, jn, ln); p0_load(jn, ln, F.lane, Rn); }
            p0_store(jb, local, scr, F.lane, R);
            jb = jn; local = ln; R = Rn; it = itn; } }
    __syncthreads();
    LAS float* Wg = (LAS float*)(F.lds + RING_OFF);
    for (int i = F.tid; i < DM * 16; i += NWAVES * 64) { const int k = i >> 4, j = i & 15; Wg[((k >> 2) * 16 + j) * 4 + (k & 3)] = A.in[I_WIN][(size_t)k * MPROJ + MPROJ_MAIN + j] * A.in[I_MIXN][k]; }
    LAS float* rsx = (LAS float*)(F.lds + RING_OFF + 65536) + F.wave * 16;
    __syncthreads();
    bf16* xb = (bf16*)(F.ws + WS_A); float* ss0 = (float*)(F.ws + T_SS0); float* gates = (float*)(F.ws + T_GATES);
    for (int tile = gw; tile < MTOK / 16; tile += NGW) {
        const int row0 = tile * 16; f32x4 D; float ssq;
        skinny16(A.in[I_X] + (size_t)row0 * DM, Wg, xb + (size_t)row0 * DM, F.lane, D, ssq);
        if (F.lane < 16) { ss0[row0 + F.lane] = ssq; rsx[F.lane] = rsqrtf(ssq * (1.0f / DM) + EPS); }
        LDS_WAIT(); asm volatile("" ::: "memory");
        const int n = F.lane & 15, rq = F.lane >> 4; const f32x4 rs4 = *(const LAS f32x4*)(rsx + 4 * rq); const float bias = n < 8 ? A.in[I_BI][n] : A.in[I_BF][n - 8];
#pragma unroll
        for (int q = 0; q < 4; ++q) { float z = softcap(D[q] * rs4[q] + bias); if (n >= 8) z = -log1pf(expf(-z)); gates[(size_t)(row0 + 4 * rq + q) * 16 + n] = z; }
        LDS_WAIT(); asm volatile("" ::: "memory");
    }
}
__device__ __forceinline__ void mlstm_simple(const Args& A, Frame& F) {
    LAS float* Lq = (LAS float*)(F.lds + RING_OFF);
    LAS float* Lk = Lq + 4096;
    LAS float* Lv = Lk + 4096;
    LAS float* Lh = Lv + 8192;
    LAS float* Lg = Lh + 8192;
    const bf16* Q = (const bf16*)(F.ws + B_Q); const bf16* Kk = (const bf16*)(F.ws + B_K); const bf16* VT = (const bf16*)(F.ws + B_VT); const bf16* OG = (const bf16*)(F.ws + B_OG);
    bf16* HN = (bf16*)(F.ws + B_HN); const float* gates = (const float*)(F.ws + T_GATES); const float* gh = A.in[I_GH];
    const int tid = F.tid, v = tid >> 2, qd = tid & 3;
    for (int u = blockIdx.x; u < NBATCH * MH; u += F.G) {
        const int b = u >> 3, h = u & 7;
        float C[16], n[16];
#pragma unroll
        for (int j = 0; j < 16; ++j) { C[j] = 0.f; n[j] = 0.f; }
        for (int c = 0; c < SEQ / 64; ++c) {
            const size_t row0 = (size_t)b * SEQ + c * 64;
            { const int r = tid >> 3, cc = (tid & 7) * 8;
              const u32x4 a = *(const GAS u32x4*)(Q + (row0 + r) * 512 + h * 64 + cc), bb = *(const GAS u32x4*)(Kk + (row0 + r) * 512 + h * 64 + cc);
#pragma unroll
              for (int i = 0; i < 4; ++i) { Lq[r * 64 + cc + 2 * i] = bf2f((unsigned short)(a[i] & 0xffff)); Lq[r * 64 + cc + 2 * i + 1] = bf2f((unsigned short)(a[i] >> 16));
                                            Lk[r * 64 + cc + 2 * i] = bf2f((unsigned short)(bb[i] & 0xffff)); Lk[r * 64 + cc + 2 * i + 1] = bf2f((unsigned short)(bb[i] >> 16)); } }
#pragma unroll
            for (int j = 0; j < 2; ++j) { const int idx = tid + 512 * j, dv = idx >> 3, tc = (idx & 7) * 8; const u32x4 a = *(const GAS u32x4*)(VT + ((size_t)(b * MH + h) * MDV + dv) * SEQ + c * 64 + tc);
#pragma unroll
              for (int i = 0; i < 4; ++i) { Lv[(tc + 2 * i) * 128 + dv] = bf2f((unsigned short)(a[i] & 0xffff)); Lv[(tc + 2 * i + 1) * 128 + dv] = bf2f((unsigned short)(a[i] >> 16)); } }
            if (tid < 64) { Lg[tid * 2] = expf(gates[(row0 + tid) * 16 + h]); Lg[tid * 2 + 1] = expf(gates[(row0 + tid) * 16 + 8 + h]); }
            __syncthreads();
            for (int t = 0; t < 64; ++t) {
                const float ii = Lg[2 * t], ff = Lg[2 * t + 1], vv = Lv[t * 128 + v] * ii;
                float num = 0.f, den = 0.f;
#pragma unroll
                for (int j4 = 0; j4 < 4; ++j4) { const f32x4 k4 = *(const LAS f32x4*)(Lk + t * 64 + 16 * qd + 4 * j4), q4 = *(const LAS f32x4*)(Lq + t * 64 + 16 * qd + 4 * j4);
#pragma unroll
                    for (int j = 0; j < 4; ++j) { const int jj = 4 * j4 + j; C[jj] = ff * C[jj] + vv * k4[j]; n[jj] = ff * n[jj] + ii * k4[j]; num += C[jj] * q4[j]; den += n[jj] * q4[j]; } }
                num += __shfl_xor(num, 1); num += __shfl_xor(num, 2); den += __shfl_xor(den, 1); den += __shfl_xor(den, 2);
                if (qd == 0) Lh[t * 128 + v] = num / fmaxf(fabsf(den), 1.0f);
            }
            __syncthreads();
#pragma unroll 1
            for (int tt = 0; tt < 8; ++tt) { const int t = F.wave * 8 + tt; const float a0 = Lh[t * 128 + F.lane], a1 = Lh[t * 128 + 64 + F.lane];
                const float rinv = rsqrtf(wave_sum(a0 * a0 + a1 * a1) * (1.0f / 128.0f) + EPS);
                const size_t o = (row0 + t) * 1024 + h * 128 + F.lane;
                HN[o] = (bf16)f2bf(a0 * rinv * gh[h * 128 + F.lane] * bf2f(OG[o])); HN[o + 64] = (bf16)f2bf(a1 * rinv * gh[h * 128 + 64 + F.lane] * bf2f(OG[o + 64])); }
            __syncthreads();
        }
    }
}

__device__ __forceinline__ void sb_simple(Frame& F) {
    const bf16* Kb = (const bf16*)(F.ws + B_SBK); const bf16* Vt = (const bf16*)(F.ws + B_SBVT); bf16* QO = (bf16*)(F.ws + B_SBQ);
    const int gw = F.vcu * NWAVES + F.wave, NGW = F.G * NWAVES;
    for (int item = gw; item < NBATCH * SBH * (SEQ / 64); item += NGW) {
        const int bh = item >> 6, tb = item & 63, b = bh >> 4, h = bh & 15, t = tb * 64 + F.lane; const size_t row = (size_t)b * SEQ + t;
        float q[64], o[64];
#pragma unroll
        for (int c = 0; c < 8; ++c) { const u32x4 a = *(const GAS u32x4*)(QO + row * 1024 + h * 64 + 8 * c);
#pragma unroll
            for (int i = 0; i < 4; ++i) { q[8 * c + 2 * i] = bf2f((unsigned short)(a[i] & 0xffff)); q[8 * c + 2 * i + 1] = bf2f((unsigned short)(a[i] >> 16)); } }
#pragma unroll
        for (int d = 0; d < 64; ++d) o[d] = 0.f;
        float carry = 0.f;
        for (int s8 = tb * 64 + 56; s8 >= 0; s8 -= 8) {
            float aa[8];
#pragma unroll
            for (int kk = 7; kk >= 0; --kk) { const int s = s8 + kk; const GAS u32x4* kr = (const GAS u32x4*)(Kb + ((size_t)b * SEQ + s) * 1024 + h * 64);
                float z = 0.f;
#pragma unroll
                for (int c = 0; c < 8; ++c) { const u32x4 a = kr[c];
#pragma unroll
                    for (int i = 0; i < 4; ++i) { z += q[8 * c + 2 * i] * bf2f((unsigned short)(a[i] & 0xffff)); z += q[8 * c + 2 * i + 1] * bf2f((unsigned short)(a[i] >> 16)); } }
                const bool valid = s < t; const float l1p = log2f(1.0f + exp2f(z));
                aa[kk] = valid ? exp2f(z - l1p + carry) : 0.f; carry += valid ? -l1p : 0.f; }
#pragma unroll
            for (int d = 0; d < 64; ++d) { const u32x4 a = *(const GAS u32x4*)(Vt + ((size_t)bh * 64 + d) * SEQ + s8); float acc = o[d];
#pragma unroll
                for (int i = 0; i < 4; ++i) { acc += aa[2 * i] * bf2f((unsigned short)(a[i] & 0xffff)); acc += aa[2 * i + 1] * bf2f((unsigned short)(a[i] >> 16)); }
                o[d] = acc; }
        }
#pragma unroll
        for (int c = 0; c < 8; ++c) { u32x4 w; w.x = pk2(o[8 * c], o[8 * c + 1]); w.y = pk2(o[8 * c + 2], o[8 * c + 3]); w.z = pk2(o[8 * c + 4], o[8 * c + 5]); w.w = pk2(o[8 * c + 6], o[8 * c + 7]);
            *(GAS u32x4*)(QO + row * 1024 + h * 64 + 8 * c) = w; }
    }
}

__device__ __forceinline__ void router_phase(const Args& A, Frame& F) {
    LAS float* Wr = (LAS float*)(F.lds + RING_OFF);
    LAS int* hist = (LAS int*)(F.lds + RING_OFF + 65536);
    LAS float* lg = (LAS float*)(F.lds + RING_OFF + 65536 + 64) + F.wave * 272;
    for (int i = F.tid; i < DM * 16; i += NWAVES * 64) { const int k = i >> 4, j = i & 15; Wr[((k >> 2) * 16 + j) * 4 + (k & 3)] = j < NEXP ? A.in[I_WR][k * NEXP + j] * A.in[I_FFNN][DM + k] : 0.f; }
    if (F.tid < NEXP) hist[F.tid] = 0;
    __syncthreads();
    int* sele = (int*)(F.ws + T_SELE); float* selw1 = (float*)(F.ws + T_SELW1); float* selw2 = (float*)(F.ws + T_SELW2); float* selrs = (float*)(F.ws + T_SELRS);
    const int TPW = MTOK / F.G;
    for (int i = F.wave * 16; i < TPW; i += NWAVES * 16) {
        const int tok0 = blockIdx.x * TPW + i; f32x4 D; float ssq;
        skinny16(F.out + (size_t)tok0 * DM, Wr, nullptr, F.lane, D, ssq);
        const int n = F.lane & 15, rq = F.lane >> 4;
#pragma unroll
        for (int q = 0; q < 4; ++q) lg[(4 * rq + q) * 16 + n] = D[q];
        if (F.lane < 16) lg[256 + F.lane] = rsqrtf(ssq * (1.0f / DM) + EPS);
        LDS_WAIT(); asm volatile("" ::: "memory");
        if (F.lane < 16) { const f32x4 l0 = *(const LAS f32x4*)(lg + F.lane * 16), l1 = *(const LAS f32x4*)(lg + F.lane * 16 + 4); const float rs = lg[256 + F.lane];
            const float s[8] = {l0[0], l0[1], l0[2], l0[3], l1[0], l1[1], l1[2], l1[3]};
            float b1 = s[0]; int i1 = 0;
#pragma unroll
            for (int e = 1; e < 8; ++e) if (s[e] > b1) { b1 = s[e]; i1 = e; }
            float b2 = -3.0e38f; int i2 = 0;
#pragma unroll
            for (int e = 0; e < 8; ++e) if (e != i1 && s[e] > b2) { b2 = s[e]; i2 = e; }
            const float w1 = 1.0f / (1.0f + expf((b2 - b1) * rs)), w2 = 1.0f - w1;
            const int tok = tok0 + F.lane; sele[tok] = i1 | (i2 << 8); selw1[tok] = w1; selw2[tok] = w2; selrs[tok] = rs;
            __hip_atomic_fetch_add(hist + i1, 1, __ATOMIC_RELAXED, __HIP_MEMORY_SCOPE_WORKGROUP); __hip_atomic_fetch_add(hist + i2, 1, __ATOMIC_RELAXED, __HIP_MEMORY_SCOPE_WORKGROUP); }
        LDS_WAIT(); asm volatile("" ::: "memory");
    }
    __syncthreads();
    if (F.tid < NEXP) ((int*)(F.ctl + CW_CNT))[blockIdx.x * NEXP + F.tid] = hist[F.tid];
}
__device__ __forceinline__ void slots_phase(Frame& F) {
    LAS int* cn = (LAS int*)(F.lds + RING_OFF);
    LAS int* tot = cn + 2048; LAS int* pre = tot + 8; LAS int* sst = pre + 8; LAS int* tst = sst + 8; LAS int* ntl = tst + 8; LAS int* le = ntl + 16;
    const int TPW = MTOK / F.G; const int w = blockIdx.x;
    for (int i = F.tid; i < F.G * NEXP; i += NWAVES * 64) cn[i] = ((const int*)(F.ctl + CW_CNT))[i];
    __syncthreads();
    if (F.tid < NEXP) { int t = 0, p = 0; for (int ww = 0; ww < F.G; ++ww) { const int c = cn[ww * NEXP + F.tid]; t += c; if (ww < w) p += c; } tot[F.tid] = t; pre[F.tid] = p; }
    __syncthreads();
    if (F.tid == 0) { int ts = 0; for (int e = 0; e < NEXP; ++e) { const int nt = (tot[e] + 255) >> 8; tst[e] = ts; sst[e] = ts * 256; ntl[e] = nt; ts += nt; } ntl[8] = ts; }
    const int* sele = (const int*)(F.ws + T_SELE); const float* selw1 = (const float*)(F.ws + T_SELW1); const float* selw2 = (const float*)(F.ws + T_SELW2); const float* selrs = (const float*)(F.ws + T_SELRS);
    int* slt = (int*)(F.ws + T_SLOT);
#define SL_TOK(s) slt[((s) >> 8) * 1024 + ((s) & 255)]
#define SL_RS(s) ((float*)slt)[((s) >> 8) * 1024 + 256 + ((s) & 255)]
#define SL_W(s) ((float*)slt)[((s) >> 8) * 1024 + 512 + ((s) & 255)]
#define SL_YROW(s) slt[((s) >> 8) * 1024 + 768 + ((s) & 255)]
    if (F.tid < TPW) le[F.tid] = sele[w * TPW + F.tid];
    __syncthreads();
    if (F.tid < 2 * TPW) { const int tl = F.tid >> 1, j = F.tid & 1, mine = le[tl], e = j ? (mine >> 8) : (mine & 255); int rank = 0;
        for (int t2 = 0; t2 < tl; ++t2) { const int o = le[t2]; rank += ((o & 255) == e || (o >> 8) == e) ? 1 : 0; }
        const int slot = sst[e] + pre[e] + rank, token = w * TPW + tl;
        SL_TOK(slot) = token; SL_YROW(slot) = 2 * token + j; SL_RS(slot) = selrs[token]; SL_W(slot) = j ? selw2[token] : selw1[token]; }
    if (w < NEXP) { const int e = w, lo = sst[e] + tot[e], hi = sst[e] + 256 * ntl[e]; for (int s = lo + F.tid; s < hi; s += NWAVES * 64) { SL_TOK(s) = 0; SL_YROW(s) = -1; SL_RS(s) = 0.f; SL_W(s) = 0.f; } }
    if (w == 0) { if (F.tid == 0) ((int*)(F.ctl + CW_MOE))[0] = ntl[8];
        for (int e = 0; e < NEXP; ++e) for (int t = F.tid; t < ntl[e]; t += NWAVES * 64) ((int*)(F.ctl + CW_TEXP))[tst[e] + t] = e; }
}
__device__ __forceinline__ void combine_phase(Frame& F) {
    const bf16* x3b = (const bf16*)(F.ws + WS_A);
    const int gw = F.vcu * NWAVES + F.wave, NGW = F.G * NWAVES;
    for (int tokn = gw; tokn < MTOK; tokn += NGW) {
        const GAS u32x4* yp = (const GAS u32x4*)((const unsigned char*)F.out + (size_t)tokn * 4096); const GAS u32x4* xp = (const GAS u32x4*)(x3b + (size_t)tokn * DM);
        u32x4 y0[2], y1[2], xx[2];
#pragma unroll
        for (int p = 0; p < 2; ++p) { y0[p] = yp[64 * p + F.lane]; y1[p] = yp[128 + 64 * p + F.lane]; xx[p] = xp[64 * p + F.lane]; }
        asm volatile("s_waitcnt vmcnt(0)" ::: "memory");
        GAS f32x4* op = (GAS f32x4*)((unsigned char*)F.out + (size_t)tokn * 4096);
#pragma unroll
        for (int p = 0; p < 2; ++p) { f32x4 r0, r1;
#pragma unroll
            for (int i = 0; i < 2; ++i) { r0[2 * i] = bf2f((unsigned short)(xx[p][i] & 0xffff)) + bf2f((unsigned short)(y0[p][i] & 0xffff)) + bf2f((unsigned short)(y1[p][i] & 0xffff));
                r0[2 * i + 1] = bf2f((unsigned short)(xx[p][i] >> 16)) + bf2f((unsigned short)(y0[p][i] >> 16)) + bf2f((unsigned short)(y1[p][i] >> 16));
                r1[2 * i] = bf2f((unsigned short)(xx[p][i + 2] & 0xffff)) + bf2f((unsigned short)(y0[p][i + 2] & 0xffff)) + bf2f((unsigned short)(y1[p][i + 2] & 0xffff));
                r1[2 * i + 1] = bf2f((unsigned short)(xx[p][i + 2] >> 16)) + bf2f((unsigned short)(y0[p][i + 2] >> 16)) + bf2f((unsigned short)(y1[p][i + 2] >> 16)); }
            op[128 * p + 2 * F.lane] = r0; op[128 * p + 2 * F.lane + 1] = r1; }
    }
}
typedef __bf16 bf16x2_t __attribute__((ext_vector_type(2)));
__device__ __forceinline__ unsigned cvtpk(float lo, float hi) { f32x2 v = {lo, hi}; return __builtin_bit_cast(unsigned, __builtin_convertvector(v, bf16x2_t)); }
__device__ __forceinline__ void sb_fast(Frame& F) {
    const bf16* Kb = (const bf16*)(F.ws + B_SBK); const bf16* Vt = (const bf16*)(F.ws + B_SBVT); bf16* QO = (bf16*)(F.ws + B_SBQ);
    const int lane = F.lane, c = lane & 31, h = lane >> 5;
    const int pic = (c & 16) + ((c >> 2) & 1) * 8 + ((c >> 3) & 1) * 4 + (c & 3);
    for (int chunk = F.vcu; chunk < NBATCH * SBH * (SEQ / 32) / NWAVES; chunk += F.G) {
        const int item = chunk * NWAVES + F.wave, bh = item >> 7, qb = item & 127, b = bh >> 4, hd = bh & 15, t0 = qb * 32;
        bf16* qp = QO + ((size_t)(b * SEQ + t0 + c) * 1024 + hd * 64 + 8 * h);
        bf16x8 qf[4];
#pragma unroll
        for (int ks = 0; ks < 4; ++ks) qf[ks] = *(const GAS bf16x8*)(qp + 16 * ks);
        f32x16 O0, O1;
#pragma unroll
        for (int i = 0; i < 16; ++i) { O0[i] = 0.f; O1[i] = 0.f; }
        float carry = 1.0f;
        const bf16* kbase = Kb + ((size_t)(b * SEQ + pic) * 1024 + hd * 64 + 8 * h);
        const bf16* vbase = Vt + ((size_t)(bh * 64 + c) * SEQ + 8 * h);
        bf16x8 kf[4], vf[4];
#define SB_LOAD(KF, VF, KB) do { const bf16* _k = kbase + (size_t)(KB) * 32 * 1024; const bf16* _v = vbase + (KB) * 32; \
            _Pragma("unroll") for (int ks = 0; ks < 4; ++ks) KF[ks] = *(const GAS bf16x8*)(_k + 16 * ks); \
            _Pragma("unroll") for (int dt = 0; dt < 2; ++dt) _Pragma("unroll") for (int s = 0; s < 2; ++s) VF[dt * 2 + s] = *(const GAS bf16x8*)(_v + (size_t)dt * 32 * SEQ + 16 * s); } while (0)
        int kb = qb;
        SB_LOAD(kf, vf, kb);
        for (;;) {
            bf16x8 kn[4], vn[4];
#pragma unroll
            for (int i = 0; i < 4; ++i) { kn[i] = kf[i]; vn[i] = vf[i]; }
            if (kb > 0) SB_LOAD(kn, vn, kb - 1);
            f32x16 X;
#pragma unroll
            for (int i = 0; i < 16; ++i) X[i] = 0.f;
#pragma unroll
            for (int ks = 0; ks < 4; ++ks) X = __builtin_amdgcn_mfma_f32_32x32x16_bf16(kf[ks], qf[ks], X, 0, 0, 0);
            float e[16], r[16];
#pragma unroll
            for (int i = 0; i < 16; ++i) e[i] = __builtin_amdgcn_exp2f(X[i]);
            if (kb == qb) {
#pragma unroll
                for (int i = 0; i < 16; ++i) { const int ko = 16 * (i >> 3) + 8 * h + (i & 7); e[i] = ko < c ? e[i] : 0.f; } }
#pragma unroll
            for (int i = 0; i < 16; ++i) r[i] = __builtin_amdgcn_rcpf(1.0f + e[i]);
            float EA[8], EB[8]; EA[7] = 1.0f; EB[7] = 1.0f;
#pragma unroll
            for (int i = 6; i >= 0; --i) { EA[i] = EA[i + 1] * r[i + 1]; EB[i] = EB[i + 1] * r[8 + i + 1]; }
            const float GA = EA[0] * r[0], GB = EB[0] * r[8];
            const float pGA = __shfl_xor(GA, 32), pGB = __shfl_xor(GB, 32);
            const float TB = h ? carry : carry * pGB;
            const float TA = (carry * pGB) * GB * (h ? 1.0f : pGA);
            carry = ((carry * GA) * GB) * (pGA * pGB);
            float a[16];
#pragma unroll
            for (int i = 0; i < 8; ++i) { a[i] = (EA[i] * TA) * (e[i] * r[i]); a[8 + i] = (EB[i] * TB) * (e[8 + i] * r[8 + i]); }
            u32x4 p0, p1;
            p0.x = cvtpk(a[0], a[1]); p0.y = cvtpk(a[2], a[3]); p0.z = cvtpk(a[4], a[5]); p0.w = cvtpk(a[6], a[7]);
            p1.x = cvtpk(a[8], a[9]); p1.y = cvtpk(a[10], a[11]); p1.z = cvtpk(a[12], a[13]); p1.w = cvtpk(a[14], a[15]);
            const bf16x8 af0 = __builtin_bit_cast(bf16x8, p0), af1 = __builtin_bit_cast(bf16x8, p1);
            O0 = __builtin_amdgcn_mfma_f32_32x32x16_bf16(vf[0], af0, O0, 0, 0, 0); O0 = __builtin_amdgcn_mfma_f32_32x32x16_bf16(vf[1], af1, O0, 0, 0, 0);
            O1 = __builtin_amdgcn_mfma_f32_32x32x16_bf16(vf[2], af0, O1, 0, 0, 0); O1 = __builtin_amdgcn_mfma_f32_32x32x16_bf16(vf[3], af1, O1, 0, 0, 0);
            if (kb == 0) break;
            if (!__any(carry >= 1.17549435e-38f)) break;
            --kb;
#pragma unroll
            for (int i = 0; i < 4; ++i) { kf[i] = kn[i]; vf[i] = vn[i]; }
        }
#undef SB_LOAD
#pragma unroll
        for (int g = 0; g < 4; ++g) {
            u32x2 w0, w1; w0.x = cvtpk(O0[4 * g], O0[4 * g + 1]); w0.y = cvtpk(O0[4 * g + 2], O0[4 * g + 3]); w1.x = cvtpk(O1[4 * g], O1[4 * g + 1]); w1.y = cvtpk(O1[4 * g + 2], O1[4 * g + 3]);
            *(GAS u32x2*)(qp - 8 * h + 8 * g + 4 * h) = w0; *(GAS u32x2*)(qp - 8 * h + 32 + 8 * g + 4 * h) = w1; }
    }
}
constexpr int ML_SEG0 = 0, ML_SEG1 = 19, ML_SEG2 = 36, ML_SEG3 = 51, ML_SEG4 = 64;
constexpr int ML_U = 0, ML_MM = 16384, ML_NB = 32768, ML_OM = 49152, ML_MC = 65536, ML_MS = 65792, ML_BL = 66048, ML_UX = 66304, ML_P = 66560, ML_QW = ML_P + 2 * 9216, ML_DEN = ML_QW + 2 * 9216, ML_SS = ML_DEN + 512, ML_END = ML_SS + 4096;
static_assert(ML_END <= RING_BYTES, "mLSTM LDS map");
__device__ __forceinline__ bf16x8 pack_frag(const f32x4 a, const f32x4 b) { u32x4 w; w.x = cvtpk(a[0], a[1]); w.y = cvtpk(a[2], a[3]); w.z = cvtpk(b[0], b[1]); w.w = cvtpk(b[2], b[3]); return __builtin_bit_cast(bf16x8, w); }
__device__ __forceinline__ bf16x8 scale_frag(const bf16x8 v, const f32x4 w0, const f32x4 w1) {
    const u32x4 x = __builtin_bit_cast(u32x4, v); f32x4 a, b;
    a[0] = __builtin_bit_cast(float, x[0] << 16) * w0[0]; a[1] = __builtin_bit_cast(float, x[0] & 0xffff0000u) * w0[1]; a[2] = __builtin_bit_cast(float, x[1] << 16) * w0[2]; a[3] = __builtin_bit_cast(float, x[1] & 0xffff0000u) * w0[3];
    b[0] = __builtin_bit_cast(float, x[2] << 16) * w1[0]; b[1] = __builtin_bit_cast(float, x[2] & 0xffff0000u) * w1[1]; b[2] = __builtin_bit_cast(float, x[3] << 16) * w1[2]; b[3] = __builtin_bit_cast(float, x[3] & 0xffff0000u) * w1[3];
    return pack_frag(a, b);
}
#define ML_MFMA(a, b, c) __builtin_amdgcn_mfma_f32_16x16x32_bf16((a), (b), (c), 0, 0, 0)
__device__ __forceinline__ void mlstm_fast(const Args& A, Frame& F) {
    LAS unsigned char* L = F.lds + RING_OFF;
    const bf16* Qm = (const bf16*)(F.ws + B_Q); const bf16* Km = (const bf16*)(F.ws + B_K); const bf16* KT = (const bf16*)F.out; const bf16* VT = (const bf16*)(F.ws + B_VT);
    const bf16* OG = (const bf16*)(F.ws + B_OG); bf16* HN = (bf16*)(F.ws + B_HN); const float* gates = (const float*)(F.ws + T_GATES);
    const int tid = F.tid, lane = F.lane, w = F.wave, c = lane & 15, q4 = lane >> 4;
    for (int unit = blockIdx.x; unit < NBATCH * MH * 4; unit += F.G) {
        const int bh = unit >> 2, seg = unit & 3, b = bh >> 3, h = bh & 7;
        const int c_full = seg == 0 ? ML_SEG0 : seg == 1 ? ML_SEG1 : seg == 2 ? ML_SEG2 : ML_SEG3, c_end = seg == 0 ? ML_SEG1 : seg == 1 ? ML_SEG2 : seg == 2 ? ML_SEG3 : ML_SEG4;
        const size_t rowb = (size_t)b * SEQ;
        __syncthreads();
        for (int cc = w; cc < c_end; cc += NWAVES) {
            const size_t row = rowb + cc * 64 + lane;
            const float ig2 = gates[row * 16 + h] * LOG2E, lf2 = gates[row * 16 + 8 + h] * LOG2E;
            float bb = lf2;
#pragma unroll
            for (int o = 1; o < 64; o <<= 1) { const float t = __shfl_up(bb, o); if (lane >= o) bb += t; }
            const float u = ig2 - bb; float pm = u;
#pragma unroll
            for (int o = 1; o < 64; o <<= 1) { const float t = __shfl_up(pm, o); if (lane >= o) pm = fmaxf(pm, t); }
            ((LAS float*)(L + ML_U))[cc * 64 + lane] = u; ((LAS float*)(L + ML_MM))[cc * 64 + lane] = pm; ((LAS float*)(L + ML_NB))[cc * 64 + lane] = -bb;
            if (lane == 63) { ((LAS float*)(L + ML_BL))[cc] = bb; ((LAS float*)(L + ML_UX))[cc] = pm; }
        }
        __syncthreads();
        if (tid == 0) { float m = -__builtin_inff(); for (int cc = 0; cc < c_end; ++cc) { ((LAS float*)(L + ML_MC))[cc] = m; const float ms = fmaxf(m, ((LAS float*)(L + ML_UX))[cc]); ((LAS float*)(L + ML_MS))[cc] = ms; m = ((LAS float*)(L + ML_BL))[cc] + ms; } }
        __syncthreads();
        for (int cc = w; cc < c_end; cc += NWAVES) {
            const float mc = ((LAS float*)(L + ML_MC))[cc], ms = ((LAS float*)(L + ML_MS))[cc];
            const float u = ((LAS float*)(L + ML_U))[cc * 64 + lane], mm = fmaxf(mc, ((LAS float*)(L + ML_MM))[cc * 64 + lane]);
            ((LAS float*)(L + ML_MM))[cc * 64 + lane] = mm; ((LAS float*)(L + ML_NB))[cc * 64 + lane] += -mm; ((LAS float*)(L + ML_OM))[cc * 64 + lane] = __builtin_amdgcn_exp2f(u - ms);
        }
        __syncthreads();
        f32x4 Ct[4], Cn[4];
#pragma unroll
        for (int i = 0; i < 4; ++i) { Ct[i] = (f32x4){0.f, 0.f, 0.f, 0.f}; Cn[i] = (f32x4){0.f, 0.f, 0.f, 0.f}; }
        const bf16* ktp = KT + ((size_t)(bh * MDK + c) * SEQ + rowb * 0 + 8 * q4);
        const bf16* vtp = VT + ((size_t)(bh * MDV + 16 * w + c) * SEQ + 8 * q4);
        const bf16x8 onesf = __builtin_bit_cast(bf16x8, (u32x4){0x3f803f80u, 0x3f803f80u, 0x3f803f80u, 0x3f803f80u});
        const bf16x8 zerof = __builtin_bit_cast(bf16x8, (u32x4){0u, 0u, 0u, 0u});
        bf16x8 kt[4][2], vt[2];
#define ML_LOADKV(KT_, VT_, CC) do { const int _t0 = (CC) * 64; _Pragma("unroll") for (int i = 0; i < 4; ++i) _Pragma("unroll") for (int ks = 0; ks < 2; ++ks) KT_[i][ks] = *(const GAS bf16x8*)(ktp + (size_t)16 * i * SEQ + _t0 + 32 * ks); \
            _Pragma("unroll") for (int ks = 0; ks < 2; ++ks) VT_[ks] = *(const GAS bf16x8*)(vtp + _t0 + 32 * ks); } while (0)
        ML_LOADKV(kt, vt, 0);
        for (int cc = 0; cc < c_end; ++cc) {
            const int par = cc & 1, t0 = cc * 64; const bool full = cc >= c_full;
            bf16x8 ktn[4][2], vtn[2];
#pragma unroll
            for (int i = 0; i < 4; ++i) { ktn[i][0] = kt[i][0]; ktn[i][1] = kt[i][1]; }
            vtn[0] = vt[0]; vtn[1] = vt[1];
            if (cc + 1 < c_end) ML_LOADKV(ktn, vtn, cc + 1);
            const float mc = ((LAS float*)(L + ML_MC))[cc], ms = ((LAS float*)(L + ML_MS))[cc];
            const float adec = __builtin_amdgcn_exp2f(mc - ms);
            LAS unsigned char* Pb = L + ML_P + par * 9216; LAS unsigned char* Qb = L + ML_QW + par * 9216;
            bf16x8 cf[2], cnf[2];
            if (full) {
#pragma unroll
                for (int ks = 0; ks < 2; ++ks) { cf[ks] = pack_frag(Ct[2 * ks], Ct[2 * ks + 1]); cnf[ks] = pack_frag(Cn[2 * ks], Cn[2 * ks + 1]); }
                { const int t = tid >> 3, ch = tid & 7; const u32x4 qv = *(const GAS u32x4*)(Qm + (rowb + t0 + t) * 512 + h * 64 + 8 * ch);
                  const float wi = __builtin_amdgcn_exp2f(mc - ((LAS float*)(L + ML_MM))[cc * 64 + t]); const f32x4 w4 = (f32x4){wi, wi, wi, wi};
                  *(LAS bf16x8*)(Qb + t * 144 + ch * 16) = scale_frag(__builtin_bit_cast(bf16x8, qv), w4, w4); }
                { const int tt = w & 3, sh = w >> 2;
                  if (2 * sh <= tt) {
                    bf16x8 qf[2];
#pragma unroll
                    for (int ks = 0; ks < 2; ++ks) qf[ks] = *(const GAS bf16x8*)(Qm + (rowb + t0 + 16 * tt + c) * 512 + h * 64 + 32 * ks + 8 * q4);
                    const float mmt = ((LAS float*)(L + ML_MM))[cc * 64 + 16 * tt + c];
#pragma unroll
                    for (int s2 = 0; s2 < 2; ++s2) { const int st = 2 * sh + s2; u32x2 pw = (u32x2){0u, 0u};
                        if (st <= tt) {
                            f32x4 sT = (f32x4){0.f, 0.f, 0.f, 0.f};
#pragma unroll
                            for (int ks = 0; ks < 2; ++ks) { const bf16x8 kf = *(const GAS bf16x8*)(Km + (rowb + t0 + 16 * st + c) * 512 + h * 64 + 32 * ks + 8 * q4); sT = ML_MFMA(kf, qf[ks], sT); }
                            const f32x4 u4 = *(const LAS f32x4*)(L + ML_U + (cc * 64 + 16 * st + 4 * q4) * 4); f32x4 p;
#pragma unroll
                            for (int r = 0; r < 4; ++r) { const bool ok = (16 * st + 4 * q4 + r) <= (16 * tt + c); p[r] = ok ? sT[r] * __builtin_amdgcn_exp2f(u4[r] - mmt) : 0.f; }
                            pw.x = cvtpk(p[0], p[1]); pw.y = cvtpk(p[2], p[3]); }
                        *(LAS u32x2*)(Pb + (16 * tt + c) * 144 + (16 * st + 4 * q4) * 2) = pw; } } }
            }
            bf16x8 vw[2], ow[2];
#pragma unroll
            for (int ks = 0; ks < 2; ++ks) { const f32x4 o0 = *(const LAS f32x4*)(L + ML_OM + (cc * 64 + 32 * ks + 8 * q4) * 4), o1 = *(const LAS f32x4*)(L + ML_OM + (cc * 64 + 32 * ks + 8 * q4 + 4) * 4);
                vw[ks] = scale_frag(vt[ks], o0, o1); ow[ks] = (c == 0) ? pack_frag(o0, o1) : zerof; }
#pragma unroll
            for (int i = 0; i < 4; ++i) { Ct[i] = Ct[i] * adec; Ct[i] = ML_MFMA(kt[i][0], vw[0], Ct[i]); Ct[i] = ML_MFMA(kt[i][1], vw[1], Ct[i]); }
            if (w == 4) {
#pragma unroll
                for (int i = 0; i < 4; ++i) { Cn[i] = Cn[i] * adec; Cn[i] = ML_MFMA(kt[i][0], ow[0], Cn[i]); Cn[i] = ML_MFMA(kt[i][1], ow[1], Cn[i]); } }
            if (full) {
                asm volatile("s_waitcnt lgkmcnt(0)" ::: "memory"); __syncthreads();
                f32x4 nT[4], dT[4];
#pragma unroll
                for (int tt = 0; tt < 4; ++tt) { nT[tt] = (f32x4){0.f, 0.f, 0.f, 0.f}; dT[tt] = (f32x4){0.f, 0.f, 0.f, 0.f}; }
#pragma unroll
                for (int tt = 0; tt < 4; ++tt) {
#pragma unroll
                    for (int ks = 0; ks < 2; ++ks) {
                        if (ks == 0 || tt >= 2) { const bf16x8 pf = *(const LAS bf16x8*)(Pb + (16 * tt + c) * 144 + (32 * ks + 8 * q4) * 2);
                            nT[tt] = ML_MFMA(vt[ks], pf, nT[tt]); if (w == 4) dT[tt] = ML_MFMA(c == 0 ? onesf : zerof, pf, dT[tt]); }
                        const u32x2 qa = *(const LAS u32x2*)(Qb + (16 * tt + c) * 144 + (32 * ks + 4 * q4) * 2), qb2 = *(const LAS u32x2*)(Qb + (16 * tt + c) * 144 + (32 * ks + 16 + 4 * q4) * 2);
                        const bf16x8 qwf = __builtin_bit_cast(bf16x8, (u32x4){qa.x, qa.y, qb2.x, qb2.y});
                        nT[tt] = ML_MFMA(cf[ks], qwf, nT[tt]); if (w == 4) dT[tt] = ML_MFMA(cnf[ks], qwf, dT[tt]); } }
                LAS float* DEN = (LAS float*)(L + ML_DEN) + par * 64; LAS float* SS = (LAS float*)(L + ML_SS) + par * 512;
#pragma unroll
                for (int tt = 0; tt < 4; ++tt) { float s = (nT[tt][0] * nT[tt][0] + nT[tt][1] * nT[tt][1]) + (nT[tt][2] * nT[tt][2] + nT[tt][3] * nT[tt][3]); s += __shfl_xor(s, 16); s += __shfl_xor(s, 32);
                    if (q4 == 0) { SS[(16 * tt + c) * 8 + w] = s; if (w == 4) DEN[16 * tt + c] = dT[tt][0]; } }
                asm volatile("s_waitcnt lgkmcnt(0)" ::: "memory"); __syncthreads();
                const f32x4 gh4 = *(const GAS f32x4*)(A.in[I_GH] + h * MDV + 16 * w + 4 * q4);
#pragma unroll
                for (int tt = 0; tt < 4; ++tt) { const int t = 16 * tt + c; const f32x4 s0 = *(const LAS f32x4*)(SS + t * 8), s1 = *(const LAS f32x4*)(SS + t * 8 + 4);
                    const float ssn = ((s0[0] + s0[1]) + (s0[2] + s0[3])) + ((s1[0] + s1[1]) + (s1[2] + s1[3]));
                    const float dn = fmaxf(fabsf(DEN[t]), __builtin_amdgcn_exp2f(((LAS float*)(L + ML_NB))[cc * 64 + t]));
                    const float rinv = rsqrtf(ssn * (1.0f / MDV) + EPS * dn * dn);
                    const size_t o = (rowb + t0 + t) * 1024 + h * MDV + 16 * w + 4 * q4; const u32x2 sg = *(const GAS u32x2*)(OG + o);
                    const float o0 = nT[tt][0] * rinv * gh4[0] * __builtin_bit_cast(float, sg.x << 16), o1 = nT[tt][1] * rinv * gh4[1] * __builtin_bit_cast(float, sg.x & 0xffff0000u);
                    const float o2 = nT[tt][2] * rinv * gh4[2] * __builtin_bit_cast(float, sg.y << 16), o3 = nT[tt][3] * rinv * gh4[3] * __builtin_bit_cast(float, sg.y & 0xffff0000u);
                    *(GAS u32x2*)(HN + o) = (u32x2){cvtpk(o0, o1), cvtpk(o2, o3)}; }
            }
#pragma unroll
            for (int i = 0; i < 4; ++i) { kt[i][0] = ktn[i][0]; kt[i][1] = ktn[i][1]; }
            vt[0] = vtn[0]; vt[1] = vtn[1];
        }
#undef ML_LOADKV
    }
}
constexpr int N_PHASES = 16;
__device__ __forceinline__ void mkframe(const Args& args, Frame& F, LAS unsigned char* lds) {
    F.lds = lds; F.MISC = (volatile LAS unsigned*)(lds + MISC_OFF);
    { int t_ = threadIdx.x; asm volatile("" : "+v"(t_)); F.tid = t_; } F.lane = F.tid & 63; F.wave = __builtin_amdgcn_readfirstlane(F.tid >> 6);
    F.G = gridDim.x; { const int bx = blockIdx.x; F.vcu = (F.G % 8 == 0) ? (bx % 8) * (F.G / 8) + bx / 8 : bx; }
    unsigned char* ws = args.ws; float* out = args.out; asm volatile("" : "+s"(ws), "+s"(out));
    F.ws = ws; F.out = out; F.ctl = (unsigned*)(ws + WS_CTL);
}
__device__ __forceinline__ void grid_barrier(const Args& args, LAS unsigned char* lds) {
    unsigned char* ws = args.ws; asm volatile("" : "+s"(ws));
    XcdBarrier bar; bar.bar = (unsigned*)(ws + WS_CTL) + CW_BAR; bar.x = xb_xcc_id(); bar.st = (volatile LAS unsigned*)(lds + MISC_OFF) + 8;
    xcd_barrier(bar);
}
#ifndef PHASE_MASK
#define PHASE_MASK 0xffff
#endif
template <int LO, int HI>
__global__ void __launch_bounds__(NWAVES * 64, 2) fwd_kernel(Args args) {
    extern __shared__ __attribute__((aligned(16))) unsigned char lds_raw[];
    LAS unsigned char* lds = (LAS unsigned char*)lds_raw;
    for (int u = threadIdx.x; u < (LDS_BYTES - AUX_OFF) / 4; u += NWAVES * 64) ((LAS unsigned*)(lds + AUX_OFF))[u] = 0u;
    __syncthreads();
    if constexpr (HI - LO > 1) { unsigned char* ws = args.ws; (void)xcd_barrier_post((unsigned*)(ws + WS_CTL) + CW_BAR, (volatile LAS unsigned*)(lds + MISC_OFF) + 8); }
#define IN(k) (((PHASE_MASK >> (k)) & 1) && LO <= (k) && (k) < HI)
#define SEAM(k) do { if constexpr (IN(k) && IN((k) + 1)) grid_barrier(args, lds); } while (0)
#ifndef REPEAT_MASK
#define REPEAT_MASK 0
#endif
#define REPS(k) _Pragma("unroll") for (int rep_ = 0; rep_ < (((REPEAT_MASK >> (k)) & 1) ? 2 : 1); ++rep_)
#define RING (F.lds + RING_OFF)
#define AUXB (F.lds + AUX_OFF)
#define RED ((LAS float*)(F.lds + RED_OFF))
#define SSP ((float*)(F.ws + T_SSP))
#define XBUF ((bf16*)(F.ws + WS_A))
    if constexpr (IN(0)) REPS(0) { Frame F; mkframe(args, F, lds); p0_prologue(args, F); } SEAM(0);
    if constexpr (IN(1)) REPS(1) {
        Frame F; mkframe(args, F, lds);
        pg8::Gemm g{XBUF, (const bf16*)(F.ws + WS_WIN), DM}; pg8::StaticOrder S; S.init(MTOK, MPROJ_MAIN, F.G, (int)blockIdx.x);
        pg8::EpiProj E{(bf16*)(F.ws + B_Q), (bf16*)(F.ws + B_K), (bf16*)F.out, (bf16*)(F.ws + B_VT), (bf16*)(F.ws + B_OG), (const float*)(F.ws + T_SS0)};
        pg8::gemm_phase<pg8::EpiProj, pg8::StaticOrder, false>(RING, AUXB, g, S, E);
    } SEAM(1);
    #ifndef ML_SIMPLE
#define ML_SIMPLE 0
#endif
    if constexpr (IN(2)) REPS(2) { Frame F; mkframe(args, F, lds); if constexpr (ML_SIMPLE) mlstm_simple(args, F); else mlstm_fast(args, F); } SEAM(2);
    if constexpr (IN(3)) {
        Frame F; mkframe(args, F, lds);
        pg8::Gemm g{(const bf16*)(F.ws + B_HN), (const bf16*)(F.ws + WS_WOUT), DM}; pg8::StaticOrder S; S.init(MTOK, DM, F.G, (int)blockIdx.x);
        pg8::EpiRes E{args.in[I_X], F.out, XBUF, SSP, RED, nullptr};
        pg8::gemm_phase<pg8::EpiRes, pg8::StaticOrder, false>(RING, AUXB, g, S, E);
    } SEAM(3);
    if constexpr (IN(4)) REPS(4) {
        Frame F; mkframe(args, F, lds);
        pg8::Gemm g{XBUF, (const bf16*)(F.ws + WS_WGU), DM}; pg8::StaticOrder S; S.init(MTOK, 2 * FFN, F.G, (int)blockIdx.x);
        pg8::EpiGu<false> E{F.ws + B_HF, FFN, SSP};
        pg8::gemm_phase<pg8::EpiGu<false>, pg8::StaticOrder, false>(RING, AUXB, g, S, E);
    } SEAM(4);
    if constexpr (IN(5)) {
        Frame F; mkframe(args, F, lds);
        pg8::Gemm g{(const bf16*)(F.ws + B_HF), (const bf16*)(F.ws + WS_WD), FFN}; pg8::StaticOrder S; S.init(MTOK, DM, F.G, (int)blockIdx.x);
        pg8::EpiRes E{F.out, F.out, XBUF, SSP, RED, nullptr};
        pg8::gemm_phase<pg8::EpiRes, pg8::StaticOrder, false>(RING, AUXB, g, S, E);
    } SEAM(5);
    if constexpr (IN(6)) REPS(6) {
        Frame F; mkframe(args, F, lds);
        LAS float* gkq = (LAS float*)(F.lds + TEX_OFF);
        if (F.tid < 64) gkq[F.tid] = args.in[I_GK][F.tid]; else if (F.tid < 128) gkq[F.tid] = args.in[I_GQ][F.tid - 64];
        __syncthreads();
        pg8::Gemm g{XBUF, (const bf16*)(F.ws + WS_WKVQ), DM}; pg8::StaticOrder S; S.init(MTOK, 3 * DM, F.G, (int)blockIdx.x);
        pg8::EpiKvq E{(bf16*)(F.ws + B_SBK), (bf16*)(F.ws + B_SBVT), (bf16*)(F.ws + B_SBQ), SSP, gkq};
        pg8::gemm_phase<pg8::EpiKvq, pg8::StaticOrder, false>(RING, AUXB, g, S, E);
    } SEAM(6);
    #ifndef SB_SIMPLE
#define SB_SIMPLE 0
#endif
    if constexpr (IN(7)) { Frame F; mkframe(args, F, lds); if constexpr (SB_SIMPLE) sb_simple(F); else sb_fast(F); } SEAM(7);
    if constexpr (IN(8)) {
        Frame F; mkframe(args, F, lds);
        pg8::Gemm g{(const bf16*)(F.ws + B_SBQ), (const bf16*)(F.ws + WS_WO), DM}; pg8::StaticOrder S; S.init(MTOK, DM, F.G, (int)blockIdx.x);
        pg8::EpiRes E{F.out, F.out, XBUF, nullptr, RED, F.ws + B_X3Q};
        pg8::gemm_phase<pg8::EpiRes, pg8::StaticOrder, false>(RING, AUXB, g, S, E);
    } SEAM(8);
    if constexpr (IN(9)) REPS(9) { Frame F; mkframe(args, F, lds); router_phase(args, F); } SEAM(9);
    if constexpr (IN(10)) { Frame F; mkframe(args, F, lds); slots_phase(F); } SEAM(10);
#define MOE_SETUP \
        Frame F; mkframe(args, F, lds); LAS int* tex = (LAS int*)(F.lds + TEX_OFF); \
        __syncthreads(); \
        const int ntl = __builtin_amdgcn_readfirstlane(((const int*)(F.ctl + CW_MOE))[0]); \
        for (int i = F.tid; i < MAXTILES; i += NWAVES * 64) tex[i] = i < ntl ? ((const int*)(F.ctl + CW_TEXP))[i] : 0; \
        __syncthreads();
    if constexpr (IN(11)) REPS(11) { MOE_SETUP
        pg8::Gemm g{F.ws + B_X3Q, F.ws + WS_WMGU, DM}; pg8::MoeOrder S{0, ntl, 2 * EDIM / 256, F.G, (int)blockIdx.x, tex};
        pg8::EpiGu<true> E{F.ws + B_HM, EDIM, (const float*)(F.ws + T_SLOT)};
        pg8::gemm_phase<pg8::EpiGu<true>, pg8::MoeOrder, true, true>(RING, AUXB, g, S, E); } SEAM(11);
    if constexpr (IN(12)) REPS(12) { MOE_SETUP
        pg8::Gemm g{F.ws + B_HM, F.ws + WS_WMD, EDIM}; pg8::MoeOrder S{0, ntl, DM / 256, F.G, (int)blockIdx.x, tex};
        pg8::EpiMoeDn E{(bf16*)F.out, (const int*)(F.ws + T_SLOT)};
        pg8::gemm_phase<pg8::EpiMoeDn, pg8::MoeOrder, false, true>(RING, AUXB, g, S, E); }
    if constexpr (IN(12) && IN(15)) grid_barrier(args, lds);
    if constexpr (IN(15)) { Frame F; mkframe(args, F, lds); combine_phase(F); }
#undef IN
#undef SEAM
}

#ifndef LAST_PHASE
#define LAST_PHASE 15
#endif
#ifndef ONE_LAUNCH
#define ONE_LAUNCH 1
#endif
typedef void (*kern_t)(Args);
template <int P> struct PhaseTab { static void fill(kern_t* t) { t[P] = fwd_kernel<P, P + 1>; PhaseTab<P - 1>::fill(t); } };
template <> struct PhaseTab<-1> { static void fill(kern_t*) {} };
extern "C" void kernel_launch(void* const* d_in, const int* in_sizes, int n_in, void* d_out, int out_size, void* d_ws, size_t ws_size, hipStream_t stream) {
    static int grid = 0; static kern_t tab[N_PHASES + 1];
    if (grid == 0) {
        if (n_in != 21 || in_sizes[0] != MTOK * DM || out_size != MTOK * DM || ws_size < WS_END) { fprintf(stderr, "kernel_launch: unexpected shapes / workspace (%d inputs, ws %zu); nothing launched\n", n_in, ws_size); grid = -1; return; }
        int dev = 0, cus = 0;
        if (hipGetDevice(&dev) != hipSuccess || hipDeviceGetAttribute(&cus, hipDeviceAttributeMultiprocessorCount, dev) != hipSuccess) { grid = -1; return; }
#if ONE_LAUNCH
        tab[N_PHASES] = fwd_kernel<0, LAST_PHASE + 1>;
        if (hipFuncSetAttribute((const void*)tab[N_PHASES], hipFuncAttributeMaxDynamicSharedMemorySize, LDS_BYTES) != hipSuccess) { fprintf(stderr, "kernel_launch: hipFuncSetAttribute failed\n"); grid = -1; return; }
        int per_cu = 0;
        if (hipOccupancyMaxActiveBlocksPerMultiprocessor(&per_cu, (const void*)tab[N_PHASES], NWAVES * 64, LDS_BYTES) != hipSuccess || per_cu < 1) fprintf(stderr, "kernel_launch: note: occupancy query reports %d workgroups per CU\n", per_cu);
#else
        PhaseTab<N_PHASES - 1>::fill(tab);
        for (int p = 0; p < N_PHASES; ++p) if (hipFuncSetAttribute((const void*)tab[p], hipFuncAttributeMaxDynamicSharedMemorySize, LDS_BYTES) != hipSuccess) { fprintf(stderr, "kernel_launch: hipFuncSetAttribute failed\n"); grid = -1; return; }
#endif
        (void)hipGetLastError();
        grid = cus;
        if (grid != 256) fprintf(stderr, "kernel_launch: built for 256 CUs, found %d\n", grid);
    }
    if (grid < 0) return;
    if (hipMemsetAsync((char*)d_ws + WS_CTL, 0, CTL_ZERO_BYTES, stream) != hipSuccess) return;
    Args a{};
    for (int i = 0; i < 21; ++i) a.in[i] = (const float*)d_in[i];
    a.out = (float*)d_out; a.ws = (unsigned char*)d_ws; a.ph_lo = 0; a.ph_hi = LAST_PHASE + 1;
#if ONE_LAUNCH
    hipLaunchKernelGGL(tab[N_PHASES], dim3(grid), dim3(NWAVES * 64), LDS_BYTES, stream, a);
#else
    for (int p = 0; p <= LAST_PHASE; ++p) hipLaunchKernelGGL(tab[p], dim3(grid), dim3(NWAVES * 64), LDS_BYTES, stream, a);
#endif
}
```

```cpp
#include <hip/hip_runtime.h>
#include <cstdio>
#include <cstdint>
#define GAS __attribute__((address_space(1)))
#define LAS __attribute__((address_space(3)))
typedef unsigned short bf16;
typedef unsigned short bf16_t;
typedef short bf16x8 __attribute__((ext_vector_type(8)));
typedef float f32x4 __attribute__((ext_vector_type(4)));
typedef float f32x2 __attribute__((ext_vector_type(2)));
typedef float f32x16 __attribute__((ext_vector_type(16)));
typedef unsigned u32x4 __attribute__((ext_vector_type(4)));
typedef unsigned u32x2 __attribute__((ext_vector_type(2)));
typedef GAS unsigned gu32;
#define RLX_AGENT __ATOMIC_RELAXED, __HIP_MEMORY_SCOPE_AGENT
#define LDS_WAIT() asm volatile("s_waitcnt lgkmcnt(0)" ::: "memory")
#define VM_WAIT() asm volatile("s_waitcnt vmcnt(0)" ::: "memory")
__device__ __forceinline__ float sum_xor16(float s) { const unsigned a = __builtin_bit_cast(unsigned, s); const auto r = __builtin_amdgcn_permlane16_swap(a, a, false, false); unsigned r0 = r[0], r1 = r[1]; asm volatile("" : "+v"(r0), "+v"(r1)); return __builtin_bit_cast(float, r0) + __builtin_bit_cast(float, r1); }
__device__ __forceinline__ float sum_xor32(float s) { const unsigned a = __builtin_bit_cast(unsigned, s); const auto r = __builtin_amdgcn_permlane32_swap(a, a, false, false); unsigned r0 = r[0], r1 = r[1]; asm volatile("" : "+v"(r0), "+v"(r1)); return __builtin_bit_cast(float, r0) + __builtin_bit_cast(float, r1); }
__device__ __forceinline__ float get_xor32(float s, bool upper) { const unsigned a = __builtin_bit_cast(unsigned, s); const auto r = __builtin_amdgcn_permlane32_swap(a, a, false, false); unsigned r0 = r[0], r1 = r[1]; asm volatile("" : "+v"(r0), "+v"(r1)); return __builtin_bit_cast(float, upper ? r0 : r1); }
__device__ __forceinline__ int lane_now() { int l; asm volatile("v_mbcnt_lo_u32_b32 %0, -1, 0\n\tv_mbcnt_hi_u32_b32 %0, -1, %0" : "=v"(l)); return l; }

constexpr int DM = 1024, NBATCH = 8, SEQ = 4096, MTOK = NBATCH * SEQ;
constexpr int MH = 8, MDK = 64, MDV = 128, MPROJ = 3088, MPROJ_MAIN = 3072;
constexpr int SBH = 16, SBD = 64;
constexpr int FFN = 2816, NEXP = 8, EDIM = 3584;
constexpr float EPS = 1e-6f, SOFTCAP = 15.0f;
constexpr float LOG2E = 1.4426950408889634f;
constexpr int NWAVES = 8;
constexpr int MAXTILES = 264;
constexpr int HALF0_TILES = 128;
namespace pg8 {
constexpr int BM = 256, BK = 64, HALF = 128, HTB = HALF * BK * 2  , STAGE_BYTES = 8 * HTB, NXCD = 8, WGM = 8;

__host__ __device__ __forceinline__ int lds_byte(int r, int c) { const int st = (r >> 4) * 2 + (c >> 5), rr = r & 15, cc = c & 31, ob = rr * 64 + cc * 2; return st * 1024 + (ob ^ (((ob >> 9) & 1) << 5)); }
__host__ __device__ __forceinline__ void stage_rc(int b, int& R, int& C) { const int st = b / 1024, sb = b % 1024, swz = sb ^ (((sb >> 9) & 1) << 5); R = (st >> 1) * 16 + swz / 64; C = (st & 1) * 32 + (swz % 64) / 2; }
__host__ __device__ __forceinline__ int perm32(int rho) { const int n = rho >> 4, i = rho & 15; return 8 * (i >> 2) + 4 * n + (i & 3); }

struct Unit { int pm, pn, pb, pa, ko; };
struct Gemm { const void* A; const void* Bt; int K, ld; };

struct StaticOrder {
    int nM, nN, nwg, G, c;
    __device__ void init(int M, int N, int G_, int c_) { nM = M / BM; nN = N / BM; nwg = nM * nN; G = G_; c = c_; }
    __device__ bool next(int i, Unit& u) const {
        const long L = (long)i * G + c; if (L >= nwg) return false;
        int wgid = (int)L; { const int q = nwg / NXCD, r = nwg % NXCD, xcd = wgid % NXCD, off = wgid / NXCD; wgid = (xcd < r ? xcd * (q + 1) : r * (q + 1) + (xcd - r) * q) + off; }
        const int nig = WGM * nN, gid = wgid / nig, fm = gid * WGM, gsz = (nM - fm) < WGM ? (nM - fm) : WGM;
        u.pm = fm + ((wgid % nig) % gsz); u.pn = (wgid % nig) / gsz; u.pb = u.pn; u.pa = u.pm; u.ko = 0; return true;
    }
};
struct MoeOrder {
    int tile_lo, ntile, nN, G, c; const LAS int* texp;
    __device__ bool next(int i, Unit& u) const {
        const int nwg = ntile * nN; const long L = (long)i * G + c; if (L >= nwg) return false;
        int wgid = (int)L; { const int q = nwg / NXCD, r = nwg % NXCD, xcd = wgid % NXCD, off = wgid / NXCD; wgid = (xcd < r ? xcd * (q + 1) : r * (q + 1) + (xcd - r) * q) + off; }
        const int nig = WGM * nN, gid = wgid / nig, fm = gid * WGM, gsz = (ntile - fm) < WGM ? (ntile - fm) : WGM;
        const int t = fm + ((wgid % nig) % gsz); u.pn = (wgid % nig) / gsz; u.pm = tile_lo + t; u.pa = t; u.pb = __builtin_amdgcn_readfirstlane(texp[u.pm]) * nN + u.pn; u.ko = 0; return true;
    }
};
struct MoeRemOrder {
    int ntile, G, c; const LAS int* texp;
    __device__ bool next(int i, Unit& u) const {
        const int L = i * G + c; if (L >= ntile * 28) return false;
        const int ks = L % 7, rest = L / 7; u.pn = rest & 3; const int r = rest >> 2; u.pm = r * 7 + ks; u.pa = 256 + r; u.pb = __builtin_amdgcn_readfirstlane(texp[256 + r]) * 4 + u.pn; u.ko = ks * 512; return true;
    }
};

typedef int v8i_t __attribute__((ext_vector_type(8)));
typedef int v4i_t __attribute__((ext_vector_type(4)));
typedef __bf16 bf16x2_t_ __attribute__((ext_vector_type(2)));
__device__ __forceinline__ unsigned cvt_pk_bf16(float lo, float hi) { f32x2 v = {lo, hi}; return __builtin_bit_cast(unsigned, __builtin_convertvector(v, bf16x2_t_)); }

template <class Epi, class Sched, bool GATHER, bool FP8 = false>
__device__ __forceinline__ void gemm_phase(LAS unsigned char* lds, LAS unsigned char* auxb, const Gemm g, const Sched& S, const Epi& E, const int wid) {
    constexpr int NAUX = Epi::NAUX; constexpr int EV = Epi::EPI_VMEM;
    const int lane = lane_now(), tid = wid * 64 + lane, wr = wid >> 2, wc = wid & 3, fr = lane & 15, fq = lane >> 4;
    const int KB = FP8 ? g.ld : g.ld * 2; int nt = (FP8 ? g.K : g.K * 2) / 128; asm volatile("" : "+s"(nt));
    unsigned voffB[2]; int Rr[2], Cc[2];
#pragma unroll
    for (int i = 0; i < 2; ++i) { int R, C; stage_rc(tid * 16 + i * 8192, R, C); const int Rb = Epi::PERM ? ((R & ~31) + perm32(R & 31)) : R;
        Rr[i] = R; Cc[i] = C; voffB[i] = (unsigned)(Rb * KB + C * 2); }
    const ptrdiff_t kstep = (ptrdiff_t)(BK * 2);
    ptrdiff_t sk = kstep;
    const size_t hstep = (size_t)HALF * KB;
    const size_t tstep = 2 * hstep;
    const unsigned ldsw = (unsigned)wid * 1024u;
    const int aoff = lds_byte(wr * 64 + fr, fq * 8), boff = lds_byte(wc * 32 + fr, fq * 8);
    const int aoff2 = aoff + 1024, boff2 = boff + 1024;
#define PG8_SA(b, h) (((b) * 2 + (h)) * HTB)
#define PG8_SB(b, h) ((4 + (b) * 2 + (h)) * HTB)
#define PG8_STAGE(bufoff, gbase, voff) do { const char* _gb = (const char*)(gbase); asm volatile("" : "+s"(_gb));     \
        _Pragma("unroll") for (int _i = 0; _i < 2; ++_i) { asm volatile("" : "+v"((voff)[_i])); \
        __builtin_amdgcn_global_load_lds((const unsigned*)(_gb + (voff)[_i]), (LAS unsigned*)(lds + (bufoff) + ldsw + _i * 8192), 16, 0, 0); } } while (0)
#define PG8_LD8(p0, p1) __builtin_shufflevector(*(const LAS v4i_t*)(p0), *(const LAS v4i_t*)(p1), 0, 1, 2, 3, 4, 5, 6, 7)
#define PG8_LDA(dst, b, h) do { if constexpr (FP8) { _Pragma("unroll") for (int m = 0; m < 4; ++m) dst##8[m] = PG8_LD8(lds + PG8_SA(b, h) + aoff + m * 2048, lds + PG8_SA(b, h) + aoff2 + m * 2048); } \
        else { _Pragma("unroll") for (int m = 0; m < 4; ++m) _Pragma("unroll") for (int k = 0; k < 2; ++k) dst[m][k] = *(const LAS bf16x8*)(lds + PG8_SA(b, h) + aoff + k * 1024 + m * 2048); } } while (0)
#define PG8_LDB(dst, b, h) do { if constexpr (FP8) { _Pragma("unroll") for (int n = 0; n < 2; ++n) dst##8[n] = PG8_LD8(lds + PG8_SB(b, h) + boff + n * 2048, lds + PG8_SB(b, h) + boff2 + n * 2048); } \
        else { _Pragma("unroll") for (int n = 0; n < 2; ++n) _Pragma("unroll") for (int k = 0; k < 2; ++k) dst[n][k] = *(const LAS bf16x8*)(lds + PG8_SB(b, h) + boff + k * 1024 + n * 2048); } } while (0)
#define PG8_MMA(ai, bj, At, Bt) do { __builtin_amdgcn_s_setprio(1); _Pragma("unroll") for (int m = 0; m < 4; ++m) _Pragma("unroll") for (int n = 0; n < 2; ++n) { \
        if constexpr (FP8) asm volatile("v_mfma_scale_f32_16x16x128_f8f6f4 %0, %1, %2, %0, %3, %3 op_sel_hi:[0,0,0]" : "+v"(acc[ai][bj][m][n]) : "v"(Bt##8[n]), "v"(At##8[m]), "v"(sc1)); \
        else { _Pragma("unroll") for (int k = 0; k < 2; ++k) acc[ai][bj][m][n] = __builtin_amdgcn_mfma_f32_16x16x32_bf16(Bt[n][k], At[m][k], acc[ai][bj][m][n], 0, 0, 0); } } __builtin_amdgcn_s_setprio(0); } while (0)
#define PG8_MMA0(ai, bj, At, Bt) do { __builtin_amdgcn_s_setprio(1); _Pragma("unroll") for (int m = 0; m < 4; ++m) _Pragma("unroll") for (int n = 0; n < 2; ++n) { \
        if constexpr (FP8) asm volatile("v_mfma_scale_f32_16x16x128_f8f6f4 %0, %1, %2, 0, %3, %3 op_sel_hi:[0,0,0]" : "=&v"(acc[ai][bj][m][n]) : "v"(Bt##8[n]), "v"(At##8[m]), "v"(sc1)); \
        else { acc[ai][bj][m][n] = __builtin_amdgcn_mfma_f32_16x16x32_bf16(Bt[n][0], At[m][0], (f32x4){0.f, 0.f, 0.f, 0.f}, 0, 0, 0); acc[ai][bj][m][n] = __builtin_amdgcn_mfma_f32_16x16x32_bf16(Bt[n][1], At[m][1], acc[ai][bj][m][n], 0, 0, 0); } } __builtin_amdgcn_s_setprio(0); } while (0)
#define PG8_WAIT_V(n) asm volatile("s_waitcnt vmcnt(" #n ")" ::: "memory")
#define PG8_WAIT_L(n) asm volatile("s_waitcnt lgkmcnt(" #n ")" ::: "memory")
#define PG8_BAR __builtin_amdgcn_s_barrier()
#define PG8_SCHED __builtin_amdgcn_sched_barrier(0)
#define PG8_VAH(dst, _h, par) do { _Pragma("unroll") for (int _i = 0; _i < 2; ++_i) { \
        if constexpr (GATHER) { const int _ix = ((const LAS int*)(auxb + (size_t)(par) * NAUX * 1024))[(_h) * HALF + Rr[_i]]; dst[_i] = (unsigned)_ix * (unsigned)KB + (unsigned)(Cc[_i] * 2); } \
        else dst[_i] = (unsigned)(((_h) * HALF + Rr[_i]) * KB + Cc[_i] * 2); } } while (0)
#define PG8_AUX(un, par) do { if constexpr (NAUX > 0) { const unsigned* _src = (const unsigned*)((const char*)E.aux_src(un) + lane * 16); LAS unsigned* _dst = (LAS unsigned*)(auxb + (size_t)((par) * NAUX) * 1024); \
        _Pragma("unroll") for (int _p = 0; _p < NAUX; ++_p) { __builtin_amdgcn_global_load_lds(_src, _dst, 16, 0, 0); _src += 256; _dst += 256; asm volatile("" : "+v"(_src)); } } } while (0)
    Unit cur, nxt, prv; int ui = 0;
    if (!S.next(0, cur)) return;
#ifdef GEMM_SKEW_TICKS
    {
        const unsigned long long t0s = __builtin_amdgcn_s_memrealtime(); const unsigned long long dly = (unsigned long long)((blockIdx.x >> 3) & 7) * GEMM_SKEW_TICKS;
        while (__builtin_amdgcn_s_memrealtime() - t0s < dly) __builtin_amdgcn_s_sleep(8); }
#endif
    prv = cur;
    f32x4 acc[2][2][4][2];
    bf16x8 At[4][2], B0[2][2], B1[2][2];
    v8i_t At8[4], B08[2], B18[2]; const int sc1 = 0x7f7f7f7f;
    unsigned vAc[2][2];
    if constexpr (NAUX > 0) { if (wid == 0) PG8_AUX(cur, 0); PG8_WAIT_V(0); PG8_BAR; }
    PG8_VAH(vAc[0], 0, 0); PG8_VAH(vAc[1], 1, 0);
    const char* cA = GATHER ? (const char*)g.A + cur.ko : (const char*)g.A + (size_t)cur.pa * tstep + cur.ko; const char* cB = (const char*)g.Bt + (size_t)cur.pb * tstep + cur.ko;
    PG8_STAGE(PG8_SB(0, 0), cB, voffB); PG8_STAGE(PG8_SB(0, 1), cB + hstep, voffB); PG8_STAGE(PG8_SA(0, 0), cA, vAc[0]); PG8_STAGE(PG8_SA(0, 1), cA, vAc[1]);
    if (wr == 1) PG8_BAR;
    PG8_WAIT_V(2); PG8_BAR;
    PG8_STAGE(PG8_SB(1, 0), cB + kstep, voffB); PG8_STAGE(PG8_SA(1, 0), cA + kstep, vAc[0]); PG8_STAGE(PG8_SB(1, 1), cB + hstep + kstep, voffB);
    if constexpr (EV > 0) PG8_WAIT_V(0); else PG8_WAIT_V(6);
    PG8_BAR;
    for (;;) {
        const bool has_next = S.next(ui + 1, nxt);
        const bool nrev = has_next && ((ui + 1) & 1); const ptrdiff_t nsk = has_next ? (nrev ? -kstep : kstep) : sk, nfirst = nrev ? (ptrdiff_t)(nt - 1) * kstep : 0;
        const char* nA = has_next ? (GATHER ? (const char*)g.A + nxt.ko : (const char*)g.A + (size_t)nxt.pa * tstep + nxt.ko) + nfirst : cA; const char* nB = has_next ? (const char*)g.Bt + (size_t)nxt.pb * tstep + nxt.ko + nfirst : cB;
#define PG8_KSTEP(MMX, AUXNOW, LASTX, W1, W2, W3) do { \
            const bool last = (LASTX); \
            if constexpr (NAUX > 0) { if ((AUXNOW) && has_next && wid == 4) PG8_AUX(nxt, (ui + 1) & 1); } \
            if (last && has_next) { PG8_VAH(vAc[0], 0, (ui + 1) & 1); } \
            const char* a1 = cA + (ptrdiff_t)(t + 1) * sk; \
            const char* a2 = last ? nA : cA + (ptrdiff_t)(t + 2) * sk; const char* b2 = last ? nB : cB + (ptrdiff_t)(t + 2) * sk; \
            const ptrdiff_t sk3 = last ? nsk : sk; const char* a3 = a2 + sk3; const char* b3 = b2 + sk3; \
            PG8_LDB(B0, 0, 0); PG8_LDB(B1, 0, 1); PG8_SCHED; PG8_LDA(At, 0, 0); PG8_STAGE(PG8_SA(1, 1), a1, vAc[1]); \
            if (last && has_next) { PG8_VAH(vAc[1], 1, (ui + 1) & 1); } \
            W1; PG8_WAIT_L(0); PG8_BAR; MMX(0, 0, At, B0); MMX(0, 1, At, B1); PG8_BAR; PG8_SCHED; \
            PG8_LDA(At, 0, 1); PG8_STAGE(PG8_SB(0, 0), b2, voffB); PG8_STAGE(PG8_SB(0, 1), b2 + hstep, voffB); PG8_STAGE(PG8_SA(0, 0), a2, vAc[0]); \
            W2; PG8_WAIT_L(0); PG8_BAR; MMX(1, 0, At, B0); MMX(1, 1, At, B1); PG8_BAR; PG8_SCHED; \
            PG8_LDB(B0, 1, 0); PG8_LDB(B1, 1, 1); PG8_SCHED; PG8_LDA(At, 1, 0); PG8_STAGE(PG8_SA(0, 1), a2, vAc[1]); \
            W3; PG8_WAIT_L(0); PG8_BAR; PG8_MMA(0, 0, At, B0); PG8_MMA(0, 1, At, B1); PG8_BAR; PG8_SCHED; \
            PG8_LDA(At, 1, 1); PG8_STAGE(PG8_SB(1, 0), b3, voffB); PG8_STAGE(PG8_SB(1, 1), b3 + hstep, voffB); PG8_STAGE(PG8_SA(1, 0), a3, vAc[0]); \
            PG8_WAIT_V(8); PG8_WAIT_L(0); PG8_BAR; PG8_MMA(1, 0, At, B0); PG8_MMA(1, 1, At, B1); PG8_BAR; PG8_SCHED; } while (0)
#define PG8_WSEAM(n) do { if constexpr (EV > 0) asm volatile("s_waitcnt vmcnt(%0)" :: "n"((n) + EV) : "memory"); else PG8_WAIT_V(8); } while (0)
        { const int t = 0; PG8_KSTEP(PG8_MMA0, false, false, PG8_WSEAM(8), PG8_WSEAM(8), PG8_WSEAM(10)); }
#pragma clang loop unroll(disable)
        for (int t = 2; t < nt; t += 2) PG8_KSTEP(PG8_MMA, t == 2, t == nt - 2, PG8_WAIT_V(8), PG8_WAIT_V(8), PG8_WAIT_V(8));
        if constexpr (FP8) asm volatile("s_nop 15\n\ts_nop 7" ::: "memory");
        if (wr == 0) PG8_BAR;
        E(acc, cur, wr, wc, fr, fq, (const LAS unsigned char*)(auxb + (size_t)(ui & 1) * NAUX * 1024), ui, prv);
        if (!has_next) break;
        prv = cur; cur = nxt; cA = nA; cB = nB; sk = nsk; ++ui;
        if (wr == 1) PG8_BAR;
    }
    PG8_WAIT_V(0); PG8_WAIT_L(0);
    PG8_BAR;
    E.finish(cur, ui);
#undef PG8_SA
#undef PG8_SB
#undef PG8_STAGE
#undef PG8_LDA
#undef PG8_LDB
#undef PG8_MMA
#undef PG8_MMA0
#undef PG8_KSTEP
#undef PG8_WSEAM
#undef PG8_WAIT_V
#undef PG8_WAIT_L
#undef PG8_BAR
#undef PG8_SCHED
#undef PG8_VAH
#undef PG8_AUX
}
}
namespace pg8 {
__device__ __forceinline__ float sigmoid_fast(float x) { return __builtin_amdgcn_rcpf(1.0f + __builtin_amdgcn_exp2f(-LOG2E * x)); }
template <int NP> __device__ __forceinline__ float row_rs(const LAS unsigned char* aux, int rl) {
    const LAS float* ax = (const LAS float*)aux; float ss = ax[rl];
#pragma unroll
    for (int p = 1; p < NP; ++p) ss += ax[p * 256 + rl];
    return rsqrtf(ss * (1.0f / DM) + EPS);
}
__device__ __forceinline__ unsigned pk4_fp8(float a, float b, float c, float d) { int v = __builtin_amdgcn_cvt_pk_fp8_f32(a, b, 0, false); v = __builtin_amdgcn_cvt_pk_fp8_f32(c, d, v, true); return (unsigned)v; }
__device__ __forceinline__ u32x2 pack8_fp8(const f32x4 a, const f32x4 b) { return (u32x2){pk4_fp8(a[0], a[1], a[2], a[3]), pk4_fp8(b[0], b[1], b[2], b[3])}; }
__device__ __forceinline__ u32x4 pack8(const f32x4 a, const f32x4 b) { u32x4 w; w.x = cvt_pk_bf16(a[0], a[1]); w.y = cvt_pk_bf16(a[2], a[3]); w.z = cvt_pk_bf16(b[0], b[1]); w.w = cvt_pk_bf16(b[2], b[3]); return w; }

struct EpiProj {
    static constexpr bool PERM = true; static constexpr int EPI_VMEM = 0; static constexpr int NAUX = 1;
    bf16_t* Q; bf16_t* Kk; bf16_t* Kt; bf16_t* Vt; bf16_t* OG; const float* ss0; LAS bf16_t* tlsb;
    __device__ __forceinline__ const void* aux_src(const Unit& u) const { return ss0 + (size_t)u.pm * 256; }
    __device__ __forceinline__ void operator()(const f32x4 (&acc)[2][2][4][2], const Unit& u, int wr, int wc, int fr, int fq, const LAS unsigned char* aux, int, const Unit&) const {
        asm volatile("" : "+v"(fr), "+v"(fq));
        const int pn = u.pn;
        if (pn < 4 || pn >= 8) {
            bf16_t* base; int ldc, colt; bool sig = false;
            if (pn < 2) { base = Q; ldc = 512; colt = pn * 256; } else if (pn < 4) { base = Kk; ldc = 512; colt = (pn - 2) * 256; } else { base = OG; ldc = 1024; colt = (pn - 8) * 256; sig = true; }
#pragma unroll
            for (int ai = 0; ai < 2; ++ai)
#pragma unroll
                for (int m = 0; m < 4; ++m) { const int rl = ai * HALF + wr * 64 + m * 16 + fr; const float rs = row_rs<1>(aux, rl);
                    bf16_t* rowp = base + (size_t)(u.pm * BM + rl) * ldc + colt + wc * 32 + 8 * fq;
#pragma unroll
                    for (int bj = 0; bj < 2; ++bj) { f32x4 v0 = acc[ai][bj][m][0] * rs, v1 = acc[ai][bj][m][1] * rs;
                        if (sig) {
#pragma unroll
                            for (int j = 0; j < 4; ++j) { v0[j] = sigmoid_fast(v0[j]); v1[j] = sigmoid_fast(v1[j]); } }
                        if (pn < 4) { const int row = u.pm * BM + rl, b = row >> 12, t = row & 4095, col = colt + bj * HALF + wc * 32 + 8 * fq, hd = col >> 6, dk0 = col & 63;
                            *(GAS u32x4*)(base + ((((size_t)((b * MH + hd) * 64 + (t >> 6)) * 4 + ((t >> 4) & 3)) * 2 + (dk0 >> 5)) * 64 + (t & 15) + 16 * ((dk0 >> 3) & 3)) * 8) = pack8(v0, v1); }
                        else *(GAS u32x4*)(rowp + bj * HALF) = pack8(v0, v1); }
                    asm volatile("" ::: "memory"); }
        }
        if (pn >= 2 && pn < 8) {
            const bool isk = pn < 4; const int colt = isk ? (pn - 2) * 256 : (pn - 4) * 256; bf16_t* tb = isk ? Kt : Vt; const int hshift = isk ? 6 : 7;
            const int lane64 = fr + 16 * fq; LAS bf16_t* tls = tlsb + (wr * 4 + wc) * 512;
#pragma unroll
            for (int ai = 0; ai < 2; ++ai)
#pragma unroll
                for (int m = 0; m < 4; ++m) { const int rl = ai * HALF + wr * 64 + m * 16 + fr; const float rs = row_rs<1>(aux, rl);
#pragma unroll
                    for (int bj = 0; bj < 2; ++bj) {
#pragma unroll
                        for (int n = 0; n < 2; ++n)
#pragma unroll
                            for (int j = 0; j < 4; ++j) tls[(8 * fq + 4 * n + j) * 16 + fr] = (bf16_t)(cvt_pk_bf16(acc[ai][bj][m][n][j] * rs, 0.f) & 0xffffu);
                        asm volatile("s_waitcnt lgkmcnt(0)" ::: "memory");
                        const int c32 = lane64 >> 1, hf = lane64 & 1; const u32x4 tv = *(const LAS u32x4*)(tls + c32 * 16 + 8 * hf);
                        asm volatile("s_waitcnt lgkmcnt(0)" ::: "memory");
                        const int tb0 = (u.pm * BM + ai * HALF + wr * 64 + m * 16 + 8 * hf) & 4095, bb = (u.pm * BM) >> 12;
                        const int col = colt + bj * HALF + wc * 32 + c32, hd = col >> hshift, cc = col & ((1 << hshift) - 1);
                        const size_t fi = isk ? ((((size_t)((bb * MH + hd) * 64 + (tb0 >> 6)) * 4 + (cc >> 4)) * 2 + ((tb0 >> 5) & 1)) * 64 + (cc & 15) + 16 * ((tb0 >> 3) & 3))
                                              : ((((size_t)((bb * MH + hd) * 64 + (tb0 >> 6)) * 8 + (cc >> 4)) * 2 + ((tb0 >> 5) & 1)) * 64 + (cc & 15) + 16 * ((tb0 >> 3) & 3));
                        *(GAS u32x4*)(tb + fi * 8) = tv; }
                    asm volatile("" ::: "memory"); }
        }
    }
    __device__ __forceinline__ void finish(const Unit&, int) const {}
};

struct EpiRes {
    static constexpr bool PERM = true; static constexpr int EPI_VMEM = 0; static constexpr int NAUX = 0;
    bf16_t* xb; float* out; float* ssp; LAS float* red; unsigned char* xq; int wv;
    __device__ __forceinline__ const void* aux_src(const Unit&) const { return nullptr; }
    __device__ __forceinline__ void flush(const Unit& p, int par) const {
        if (wv < 4) { const LAS float* r = red + par * 1024; const int row = wv * 64 + lane_now(); ssp[((size_t)p.pm * 4 + p.pn) * 256 + row] = (r[row] + r[256 + row]) + (r[512 + row] + r[768 + row]); } }
    __device__ __forceinline__ void operator()(const f32x4 (&acc)[2][2][4][2], const Unit& u, int wr, int wc, int fr, int fq, const LAS unsigned char*, int ui, const Unit& prv) const {
        asm volatile("" : "+v"(fr), "+v"(fq));
        if (ssp && ui > 0) flush(prv, (ui - 1) & 1);
#pragma unroll
        for (int ai = 0; ai < 2; ++ai)
#pragma unroll
            for (int m = 0; m < 4; ++m) { const int rl = ai * HALF + wr * 64 + m * 16 + fr; const size_t off = (size_t)(u.pm * BM + rl) * DM + u.pn * BM + wc * 32 + 8 * fq; float ss = 0.f;
#pragma unroll
                for (int bj = 0; bj < 2; ++bj) { const u32x4 bv = *(const GAS u32x4*)(xb + off + bj * HALF);
                    f32x4 v0, v1;
                    v0[0] = __builtin_bit_cast(float, bv[0] << 16); v0[1] = __builtin_bit_cast(float, bv[0] & 0xffff0000u); v0[2] = __builtin_bit_cast(float, bv[1] << 16); v0[3] = __builtin_bit_cast(float, bv[1] & 0xffff0000u);
                    v1[0] = __builtin_bit_cast(float, bv[2] << 16); v1[1] = __builtin_bit_cast(float, bv[2] & 0xffff0000u); v1[2] = __builtin_bit_cast(float, bv[3] << 16); v1[3] = __builtin_bit_cast(float, bv[3] & 0xffff0000u);
                    v0 = v0 + acc[ai][bj][m][0]; v1 = v1 + acc[ai][bj][m][1];
                    *(GAS u32x4*)(xb + off + bj * HALF) = pack8(v0, v1);
                    if (out) { *(GAS f32x4*)(out + off + bj * HALF) = v0; *(GAS f32x4*)(out + off + bj * HALF + 4) = v1; }
                    if (xq) *(GAS u32x2*)(xq + off + bj * HALF) = pack8_fp8(v0, v1);
                    ss += (v0[0] * v0[0] + v0[1] * v0[1]) + (v0[2] * v0[2] + v0[3] * v0[3]) + (v1[0] * v1[0] + v1[1] * v1[1]) + (v1[2] * v1[2] + v1[3] * v1[3]); }
                if (ssp) { ss = sum_xor16(ss); ss = sum_xor32(ss); if (fq == 0) red[(ui & 1) * 1024 + wc * 256 + rl] = ss; }
                asm volatile("" ::: "memory"); }
    }
    __device__ __forceinline__ void finish(const Unit& last, int ui) const { if (ssp) flush(last, ui & 1); }
};

constexpr float MOE_WSCALE = 32.0f, MOE_HSCALE = 8.0f;
template <bool MOE> struct EpiGu {
    static constexpr bool PERM = true; static constexpr int EPI_VMEM = 8;     static constexpr int NAUX = MOE ? 3 : 4;
    void* H; int ldh; const float* ssp;
    __device__ __forceinline__ const void* aux_src(const Unit& u) const { return ssp + (size_t)u.pm * 1024; }
    __device__ __forceinline__ void operator()(const f32x4 (&acc)[2][2][4][2], const Unit& u, int wr, int wc, int fr, int fq, const LAS unsigned char* aux, int, const Unit&) const {
        asm volatile("" : "+v"(fr), "+v"(fq));
        float rsv[2][4], wv[2][4];
#pragma unroll
        for (int ai = 0; ai < 2; ++ai)
#pragma unroll
            for (int m = 0; m < 4; ++m) { const int rl = ai * HALF + wr * 64 + m * 16 + fr;
                if constexpr (MOE) { rsv[ai][m] = ((const LAS float*)(aux + 1024))[rl] * (1.0f / MOE_WSCALE); wv[ai][m] = ((const LAS float*)(aux + 2048))[rl] * MOE_HSCALE; } else { rsv[ai][m] = row_rs<4>(aux, rl); wv[ai][m] = 1.f; } }
#pragma unroll
        for (int ai = 0; ai < 2; ++ai)
#pragma unroll
            for (int m = 0; m < 4; ++m) { const int rl = ai * HALF + wr * 64 + m * 16 + fr; const float rs = rsv[ai][m], w = wv[ai][m];
                GAS unsigned char* Hg = (GAS unsigned char*)H + ((size_t)(u.pa * BM + ai * HALF + wr * 64 + m * 16) * ldh + u.pn * HALF + wc * 32) * (MOE ? 1 : 2);
                unsigned vo = (unsigned)(fr * ldh + 8 * fq) * (MOE ? 1u : 2u); asm volatile("" : "+v"(vo));
                const float k120 = (-LOG2E * (1.0f / 120.0f)) * rs, crow = rs * rs * w; const f32x2 kk = (f32x2){k120, k120}, hh = (f32x2){0.5f, 0.5f};
                f32x4 h[2];
#pragma unroll
                for (int n = 0; n < 2; ++n) { const f32x4 G = acc[ai][0][m][n], U = acc[ai][1][m][n];
                    const f32x2 ga = (f32x2){G[0], G[1]}, gb = (f32x2){G[2], G[3]}, ua = (f32x2){U[0], U[1]}, ub = (f32x2){U[2], U[3]};
                    f32x2 ta, tb;
                    asm("v_pk_fma_f32 %0, %1, %2, %3 clamp" : "=v"(ta) : "v"(ga), "v"(kk), "v"(hh));
                    asm("v_pk_fma_f32 %0, %1, %2, %3 clamp" : "=v"(tb) : "v"(gb), "v"(kk), "v"(hh));
                    ta = ta * 120.0f - 60.0f; tb = tb * 120.0f - 60.0f;
                    f32x2 da, db; da.x = __builtin_amdgcn_exp2f(ta.x); da.y = __builtin_amdgcn_exp2f(ta.y); db.x = __builtin_amdgcn_exp2f(tb.x); db.y = __builtin_amdgcn_exp2f(tb.y);
                    da = da + 1.0f; db = db + 1.0f;
                    const f32x2 pab = da * db; const float r = __builtin_amdgcn_rcpf(pab.x * pab.y) * crow;
                    const f32x2 rr = (f32x2){pab.y, pab.x} * r;
                    const f32x2 ha = (ga * ua) * (rr * db), hb = (gb * ub) * (rr * da);
                    h[n] = (f32x4){ha.x, ha.y, hb.x, hb.y}; }
                if constexpr (MOE) *(GAS u32x2*)(Hg + vo) = pack8_fp8(h[0], h[1]); else *(GAS u32x4*)(Hg + vo) = pack8(h[0], h[1]);
                asm volatile("" ::: "memory"); }
    }
    __device__ __forceinline__ void finish(const Unit&, int) const {}
};

struct EpiKvq {
    static constexpr bool PERM = true; static constexpr int EPI_VMEM = 0; static constexpr int NAUX = 4;
    bf16_t* Kb; bf16_t* Vt; bf16_t* Qb; const float* ssp; const LAS float* gk; LAS bf16_t* tlsb;
    __device__ __forceinline__ const void* aux_src(const Unit& u) const { return ssp + (size_t)u.pm * 1024; }
    __device__ __forceinline__ void operator()(const f32x4 (&acc)[2][2][4][2], const Unit& u, int wr, int wc, int fr, int fq, const LAS unsigned char* aux, int, const Unit&) const {
        asm volatile("" : "+v"(fr), "+v"(fq));
        const int kind = u.pn >> 2, hd = (u.pn & 3) * 4 + wc;
#pragma unroll
        for (int ai = 0; ai < 2; ++ai)
#pragma unroll
            for (int m = 0; m < 4; ++m) { const int rl = ai * HALF + wr * 64 + m * 16 + fr; const float rs = row_rs<4>(aux, rl); const int row = u.pm * BM + rl;
                f32x4 y[2][2]; float ssq = 0.f;
#pragma unroll
                for (int bj = 0; bj < 2; ++bj)
#pragma unroll
                    for (int n = 0; n < 2; ++n) { y[bj][n] = acc[ai][bj][m][n] * rs; const f32x4 t = y[bj][n]; ssq += (t[0] * t[0] + t[1] * t[1]) + (t[2] * t[2] + t[3] * t[3]); }
                const int b = row >> 12, t = row & 4095, bh = b * 16 + hd, blk = t >> 5, tl = t & 31;
                if (kind != 1) {
                    ssq = sum_xor16(ssq); ssq = sum_xor32(ssq);
                    const float rinv = rsqrtf(ssq * (1.0f / 64.0f) + EPS) * (kind == 2 ? LOG2E * 0.125f : 1.0f);
                    const LAS float* g = gk + (kind == 2 ? 64 : 0);
                    const int r = kind == 2 ? tl : ((tl & 19) | ((tl & 4) << 1) | ((tl & 8) >> 1));
                    bf16_t* dst = (kind == 2 ? Qb : Kb) + ((size_t)(bh * 128 + blk) * 4 * 64 + r) * 8;
#pragma unroll
                    for (int bj = 0; bj < 2; ++bj) { const int pos0 = 32 * bj + 8 * fq; const f32x4 g0 = *(const LAS f32x4*)(g + pos0), g1 = *(const LAS f32x4*)(g + pos0 + 4);
                        *(GAS u32x4*)(dst + ((size_t)(pos0 >> 4) * 64 + 32 * ((pos0 >> 3) & 1)) * 8) = pack8(y[bj][0] * rinv * g0, y[bj][1] * rinv * g1); }
                } else {
                    const int lane64 = fr + 16 * fq; LAS bf16_t* tls = tlsb + (wr * 4 + wc) * 512;
#pragma unroll
                    for (int bj = 0; bj < 2; ++bj) {
#pragma unroll
                        for (int n = 0; n < 2; ++n)
#pragma unroll
                            for (int j = 0; j < 4; ++j) tls[(8 * fq + 4 * n + j) * 16 + fr] = (bf16_t)(cvt_pk_bf16(y[bj][n][j], 0.f) & 0xffffu);
                        asm volatile("s_waitcnt lgkmcnt(0)" ::: "memory");
                        const int c32 = lane64 >> 1, hf = lane64 & 1; const u32x4 tv = *(const LAS u32x4*)(tls + c32 * 16 + 8 * hf);
                        asm volatile("s_waitcnt lgkmcnt(0)" ::: "memory");
                        const int tb0 = (u.pm * BM + ai * HALF + wr * 64 + m * 16 + 8 * hf) & 4095, tl0 = tb0 & 31, pos = 32 * bj + c32;
                        *(GAS u32x4*)(Vt + (((((size_t)(bh * 128 + (tb0 >> 5)) * 2 + (pos >> 5)) * 2 + ((tl0 >> 4) & 1)) * 64 + (pos & 31) + 32 * ((tl0 >> 3) & 1)) * 8)) = tv; }
                }
                asm volatile("" ::: "memory"); }
    }
    __device__ __forceinline__ void finish(const Unit&, int) const {}
};

constexpr float MOE_YSCALE = 16.0f;
struct EpiMoeDn {
    static constexpr bool PERM = true; static constexpr int EPI_VMEM = 0; static constexpr int NAUX = 1;
    unsigned char* Y; const int* slot;
    __device__ __forceinline__ const void* aux_src(const Unit& u) const { return slot + (size_t)u.pm * 1024 + 768; }
    __device__ __forceinline__ void operator()(const f32x4 (&acc)[2][2][4][2], const Unit& u, int wr, int wc, int fr, int fq, const LAS unsigned char* aux, int, const Unit&) const {
        asm volatile("" : "+v"(fr), "+v"(fq));
        constexpr float sc = MOE_YSCALE / (MOE_WSCALE * MOE_HSCALE);
#pragma unroll
        for (int ai = 0; ai < 2; ++ai)
#pragma unroll
            for (int m = 0; m < 4; ++m) { const int rl = ai * HALF + wr * 64 + m * 16 + fr; const int yr = ((const LAS int*)aux)[rl];
                if (yr >= 0) { unsigned char* rowp = Y + (size_t)yr * DM + u.pn * BM + wc * 32 + 8 * fq;
#pragma unroll
                    for (int bj = 0; bj < 2; ++bj) *(GAS u32x2*)(rowp + bj * HALF) = pack8_fp8(acc[ai][bj][m][0] * sc, acc[ai][bj][m][1] * sc); }
                asm volatile("" ::: "memory"); }
    }
    __device__ __forceinline__ void finish(const Unit&, int) const {}
};
struct EpiMoeDnPart {
    static constexpr bool PERM = true; static constexpr int EPI_VMEM = 0; static constexpr int NAUX = 0;
    bf16_t* YP;
    __device__ __forceinline__ const void* aux_src(const Unit&) const { return nullptr; }
    __device__ __forceinline__ void operator()(const f32x4 (&acc)[2][2][4][2], const Unit& u, int wr, int wc, int fr, int fq, const LAS unsigned char*, int, const Unit&) const {
        asm volatile("" : "+v"(fr), "+v"(fq));
#pragma unroll
        for (int ai = 0; ai < 2; ++ai)
#pragma unroll
            for (int m = 0; m < 4; ++m) { const int rl = ai * HALF + wr * 64 + m * 16 + fr; bf16_t* rowp = YP + (size_t)(u.pm * BM + rl) * DM + u.pn * BM + wc * 32 + 8 * fq;
#pragma unroll
                for (int bj = 0; bj < 2; ++bj) *(GAS u32x4*)(rowp + bj * HALF) = pack8(acc[ai][bj][m][0] * (1.0f / (MOE_WSCALE * MOE_HSCALE)), acc[ai][bj][m][1] * (1.0f / (MOE_WSCALE * MOE_HSCALE)));
                asm volatile("" ::: "memory"); }
    }
    __device__ __forceinline__ void finish(const Unit&, int) const {}
};
}
constexpr size_t MiB = 1u << 20;
constexpr size_t WS_CTL = 0, CTL_ZERO_BYTES = 64 * 1024;
constexpr size_t WS_WIN = 1 * MiB, WS_WOUT = 7 * MiB, WS_WGU = 9 * MiB, WS_WD = 20 * MiB, WS_WKVQ = 26 * MiB, WS_WO = 32 * MiB, WS_WMGU = 34 * MiB, WS_WMD = 90 * MiB;
constexpr size_t WS_TAB = 118 * MiB;
constexpr size_t T_SS0 = WS_TAB, T_SSP = WS_TAB + 128 * 1024, T_GATES = WS_TAB + 1 * MiB, T_SELE = WS_TAB + 3 * MiB, T_SELW1 = T_SELE + 128 * 1024, T_SELW2 = T_SELE + 256 * 1024, T_SELRS = T_SELE + 384 * 1024;
constexpr size_t T_SLOTOF = WS_TAB + 5 * MiB + 256 * 1024;
constexpr size_t T_SLOT = WS_TAB + 4 * MiB;
constexpr size_t WS_A = 124 * MiB;
constexpr size_t WS_B = 188 * MiB;
constexpr size_t B_Q = WS_B, B_K = WS_B + 32 * MiB, B_VT = WS_B + 64 * MiB, B_OG = WS_B + 128 * MiB, B_HN = WS_B + 192 * MiB;
constexpr size_t B_HF = WS_B;
constexpr size_t B_SBK = WS_B, B_SBVT = WS_B + 64 * MiB, B_SBQ = WS_B + 128 * MiB, B_SBO = WS_B + 192 * MiB;
constexpr size_t WS_Y = 1 * MiB;
constexpr size_t B_YP = WS_B + 264 * MiB;
constexpr size_t B_X3Q = WS_B, B_HM = WS_B + 32 * MiB;
constexpr size_t WS_END = 528 * MiB;
static_assert(WS_Y + (size_t)2 * MTOK * DM <= WS_WMD && B_YP + (size_t)56 * 256 * DM * 2 <= WS_END && (size_t)MAXTILES * 4096 <= MiB + 256 * 1024 && B_HM + (size_t)MAXTILES * 256 * EDIM <= WS_END && B_HN + (size_t)MTOK * DM * 2 <= WS_END, "d_ws map");
constexpr int CW_TMO = 0, CW_BAR = 4096, CW_CNT = 8192, CW_MOE = 12288, CW_TEXP = CW_MOE + 64;
constexpr int RING_OFF = 0, RING_BYTES = 131072;
constexpr int AUX_OFF = RING_BYTES, AUX_BYTES = 8192;
constexpr int RED_OFF = AUX_OFF + AUX_BYTES, RED_BYTES = 8192;
constexpr int TEX_OFF = RED_OFF + RED_BYTES, TEX_BYTES = 2048;
constexpr int MISC_OFF = TEX_OFF + TEX_BYTES;
constexpr int LDS_BYTES = MISC_OFF + 128;
static_assert(LDS_BYTES <= 160 * 1024 && LDS_BYTES > 80 * 1024, "LDS map: one workgroup per CU");

#define XB_TMO      128
#define XB_XCNT(j)  (256  + 64 * (j))
#define XB_XSUB(j)  (1280 + 64 * (j))
#define XB_XGEN(j)  (2304 + 64 * (j))
#define XB_TOP      3328
#define XB_TOPGEN   3392
#define XCD_BAR_WORDS 3456
#define XB_SPIN_CAP (1u << 18)
__device__ __forceinline__ unsigned xb_ld(unsigned* p)              { return __hip_atomic_load(p, __ATOMIC_RELAXED, __HIP_MEMORY_SCOPE_AGENT); }
__device__ __forceinline__ unsigned xb_add(unsigned* p, unsigned v) { return __hip_atomic_fetch_add(p, v, __ATOMIC_RELAXED, __HIP_MEMORY_SCOPE_AGENT); }
__device__ __forceinline__ unsigned xb_xcc_id() { return (unsigned)__builtin_amdgcn_s_getreg((3 << 11) | 20) & 0xFu; }
#define XB_SPIN(cond, bar) do { unsigned _sp = 0; while (cond) { __builtin_amdgcn_s_sleep(1); \
    if ((++_sp & 255u) == 0u) { if (xb_ld(&(bar)[XB_TMO])) break; if (_sp > XB_SPIN_CAP) { atomicAdd(&(bar)[XB_TMO], 1u); break; } } } } while (0)
struct XcdBarrier { unsigned* bar; unsigned x; volatile LAS unsigned* st; };
__device__ __forceinline__ XcdBarrier xcd_barrier_post(unsigned* bar, volatile LAS unsigned* st, bool t0) {
    XcdBarrier b; b.bar = bar; b.x = xb_xcc_id(); b.st = st;
    if (t0) (void)xb_add(&bar[XB_XCNT(b.x)], 1u);
    return b;
}
__device__ __forceinline__ void xcd_barrier_complete(unsigned* bar, unsigned x, unsigned& nloc, unsigned& nx) {
    const unsigned G = gridDim.x * gridDim.y * gridDim.z;
    unsigned sum, cnt, mine, sp = 0u;
    for (;;) {
        sum = 0u; cnt = 0u; mine = 0u;
#pragma unroll
        for (unsigned j = 0; j < 16; ++j) { const unsigned c = xb_ld(&bar[XB_XCNT(j)]); sum += c; cnt += (c > 0u) ? 1u : 0u; mine = (j == x) ? c : mine; }
        if (sum == G) break;
        __builtin_amdgcn_s_sleep(1);
        if ((++sp & 255u) == 0u) { if (xb_ld(&bar[XB_TMO])) break; if (sp > XB_SPIN_CAP) { atomicAdd(&bar[XB_TMO], 1u); break; } }
    }
    nloc = mine > 0u ? mine : 1u; nx = cnt > 0u ? cnt : 1u;
}
__device__ __forceinline__ void xcd_barrier(const XcdBarrier& b, bool t0) {
    asm volatile("s_waitcnt vmcnt(0)" ::: "memory");
    __syncthreads();
    if (t0) {
        unsigned* bar = b.bar;
        __builtin_amdgcn_s_waitcnt(0);
        unsigned nloc = b.st[0], nx = b.st[1];
        if (nloc == 0u) { xcd_barrier_complete(bar, b.x, nloc, nx); b.st[0] = nloc; b.st[1] = nx; }
        const unsigned old = xb_add(&bar[XB_XSUB(b.x)], 1u);
        const unsigned gen = old / nloc;
        if (old + 1u == (gen + 1u) * nloc) {
            __builtin_amdgcn_fence(__ATOMIC_RELEASE, "agent");
            asm volatile("s_waitcnt vmcnt(0)" ::: "memory");
            const unsigned og = xb_add(&bar[XB_TOP], 1u);
            const unsigned tg = og / nx;
            if (og + 1u == (tg + 1u) * nx) xb_add(&bar[XB_TOPGEN], 1u);
            else XB_SPIN(xb_ld(&bar[XB_TOPGEN]) == tg, bar);
            __builtin_amdgcn_fence(__ATOMIC_ACQUIRE, "agent");
            xb_add(&bar[XB_XGEN(b.x)], 1u);
            asm volatile("s_waitcnt vmcnt(0)" ::: "memory");
        } else {
            XB_SPIN(xb_ld(&bar[XB_XGEN(b.x)]) == gen, bar);
            __builtin_amdgcn_fence(__ATOMIC_ACQUIRE, "agent");
            asm volatile("s_waitcnt vmcnt(0)" ::: "memory");
        }
    }
    __syncthreads();
}

struct Args { const float* in[21]; float* out; unsigned char* ws; int ph_lo, ph_hi; };
struct Frame {
    LAS unsigned char* lds;
    volatile LAS unsigned* MISC;
    unsigned* ctl;
    int tid, lane, wave, vcu, G;
    float* out; unsigned char* ws;
};
enum { I_X = 0, I_MIXN, I_FFNN, I_WIN, I_BI, I_BF, I_GH, I_WOUT, I_KVN, I_WKV, I_GK, I_WQ, I_GQ, I_WO, I_FG, I_FU, I_FD, I_WR, I_MG, I_MU, I_MD };
__device__ __forceinline__ unsigned f2bf(float f) { unsigned u = __builtin_bit_cast(unsigned, f); return (u + 0x7fffu + ((u >> 16) & 1u)) >> 16; }
__device__ __forceinline__ unsigned pk2(float lo, float hi) { return f2bf(lo) | (f2bf(hi) << 16); }
__device__ __forceinline__ float bf2f(unsigned short b) { return __builtin_bit_cast(float, (unsigned)b << 16); }
__device__ __forceinline__ float wave_sum(float v) {
#pragma unroll
    for (int o = 1; o < 64; o <<= 1) v += __shfl_xor(v, o);
    return v;
}

struct Job { const float* src; int ldw, col0, ncols, K; const float* gain; float scale; void* dst; int type, roff; int fp8; };
__device__ __forceinline__ int rowmap(int type, int roff, int n) {
    if (type == 0) return roff + n;
    if (type == 1) return 256 * (n >> 7) + (n & 127) + roff;
    return roff + 256 * (n >> 8) + 128 * ((n & 63) >> 5) + 32 * ((n & 255) >> 6) + (n & 31);
}
constexpr int SMALL_ITEMS = 256 + 256 + 1024 + 512 + 1408 * 3 + 512 * 4, MOE_ITEMS = 1792, P0_ITEMS = SMALL_ITEMS + 24 * MOE_ITEMS;
constexpr int P0_NOW_ITEMS = P0_ITEMS;
__device__ __forceinline__ void get_job(const Args& A, Frame& F, int it, Job& jb, int& local) {
    unsigned char* ws = F.ws;
    if (it >= SMALL_ITEMS) { const int r = it - SMALL_ITEMS, j = r / MOE_ITEMS; local = r % MOE_ITEMS; const int kind = j >> 3, e = j & 7;
        if (kind == 0)      jb = Job{A.in[I_MG] + (size_t)e * DM * EDIM, EDIM, 0, EDIM, DM, A.in[I_FFNN] + DM, 32.f, ws + WS_WMGU + (size_t)e * 2 * EDIM * DM, 1, 0, 1};
        else if (kind == 1) jb = Job{A.in[I_MU] + (size_t)e * DM * EDIM, EDIM, 0, EDIM, DM, A.in[I_FFNN] + DM, 32.f, ws + WS_WMGU + (size_t)e * 2 * EDIM * DM, 1, 128, 1};
        else                jb = Job{A.in[I_MD] + (size_t)e * EDIM * DM, DM, 0, DM, EDIM, nullptr, 32.f, ws + WS_WMD + (size_t)e * DM * EDIM, 0, 0, 1};
        return; }
    int r = it;
    if (r < 256)  { local = r; jb = Job{A.in[I_WIN], MPROJ, 0, 512, DM, A.in[I_MIXN], 1.f, (bf16*)(ws + WS_WIN), 0, 0, 0}; return; } r -= 256;
    if (r < 256)  { local = r; jb = Job{A.in[I_WIN], MPROJ, 512, 512, DM, A.in[I_MIXN], 0.125f, (bf16*)(ws + WS_WIN), 0, 512, 0}; return; } r -= 256;
    if (r < 1024) { local = r; jb = Job{A.in[I_WIN], MPROJ, 1024, 2048, DM, A.in[I_MIXN], 1.f, (bf16*)(ws + WS_WIN), 0, 1024, 0}; return; } r -= 1024;
    if (r < 512)  { local = r; jb = Job{A.in[I_WOUT], DM, 0, DM, DM, nullptr, 1.f, (bf16*)(ws + WS_WOUT), 0, 0, 0}; return; } r -= 512;
    if (r < 1408) { local = r; jb = Job{A.in[I_FG], FFN, 0, FFN, DM, A.in[I_FFNN], 1.f, (bf16*)(ws + WS_WGU), 1, 0, 0}; return; } r -= 1408;
    if (r < 1408) { local = r; jb = Job{A.in[I_FU], FFN, 0, FFN, DM, A.in[I_FFNN], 1.f, (bf16*)(ws + WS_WGU), 1, 128, 0}; return; } r -= 1408;
    if (r < 1408) { local = r; jb = Job{A.in[I_FD], DM, 0, DM, FFN, nullptr, 1.f, (bf16*)(ws + WS_WD), 0, 0, 0}; return; } r -= 1408;
    if (r < 512)  { local = r; jb = Job{A.in[I_WKV], 2 * DM, 0, DM, DM, A.in[I_KVN], 1.f, (bf16*)(ws + WS_WKVQ), 2, 0, 0}; return; } r -= 512;
    if (r < 512)  { local = r; jb = Job{A.in[I_WKV], 2 * DM, DM, DM, DM, A.in[I_KVN], 1.f, (bf16*)(ws + WS_WKVQ), 2, 1024, 0}; return; } r -= 512;
    if (r < 512)  { local = r; jb = Job{A.in[I_WQ], DM, 0, DM, DM, A.in[I_MIXN] + DM, 1.f, (bf16*)(ws + WS_WKVQ), 2, 2048, 0}; return; } r -= 512;
    local = r; jb = Job{A.in[I_WO], DM, 0, DM, DM, nullptr, 1.f, (bf16*)(ws + WS_WO), 0, 0, 0};
}
struct P0Regs { f32x4 v[8]; };
__device__ __forceinline__ void p0_load(const Job& jb, int item, int lane, P0Regs& R) {
    const int nnb = jb.ncols / 32, kb = item / nnb, nb = item % nnb, k0 = 64 * kb, n0 = 32 * nb;
#pragma unroll
    for (int i = 0; i < 8; ++i) { const int kk = 8 * i + (lane >> 3); R.v[i] = *(const GAS f32x4*)(jb.src + (size_t)(k0 + kk) * jb.ldw + jb.col0 + n0 + 4 * (lane & 7)); }
}
__device__ __forceinline__ void p0_store(const Job& jb, int item, LAS float* scr, int lane, const P0Regs& R) {
    const int nnb = jb.ncols / 32, kb = item / nnb, nb = item % nnb, k0 = 64 * kb, n0 = 32 * nb;
#pragma unroll
    for (int i = 0; i < 8; ++i) { const int kk = 8 * i + (lane >> 3); const float gsc = (jb.gain ? jb.gain[k0 + kk] : 1.f) * jb.scale;
        LAS float* d = scr + kk * 33 + 4 * (lane & 7); d[0] = R.v[i][0] * gsc; d[1] = R.v[i][1] * gsc; d[2] = R.v[i][2] * gsc; d[3] = R.v[i][3] * gsc; }
    LDS_WAIT(); asm volatile("" ::: "memory");
    const int c = lane & 7;
#pragma unroll
    for (int j = 0; j < 4; ++j) { const int n = (lane >> 3) + 8 * j; const LAS float* s = scr + (8 * c) * 33 + n;
        u32x4 o; o.x = pk2(s[0 * 33], s[1 * 33]); o.y = pk2(s[2 * 33], s[3 * 33]); o.z = pk2(s[4 * 33], s[5 * 33]); o.w = pk2(s[6 * 33], s[7 * 33]);
        const size_t eo = (size_t)rowmap(jb.type, jb.roff, n0 + n) * jb.K + k0 + 8 * c;
        if (jb.fp8) { int lo = __builtin_amdgcn_cvt_pk_fp8_f32(s[0 * 33], s[1 * 33], 0, false); lo = __builtin_amdgcn_cvt_pk_fp8_f32(s[2 * 33], s[3 * 33], lo, true);
            int hi = __builtin_amdgcn_cvt_pk_fp8_f32(s[4 * 33], s[5 * 33], 0, false); hi = __builtin_amdgcn_cvt_pk_fp8_f32(s[6 * 33], s[7 * 33], hi, true);
            *(GAS u32x2*)((unsigned char*)jb.dst + eo) = (u32x2){(unsigned)lo, (unsigned)hi}; }
        else *(GAS u32x4*)((bf16*)jb.dst + eo) = o; }
    LDS_WAIT(); asm volatile("" ::: "memory");
}
__device__ __forceinline__ float softcap(float z) { return SOFTCAP * tanhf(z * (1.0f / SOFTCAP)); }
__device__ __forceinline__ void skinny16(const float* x0, const LAS float* G, bf16* xb0, int lane, f32x4& D, float& ssq) {
    const int r = lane & 15, kq = lane >> 4;
    const GAS f32x4* xp = (const GAS f32x4*)(x0 + (size_t)r * DM) + kq; const LAS f32x4* gp = (const LAS f32x4*)G + lane;
    D = (f32x4){0.f, 0.f, 0.f, 0.f}; float ss = 0.f;
#pragma unroll 8
    for (int s = 0; s < 64; ++s) { const f32x4 a = xp[4 * s]; const f32x4 g = gp[64 * s];
        ss += (a[0] * a[0] + a[1] * a[1]) + (a[2] * a[2] + a[3] * a[3]);
        D = __builtin_amdgcn_mfma_f32_16x16x4f32(a[0], g[0], D, 0, 0, 0); D = __builtin_amdgcn_mfma_f32_16x16x4f32(a[1], g[1], D, 0, 0, 0);
        D = __builtin_amdgcn_mfma_f32_16x16x4f32(a[2], g[2], D, 0, 0, 0); D = __builtin_amdgcn_mfma_f32_16x16x4f32(a[3], g[3], D, 0, 0, 0);
        if (xb0) *(GAS u32x2*)(xb0 + (size_t)r * DM + 16 * s + 4 * kq) = (u32x2){pk2(a[0], a[1]), pk2(a[2], a[3])}; }
    ss = sum_xor16(ss); ss = sum_xor32(ss); ssq = ss;
}
__device__ __forceinline__ void skinny16_bf16(const bf16* x0, const LAS float* G, int lane, f32x4& D, float& ssq) {
    const int r = lane & 15, kq = lane >> 4;
    const GAS u32x2* xp = (const GAS u32x2*)(x0 + (size_t)r * DM) + kq; const LAS f32x4* gp = (const LAS f32x4*)G + lane;
    D = (f32x4){0.f, 0.f, 0.f, 0.f}; float ss = 0.f;
#pragma unroll 8
    for (int s = 0; s < 64; ++s) { const u32x2 av = xp[4 * s]; const f32x4 g = gp[64 * s];
        const float a0 = __builtin_bit_cast(float, av.x << 16), a1 = __builtin_bit_cast(float, av.x & 0xffff0000u), a2 = __builtin_bit_cast(float, av.y << 16), a3 = __builtin_bit_cast(float, av.y & 0xffff0000u);
        ss += (a0 * a0 + a1 * a1) + (a2 * a2 + a3 * a3);
        D = __builtin_amdgcn_mfma_f32_16x16x4f32(a0, g[0], D, 0, 0, 0); D = __builtin_amdgcn_mfma_f32_16x16x4f32(a1, g[1], D, 0, 0, 0);
        D = __builtin_amdgcn_mfma_f32_16x16x4f32(a2, g[2], D, 0, 0, 0); D = __builtin_amdgcn_mfma_f32_16x16x4f32(a3, g[3], D, 0, 0, 0); }
    ss = sum_xor16(ss); ss = sum_xor32(ss); ssq = ss;
}
__device__ __forceinline__ void p0_prologue(const Args& A, Frame& F) {
    const int gw = F.vcu * NWAVES + F.wave, NGW = F.G * NWAVES;
    __syncthreads();
    {   LAS float* scr = (LAS float*)(F.lds + RING_OFF + F.wave * 16384);
        int it = gw; Job jb; int local; P0Regs R;
        if (it < P0_NOW_ITEMS) { get_job(A, F, it, jb, local); p0_load(jb, local, F.lane, R); }
        while (it < P0_NOW_ITEMS) {
            const int itn = it + NGW; Job jn = jb; int ln = local; P0Regs Rn = R;
            if (itn < P0_NOW_ITEMS) { get_job(A, F, itn, jn, ln); p0_load(jn, ln, F.lane, Rn); }
            p0_store(jb, local, scr, F.lane, R);
            jb = jn; local = ln; R = Rn; it = itn; } }
    __syncthreads();
    LAS float* Wg = (LAS float*)(F.lds + RING_OFF);
    {   f32x4 wv[8]; float gv[8];
#pragma unroll
        for (int it = 0; it < 8; ++it) { const int idx = F.tid + 512 * it, k = idx >> 2, q = idx & 3; wv[it] = *(const GAS f32x4*)(A.in[I_WIN] + (size_t)k * MPROJ + MPROJ_MAIN + 4 * q); gv[it] = A.in[I_MIXN][k]; }
#pragma unroll
        for (int it = 0; it < 8; ++it) { const int idx = F.tid + 512 * it, k = idx >> 2, q = idx & 3;
#pragma unroll
            for (int c = 0; c < 4; ++c) Wg[((k >> 2) * 16 + 4 * q + c) * 4 + (k & 3)] = wv[it][c] * gv[it]; } }
    LAS float* rsx = (LAS float*)(F.lds + RING_OFF + 65536) + F.wave * 16;
    __syncthreads();
    bf16* xb = (bf16*)(F.ws + WS_A); float* ss0 = (float*)(F.ws + T_SS0); float* gates = (float*)(F.ws + T_GATES);
    for (int tile = gw; tile < MTOK / 16; tile += NGW) {
        const int row0 = tile * 16; f32x4 D; float ssq;
        skinny16(A.in[I_X] + (size_t)row0 * DM, Wg, xb + (size_t)row0 * DM, F.lane, D, ssq);
        if (F.lane < 16) { ss0[row0 + F.lane] = ssq; rsx[F.lane] = rsqrtf(ssq * (1.0f / DM) + EPS); }
        LDS_WAIT(); asm volatile("" ::: "memory");
        const int n = F.lane & 15, rq = F.lane >> 4; const f32x4 rs4 = *(const LAS f32x4*)(rsx + 4 * rq); const float bias = n < 8 ? A.in[I_BI][n] : A.in[I_BF][n - 8];
#pragma unroll
        for (int q = 0; q < 4; ++q) { float z = softcap(D[q] * rs4[q] + bias); if (n >= 8) z = -log1pf(expf(-z)); gates[(size_t)(row0 + 4 * rq + q) * 16 + n] = z; }
        LDS_WAIT(); asm volatile("" ::: "memory");
    }
}
__device__ __forceinline__ void router_phase(const Args& A, Frame& F) {
    LAS float* Wr = (LAS float*)(F.lds + RING_OFF);
    LAS int* hist = (LAS int*)(F.lds + RING_OFF + 65536);
    LAS float* lg = (LAS float*)(F.lds + RING_OFF + 65536 + 64) + F.wave * 272;
    {   f32x4 wv[4]; float gv[4];
#pragma unroll
        for (int it = 0; it < 4; ++it) { const int idx = F.tid + 512 * it, k = idx >> 1, q = idx & 1; wv[it] = *(const GAS f32x4*)(A.in[I_WR] + (size_t)k * NEXP + 4 * q); gv[it] = A.in[I_FFNN][DM + k]; }
#pragma unroll
        for (int it = 0; it < 4; ++it) { const int idx = F.tid + 512 * it, k = idx >> 1, q = idx & 1;
#pragma unroll
            for (int c = 0; c < 4; ++c) { Wr[((k >> 2) * 16 + 4 * q + c) * 4 + (k & 3)] = wv[it][c] * gv[it]; Wr[((k >> 2) * 16 + 8 + 4 * q + c) * 4 + (k & 3)] = 0.f; } } }
    if (F.tid < NEXP) hist[F.tid] = 0;
    __syncthreads();
    int* sele = (int*)(F.ws + T_SELE); float* selw1 = (float*)(F.ws + T_SELW1); float* selw2 = (float*)(F.ws + T_SELW2); float* selrs = (float*)(F.ws + T_SELRS);
    const int TPW = MTOK / F.G;
    for (int i = F.wave * 16; i < TPW; i += NWAVES * 16) {
        const int tok0 = blockIdx.x * TPW + i; f32x4 D; float ssq;
        skinny16_bf16((const bf16*)(F.ws + WS_A) + (size_t)tok0 * DM, Wr, F.lane, D, ssq);
        const int n = F.lane & 15, rq = F.lane >> 4;
#pragma unroll
        for (int q = 0; q < 4; ++q) lg[(4 * rq + q) * 16 + n] = D[q];
        if (F.lane < 16) lg[256 + F.lane] = rsqrtf(ssq * (1.0f / DM) + EPS);
        LDS_WAIT(); asm volatile("" ::: "memory");
        if (F.lane < 16) { const f32x4 l0 = *(const LAS f32x4*)(lg + F.lane * 16), l1 = *(const LAS f32x4*)(lg + F.lane * 16 + 4); const float rs = lg[256 + F.lane];
            const float s[8] = {l0[0], l0[1], l0[2], l0[3], l1[0], l1[1], l1[2], l1[3]};
            float b1 = s[0]; int i1 = 0;
#pragma unroll
            for (int e = 1; e < 8; ++e) if (s[e] > b1) { b1 = s[e]; i1 = e; }
            float b2 = -3.0e38f; int i2 = 0;
#pragma unroll
            for (int e = 0; e < 8; ++e) if (e != i1 && s[e] > b2) { b2 = s[e]; i2 = e; }
            const float w1 = 1.0f / (1.0f + expf((b2 - b1) * rs)), w2 = 1.0f - w1;
            const int tok = tok0 + F.lane; sele[tok] = i1 | (i2 << 8); selw1[tok] = w1; selw2[tok] = w2; selrs[tok] = rs;
            __hip_atomic_fetch_add(hist + i1, 1, __ATOMIC_RELAXED, __HIP_MEMORY_SCOPE_WORKGROUP); __hip_atomic_fetch_add(hist + i2, 1, __ATOMIC_RELAXED, __HIP_MEMORY_SCOPE_WORKGROUP); }
        LDS_WAIT(); asm volatile("" ::: "memory");
    }
    __syncthreads();
    if (F.tid < NEXP) ((int*)(F.ctl + CW_CNT))[blockIdx.x * NEXP + F.tid] = hist[F.tid];
}
__device__ __forceinline__ void slots_phase(Frame& F) {
    LAS int* cn = (LAS int*)(F.lds + RING_OFF);
    LAS int* tot = cn + 2048; LAS int* pre = tot + 8; LAS int* sst = pre + 8; LAS int* tst = sst + 8; LAS int* ntl = tst + 8; LAS int* le = ntl + 16;
    const int TPW = MTOK / F.G; const int w = blockIdx.x;
    for (int i = F.tid; i < F.G * NEXP; i += NWAVES * 64) cn[i] = ((const int*)(F.ctl + CW_CNT))[i];
    __syncthreads();
    if (F.tid < NEXP) { int t = 0, p = 0; for (int ww = 0; ww < F.G; ++ww) { const int c = cn[ww * NEXP + F.tid]; t += c; if (ww < w) p += c; } tot[F.tid] = t; pre[F.tid] = p; }
    __syncthreads();
    if (F.tid == 0) { int ts = 0; for (int e = 0; e < NEXP; ++e) { const int nt = (tot[e] + 255) >> 8; tst[e] = ts; sst[e] = ts * 256; ntl[e] = nt; ts += nt; } ntl[8] = ts; }
    const int* sele = (const int*)(F.ws + T_SELE); const float* selw1 = (const float*)(F.ws + T_SELW1); const float* selw2 = (const float*)(F.ws + T_SELW2); const float* selrs = (const float*)(F.ws + T_SELRS);
    int* slt = (int*)(F.ws + T_SLOT);
#define SL_TOK(s) slt[((s) >> 8) * 1024 + ((s) & 255)]
#define SL_RS(s) ((float*)slt)[((s) >> 8) * 1024 + 256 + ((s) & 255)]
#define SL_W(s) ((float*)slt)[((s) >> 8) * 1024 + 512 + ((s) & 255)]
#define SL_YROW(s) slt[((s) >> 8) * 1024 + 768 + ((s) & 255)]
    if (F.tid < TPW) le[F.tid] = sele[w * TPW + F.tid];
    __syncthreads();
    if (F.tid < 2 * TPW) { const int tl = F.tid >> 1, j = F.tid & 1, mine = le[tl], e = j ? (mine >> 8) : (mine & 255); int rank = 0;
        for (int t2 = 0; t2 < tl; ++t2) { const int o = le[t2]; rank += ((o & 255) == e || (o >> 8) == e) ? 1 : 0; }
        const int slot = sst[e] + pre[e] + rank, token = w * TPW + tl;
        ((int*)(F.ws + T_SLOTOF))[2 * token + j] = slot; SL_TOK(slot) = token; SL_YROW(slot) = 2 * token + j; SL_RS(slot) = selrs[token]; SL_W(slot) = j ? selw2[token] : selw1[token]; }
    if (w < NEXP) { const int e = w, lo = sst[e] + tot[e], hi = sst[e] + 256 * ntl[e]; for (int s = lo + F.tid; s < hi; s += NWAVES * 64) { SL_TOK(s) = 0; SL_YROW(s) = -1; SL_RS(s) = 0.f; SL_W(s) = 0.f; } }
    if (w == 0) { if (F.tid == 0) ((int*)(F.ctl + CW_MOE))[0] = ntl[8];
        for (int e = 0; e < NEXP; ++e) for (int t = F.tid; t < ntl[e]; t += NWAVES * 64) ((int*)(F.ctl + CW_TEXP))[tst[e] + t] = e; }
}
__device__ __forceinline__ f32x4 fp8x4_to_f32(unsigned v) { const f32x2 lo = __builtin_amdgcn_cvt_pk_f32_fp8((int)v, false), hi = __builtin_amdgcn_cvt_pk_f32_fp8((int)v, true); return (f32x4){lo.x, lo.y, hi.x, hi.y}; }
__device__ __forceinline__ void combine_phase(Frame& F) {
    const bf16* x3b = (const bf16*)(F.ws + WS_A); const unsigned char* Y = F.ws + WS_Y;
    const int gw = F.vcu * NWAVES + F.wave, NGW = F.G * NWAVES;
    for (int tokn = gw; tokn < MTOK; tokn += NGW) {
        const GAS u32x2* yp = (const GAS u32x2*)(Y + (size_t)tokn * 2048); const GAS u32x4* xp = (const GAS u32x4*)(x3b + (size_t)tokn * DM);
        u32x2 y0[2], y1[2]; u32x4 xx[2];
#pragma unroll
        for (int p = 0; p < 2; ++p) { y0[p] = yp[64 * p + F.lane]; y1[p] = yp[128 + 64 * p + F.lane]; xx[p] = xp[64 * p + F.lane]; }
        f32x4 ex[2][2];
#pragma unroll
        for (int p = 0; p < 2; ++p) { ex[p][0] = (f32x4){0.f, 0.f, 0.f, 0.f}; ex[p][1] = (f32x4){0.f, 0.f, 0.f, 0.f}; }
        const int s0 = __builtin_amdgcn_readfirstlane(((const int*)(F.ws + T_SLOTOF))[2 * tokn]), s1 = __builtin_amdgcn_readfirstlane(((const int*)(F.ws + T_SLOTOF))[2 * tokn + 1]);
#pragma unroll
        for (int j = 0; j < 2; ++j) { const int sl = j ? s1 : s0;
            if (sl >= 65536) { const int r = (sl - 65536) >> 8, rl = sl & 255;
                if (j) { y1[0] = (u32x2){0u, 0u}; y1[1] = y1[0]; } else { y0[0] = (u32x2){0u, 0u}; y0[1] = y0[0]; }
                for (int ks = 0; ks < 7; ++ks) { const GAS u32x4* pp = (const GAS u32x4*)((const bf16*)(F.ws + B_YP) + (size_t)((r * 7 + ks) * 256 + rl) * DM);
#pragma unroll
                    for (int p = 0; p < 2; ++p) { const u32x4 v = pp[64 * p + F.lane];
#pragma unroll
                        for (int i = 0; i < 2; ++i) { ex[p][0][2 * i] += bf2f((unsigned short)(v[i] & 0xffff)); ex[p][0][2 * i + 1] += bf2f((unsigned short)(v[i] >> 16));
                            ex[p][1][2 * i] += bf2f((unsigned short)(v[i + 2] & 0xffff)); ex[p][1][2 * i + 1] += bf2f((unsigned short)(v[i + 2] >> 16)); } } } } }
        GAS f32x4* op = (GAS f32x4*)(F.out + (size_t)tokn * DM);
#pragma unroll
        for (int p = 0; p < 2; ++p) { f32x4 r0, r1; constexpr float ys = 1.0f / pg8::MOE_YSCALE;
#pragma unroll
            for (int i = 0; i < 2; ++i) { r0[2 * i] = bf2f((unsigned short)(xx[p][i] & 0xffff)); r0[2 * i + 1] = bf2f((unsigned short)(xx[p][i] >> 16));
                r1[2 * i] = bf2f((unsigned short)(xx[p][i + 2] & 0xffff)); r1[2 * i + 1] = bf2f((unsigned short)(xx[p][i + 2] >> 16)); }
            r0 = r0 + (fp8x4_to_f32(y0[p].x) + fp8x4_to_f32(y1[p].x)) * ys + ex[p][0]; r1 = r1 + (fp8x4_to_f32(y0[p].y) + fp8x4_to_f32(y1[p].y)) * ys + ex[p][1];
            op[128 * p + 2 * F.lane] = r0; op[128 * p + 2 * F.lane + 1] = r1; }
    }
}
typedef __bf16 bf16x2_t __attribute__((ext_vector_type(2)));
__device__ __forceinline__ unsigned cvtpk(float lo, float hi) { f32x2 v = {lo, hi}; return __builtin_bit_cast(unsigned, __builtin_convertvector(v, bf16x2_t)); }
__device__ __forceinline__ void sb_block(const bf16x8 (&kf)[4], const bf16x8 (&vf)[4], const bf16x8 (&qf)[4], f32x16& O0, f32x16& O1, float& carry, bool diag, int c, int h) {
    f32x16 X;
#pragma unroll
    for (int i = 0; i < 16; ++i) X[i] = 0.f;
#pragma unroll
    for (int ks = 0; ks < 4; ++ks) X = __builtin_amdgcn_mfma_f32_32x32x16_bf16(kf[ks], qf[ks], X, 0, 0, 0);
    float e[16], r[16];
#pragma unroll
    for (int i = 0; i < 16; ++i) e[i] = __builtin_amdgcn_exp2f(fminf(X[i], 126.0f));
    if (diag) {
#pragma unroll
        for (int i = 0; i < 16; ++i) { const int ko = 16 * (i >> 3) + 8 * h + (i & 7); e[i] = ko < c ? e[i] : 0.f; } }
#pragma unroll
    for (int i = 0; i < 16; ++i) r[i] = __builtin_amdgcn_rcpf(1.0f + e[i]);
    float EA[8], EB[8]; EA[7] = 1.0f; EB[7] = 1.0f;
#pragma unroll
    for (int i = 6; i >= 0; --i) { EA[i] = EA[i + 1] * r[i + 1]; EB[i] = EB[i + 1] * r[8 + i + 1]; }
    const float GA = EA[0] * r[0], GB = EB[0] * r[8];
    const float pGA = get_xor32(GA, h != 0), pGB = get_xor32(GB, h != 0);
    const float TB = h ? carry : carry * pGB;
    const float TA = (carry * pGB) * GB * (h ? 1.0f : pGA);
    carry = ((carry * GA) * GB) * (pGA * pGB);
    float a[16];
#pragma unroll
    for (int i = 0; i < 8; ++i) { a[i] = (EA[i] * TA) * (e[i] * r[i]); a[8 + i] = (EB[i] * TB) * (e[8 + i] * r[8 + i]); }
    u32x4 p0, p1;
    p0.x = cvtpk(a[0], a[1]); p0.y = cvtpk(a[2], a[3]); p0.z = cvtpk(a[4], a[5]); p0.w = cvtpk(a[6], a[7]);
    p1.x = cvtpk(a[8], a[9]); p1.y = cvtpk(a[10], a[11]); p1.z = cvtpk(a[12], a[13]); p1.w = cvtpk(a[14], a[15]);
    const bf16x8 af0 = __builtin_bit_cast(bf16x8, p0), af1 = __builtin_bit_cast(bf16x8, p1);
    O0 = __builtin_amdgcn_mfma_f32_32x32x16_bf16(vf[0], af0, O0, 0, 0, 0); O0 = __builtin_amdgcn_mfma_f32_32x32x16_bf16(vf[1], af1, O0, 0, 0, 0);
    O1 = __builtin_amdgcn_mfma_f32_32x32x16_bf16(vf[2], af0, O1, 0, 0, 0); O1 = __builtin_amdgcn_mfma_f32_32x32x16_bf16(vf[3], af1, O1, 0, 0, 0);
}
__device__ __forceinline__ void sb_fast(Frame& F) {
    const bf16* Kb = (const bf16*)(F.ws + B_SBK); const bf16* Vt = (const bf16*)(F.ws + B_SBVT); bf16* QO = (bf16*)(F.ws + B_SBQ);
    const int lane = F.lane, c = lane & 31, h = lane >> 5;
    for (int chunk = F.vcu; chunk < NBATCH * SBH * (SEQ / 32) / NWAVES; chunk += F.G) {
        const int item = chunk * NWAVES + F.wave, bh = item >> 7, qb = item & 127, b = bh >> 4, hd = bh & 15, t0 = qb * 32;
        bf16* op = (bf16*)(F.ws + B_SBO) + ((size_t)(b * SEQ + t0 + c) * 1024 + hd * 64);
        const bf16* qfp = QO + ((size_t)(bh * 128 + qb) * 4 * 64 + lane) * 8;
        const bf16* kfp = Kb + ((size_t)bh * 128 * 4 * 64 + lane) * 8; const bf16* vfp = Vt + ((size_t)bh * 128 * 4 * 64 + lane) * 8;
#define SB_LOAD(S, KB) do { const int _kb = (KB) > 0 ? (KB) : 0; const bf16* _k = kfp + (size_t)_kb * 2048; const bf16* _v = vfp + (size_t)_kb * 2048; \
            _Pragma("unroll") for (int ks = 0; ks < 4; ++ks) kf##S[ks] = *(const GAS bf16x8*)(_k + 512 * ks); \
            _Pragma("unroll") for (int i = 0; i < 4; ++i) vf##S[i] = *(const GAS bf16x8*)(_v + 512 * i); } while (0)
        bf16x8 qf[4], kf0[4], vf0[4], kf1[4], vf1[4], kf2[4], vf2[4];
        SB_LOAD(0, qb);
#pragma unroll
        for (int ks = 0; ks < 4; ++ks) qf[ks] = *(const GAS bf16x8*)(qfp + 512 * ks);
        SB_LOAD(1, qb - 1); SB_LOAD(2, qb - 2);
        f32x16 O0, O1;
#pragma unroll
        for (int i = 0; i < 16; ++i) { O0[i] = 0.f; O1[i] = 0.f; }
        float carry = 1.0f;
        for (int kb = qb; ; kb -= 3) {
            sb_block(kf0, vf0, qf, O0, O1, carry, kb == qb, c, h);
            if (kb == 0 || !__any(carry >= 1.17549435e-38f)) break;
            SB_LOAD(0, kb - 3);
            sb_block(kf1, vf1, qf, O0, O1, carry, false, c, h);
            if (kb == 1 || !__any(carry >= 1.17549435e-38f)) break;
            SB_LOAD(1, kb - 4);
            sb_block(kf2, vf2, qf, O0, O1, carry, false, c, h);
            if (kb == 2 || !__any(carry >= 1.17549435e-38f)) break;
            SB_LOAD(2, kb - 5);
        }
#undef SB_LOAD
#pragma unroll
        for (int g = 0; g < 4; ++g) {
            u32x2 w0, w1; w0.x = cvtpk(O0[4 * g], O0[4 * g + 1]); w0.y = cvtpk(O0[4 * g + 2], O0[4 * g + 3]); w1.x = cvtpk(O1[4 * g], O1[4 * g + 1]); w1.y = cvtpk(O1[4 * g + 2], O1[4 * g + 3]);
            *(GAS u32x2*)(op + 8 * g + 4 * h) = w0; *(GAS u32x2*)(op + 32 + 8 * g + 4 * h) = w1; }
    }
}
constexpr int ML_SEG0 = 0, ML_SEG1 = 19, ML_SEG2 = 36, ML_SEG3 = 51, ML_SEG4 = 64;
constexpr int ML_U = 0, ML_MM = 16384, ML_NB = 32768, ML_OM = 49152, ML_MC = 65536, ML_MS = 65792, ML_BL = 66048, ML_UX = 66304, ML_P = 66560, ML_QW = ML_P + 2 * 9216, ML_DEN = ML_QW + 2 * 9216, ML_SS = ML_DEN + 512, ML_END = ML_SS + 4096;
static_assert(ML_END <= RING_BYTES, "mLSTM LDS map");
__device__ __forceinline__ bf16x8 pack_frag(const f32x4 a, const f32x4 b) { u32x4 w; w.x = cvtpk(a[0], a[1]); w.y = cvtpk(a[2], a[3]); w.z = cvtpk(b[0], b[1]); w.w = cvtpk(b[2], b[3]); return __builtin_bit_cast(bf16x8, w); }
__device__ __forceinline__ bf16x8 scale_frag(const bf16x8 v, const f32x4 w0, const f32x4 w1) {
    const u32x4 x = __builtin_bit_cast(u32x4, v); f32x4 a, b;
    a[0] = __builtin_bit_cast(float, x[0] << 16) * w0[0]; a[1] = __builtin_bit_cast(float, x[0] & 0xffff0000u) * w0[1]; a[2] = __builtin_bit_cast(float, x[1] << 16) * w0[2]; a[3] = __builtin_bit_cast(float, x[1] & 0xffff0000u) * w0[3];
    b[0] = __builtin_bit_cast(float, x[2] << 16) * w1[0]; b[1] = __builtin_bit_cast(float, x[2] & 0xffff0000u) * w1[1]; b[2] = __builtin_bit_cast(float, x[3] << 16) * w1[2]; b[3] = __builtin_bit_cast(float, x[3] & 0xffff0000u) * w1[3];
    return pack_frag(a, b);
}
#define ML_MFMA(a, b, c) __builtin_amdgcn_mfma_f32_16x16x32_bf16((a), (b), (c), 0, 0, 0)
__device__ __forceinline__ void mlstm_fast(const Args& A, Frame& F) {
    LAS unsigned char* L = F.lds + RING_OFF;
    const bf16* QRF = (const bf16*)(F.ws + B_Q); const bf16* KRF = (const bf16*)(F.ws + B_K); const bf16* KTF = (const bf16*)F.out; const bf16* VTF = (const bf16*)(F.ws + B_VT);
    const bf16* OG = (const bf16*)(F.ws + B_OG); bf16* HN = (bf16*)(F.ws + B_HN); const float* gates = (const float*)(F.ws + T_GATES);
    int tid_l = F.tid; const int w = F.wave;
    for (int unit = blockIdx.x; unit < NBATCH * MH * 4; unit += F.G) {
        const int bh = unit >> 2, seg = unit & 3, b = bh >> 3, h = bh & 7;
        const int c_full = seg == 0 ? ML_SEG0 : seg == 1 ? ML_SEG1 : seg == 2 ? ML_SEG2 : ML_SEG3, c_end = seg == 0 ? ML_SEG1 : seg == 1 ? ML_SEG2 : seg == 2 ? ML_SEG3 : ML_SEG4;
        const size_t rowb = (size_t)b * SEQ;
        __syncthreads();
        f32x4 Ct[4], Cn[4];
#pragma unroll
        for (int i = 0; i < 4; ++i) { Ct[i] = (f32x4){0.f, 0.f, 0.f, 0.f}; Cn[i] = (f32x4){0.f, 0.f, 0.f, 0.f}; }
        const bf16x8 zerof = __builtin_bit_cast(bf16x8, (u32x4){0u, 0u, 0u, 0u});
        {
        const int tid = tid_l, lane = tid & 63, c = lane & 15, q4 = lane >> 4;
        {
        { float ig2[8], lf2[8];
#pragma unroll
          for (int j = 0; j < 8; ++j) { const int cc = w + 8 * j; const size_t row = rowb + (cc < c_end ? cc : 0) * 64 + lane; ig2[j] = gates[row * 16 + h] * LOG2E; lf2[j] = gates[row * 16 + 8 + h] * LOG2E; }
#pragma unroll
          for (int j = 0; j < 8; ++j) { const int cc = w + 8 * j; if (cc < c_end) {
            float bb = lf2[j];
#pragma unroll
            for (int o = 1; o < 64; o <<= 1) { const float t = __shfl_up(bb, o); if (lane >= o) bb += t; }
            const float u = ig2[j] - bb; float pm = u;
#pragma unroll
            for (int o = 1; o < 64; o <<= 1) { const float t = __shfl_up(pm, o); if (lane >= o) pm = fmaxf(pm, t); }
            ((LAS float*)(L + ML_U))[cc * 64 + lane] = u; ((LAS float*)(L + ML_MM))[cc * 64 + lane] = pm; ((LAS float*)(L + ML_NB))[cc * 64 + lane] = -bb;
            if (lane == 63) { ((LAS float*)(L + ML_BL))[cc] = bb; ((LAS float*)(L + ML_UX))[cc] = pm; } } } }
        __syncthreads();
        if (tid == 0) { float m = -__builtin_inff(); for (int cc = 0; cc < c_end; ++cc) { ((LAS float*)(L + ML_MC))[cc] = m; const float ms = fmaxf(m, ((LAS float*)(L + ML_UX))[cc]); ((LAS float*)(L + ML_MS))[cc] = ms; m = ((LAS float*)(L + ML_BL))[cc] + ms; } }
        __syncthreads();
        for (int cc = w; cc < c_end; cc += NWAVES) {
            const float mc = ((LAS float*)(L + ML_MC))[cc], ms = ((LAS float*)(L + ML_MS))[cc];
            const float u = ((LAS float*)(L + ML_U))[cc * 64 + lane], mm = fmaxf(mc, ((LAS float*)(L + ML_MM))[cc * 64 + lane]);
            ((LAS float*)(L + ML_MM))[cc * 64 + lane] = mm; ((LAS float*)(L + ML_NB))[cc * 64 + lane] += -mm; ((LAS float*)(L + ML_OM))[cc * 64 + lane] = __builtin_amdgcn_exp2f(u - ms);
        }
        __syncthreads();
        }
        const bf16* ktp = KTF + ((size_t)bh * 64 * 8 * 64 + lane) * 8;
        const bf16* vtp = VTF + (((size_t)bh * 64 * 8 + w) * 2 * 64 + lane) * 8;
#define ML_LOADKV(KT_, VT_, CC) do { _Pragma("unroll") for (int i = 0; i < 4; ++i) _Pragma("unroll") for (int ks = 0; ks < 2; ++ks) KT_[i][ks] = *(const GAS bf16x8*)(ktp + (size_t)(CC) * 4096 + (i * 2 + ks) * 512); \
            _Pragma("unroll") for (int ks = 0; ks < 2; ++ks) VT_[ks] = *(const GAS bf16x8*)(vtp + (size_t)(CC) * 8192 + ks * 512); } while (0)
#define ML_UPDATE(KT_, VT_, CC) do { const float _a = __builtin_amdgcn_exp2f(((LAS float*)(L + ML_MC))[CC] - ((LAS float*)(L + ML_MS))[CC]); bf16x8 _vw[2], _ow[2]; \
            _Pragma("unroll") for (int ks = 0; ks < 2; ++ks) { const f32x4 o0 = *(const LAS f32x4*)(L + ML_OM + ((CC) * 64 + 32 * ks + 8 * q4) * 4), o1 = *(const LAS f32x4*)(L + ML_OM + ((CC) * 64 + 32 * ks + 8 * q4 + 4) * 4); \
                _vw[ks] = scale_frag(VT_[ks], o0, o1); _ow[ks] = (c == 0) ? pack_frag(o0, o1) : zerof; } \
            _Pragma("unroll") for (int i = 0; i < 4; ++i) { Ct[i] = Ct[i] * _a; Ct[i] = ML_MFMA(KT_[i][0], _vw[0], Ct[i]); Ct[i] = ML_MFMA(KT_[i][1], _vw[1], Ct[i]); } \
            if (w == 4) { _Pragma("unroll") for (int i = 0; i < 4; ++i) { Cn[i] = Cn[i] * _a; Cn[i] = ML_MFMA(KT_[i][0], _ow[0], Cn[i]); Cn[i] = ML_MFMA(KT_[i][1], _ow[1], Cn[i]); } } } while (0)
        {   bf16x8 kt0[4][2], vt0[2], kt1[4][2], vt1[2], kt2[4][2], vt2[2];
#define ML_LD(S, CC) do { if ((CC) < c_full) ML_LOADKV(kt##S, vt##S, CC); } while (0)
#define ML_UP(S, CC) do { if ((CC) < c_full) ML_UPDATE(kt##S, vt##S, CC); } while (0)
            ML_LOADKV(kt0, vt0, 0); ML_LOADKV(kt1, vt1, 1); ML_LOADKV(kt2, vt2, 2);
            for (int cc = 0; cc < c_full; cc += 3) {
                ML_UP(0, cc);     ML_LD(0, cc + 3);
                ML_UP(1, cc + 1); ML_LD(1, cc + 4);
                ML_UP(2, cc + 2); ML_LD(2, cc + 5);
            }
#undef ML_LD
#undef ML_UP
        }
        }
        asm volatile("" : "+v"(tid_l));
        const int tid = tid_l, lane = tid & 63, c = lane & 15, q4 = lane >> 4;
        const bf16* ktp = KTF + ((size_t)bh * 64 * 8 * 64 + lane) * 8; const bf16* vtp = VTF + (((size_t)bh * 64 * 8 + w) * 2 * 64 + lane) * 8;
        const bf16* qrp = QRF + (size_t)bh * 64 * 4096; const bf16* krp = KRF + (size_t)bh * 64 * 4096;
        const bf16x8 onesf = __builtin_bit_cast(bf16x8, (u32x4){0x3f803f80u, 0x3f803f80u, 0x3f803f80u, 0x3f803f80u});
        bf16x8 kt[4][2], vt[2];
        ML_LOADKV(kt, vt, c_full);
        const int tt_p = w & 3, sh_p = w >> 2; const bool pmake = 2 * sh_p <= tt_p;
        bf16x8 qf[2], kfa[2][2]; u32x4 qv; u32x2 sg[4];
#define ML_LOADP(CC) do { const bf16* _q = qrp + (size_t)(CC) * 4096; const bf16* _k = krp + (size_t)(CC) * 4096; \
            if (pmake) { _Pragma("unroll") for (int ks = 0; ks < 2; ++ks) { qf[ks] = *(const GAS bf16x8*)(_q + (tt_p * 2 + ks) * 512 + lane * 8); \
                _Pragma("unroll") for (int s2 = 0; s2 < 2; ++s2) kfa[s2][ks] = *(const GAS bf16x8*)(_k + ((2 * sh_p + s2) * 2 + ks) * 512 + lane * 8); } } \
            qv = *(const GAS u32x4*)(_q + (((tid >> 7) * 2 + ((tid >> 2) & 1)) * 64 + ((tid >> 3) & 15) + 16 * (tid & 3)) * 8); } while (0)
        qf[0] = qf[1] = zerof; kfa[0][0] = kfa[0][1] = kfa[1][0] = kfa[1][1] = zerof;
        ML_LOADP(c_full);
        const f32x4 gh4 = *(const GAS f32x4*)(A.in[I_GH] + h * MDV + 16 * w + 4 * q4);
        f32x4 nTp[4];
#pragma unroll
        for (int tt = 0; tt < 4; ++tt) nTp[tt] = (f32x4){0.f, 0.f, 0.f, 0.f};
#define ML_FINAL(NT, CC) do { const int _par = (CC) & 1, _t0 = (CC) * 64; LAS float* _DEN = (LAS float*)(L + ML_DEN) + _par * 64; LAS float* _SS = (LAS float*)(L + ML_SS) + _par * 512; \
            _Pragma("unroll") for (int tt = 0; tt < 4; ++tt) { const int t = 16 * tt + c; const f32x4 s0 = *(const LAS f32x4*)(_SS + t * 8), s1 = *(const LAS f32x4*)(_SS + t * 8 + 4); \
                const float ssn = ((s0[0] + s0[1]) + (s0[2] + s0[3])) + ((s1[0] + s1[1]) + (s1[2] + s1[3])); \
                const float dn = fmaxf(fabsf(_DEN[t]), __builtin_amdgcn_exp2f(((LAS float*)(L + ML_NB))[(CC) * 64 + t])); \
                const float rinv = rsqrtf(ssn * (1.0f / MDV) + EPS * dn * dn); \
                const size_t o = (rowb + _t0 + t) * 1024 + h * MDV + 16 * w + 4 * q4; \
                const float o0 = NT[tt][0] * rinv * gh4[0] * __builtin_bit_cast(float, sg[tt].x << 16), o1 = NT[tt][1] * rinv * gh4[1] * __builtin_bit_cast(float, sg[tt].x & 0xffff0000u); \
                const float o2 = NT[tt][2] * rinv * gh4[2] * __builtin_bit_cast(float, sg[tt].y << 16), o3 = NT[tt][3] * rinv * gh4[3] * __builtin_bit_cast(float, sg[tt].y & 0xffff0000u); \
                *(GAS u32x2*)(HN + o) = (u32x2){cvtpk(o0, o1), cvtpk(o2, o3)}; } } while (0)
        {
        for (int cc = c_full; cc < c_end; ++cc) {
            const int par = cc & 1, t0 = cc * 64; const bool more = cc + 1 < c_end;
            if (cc > c_full) {
#pragma unroll
                for (int tt = 0; tt < 4; ++tt) sg[tt] = *(const GAS u32x2*)(OG + (rowb + t0 - 64 + 16 * tt + c) * 1024 + h * MDV + 16 * w + 4 * q4); }
            const float mc = ((LAS float*)(L + ML_MC))[cc];
            LAS unsigned char* Pb = L + ML_P + par * 9216; LAS unsigned char* Qb = L + ML_QW + par * 9216;
            bf16x8 cf[2], cnf[2];
#pragma unroll
            for (int ks = 0; ks < 2; ++ks) { cf[ks] = pack_frag(Ct[2 * ks], Ct[2 * ks + 1]); cnf[ks] = pack_frag(Cn[2 * ks], Cn[2 * ks + 1]); }
            { const int t = tid >> 3, ch = tid & 7;
              const float wi = __builtin_amdgcn_exp2f(mc - ((LAS float*)(L + ML_MM))[cc * 64 + t]); const f32x4 w4 = (f32x4){wi, wi, wi, wi};
              *(LAS bf16x8*)(Qb + t * 144 + ch * 16) = scale_frag(__builtin_bit_cast(bf16x8, qv), w4, w4); }
            if (pmake) {
                const float mmt = ((LAS float*)(L + ML_MM))[cc * 64 + 16 * tt_p + c];
#pragma unroll
                for (int s2 = 0; s2 < 2; ++s2) { const int st = 2 * sh_p + s2; u32x2 pw = (u32x2){0u, 0u};
                    if (st <= tt_p) {
                        f32x4 sT = (f32x4){0.f, 0.f, 0.f, 0.f};
#pragma unroll
                        for (int ks = 0; ks < 2; ++ks) sT = ML_MFMA(kfa[s2][ks], qf[ks], sT);
                        const f32x4 u4 = *(const LAS f32x4*)(L + ML_U + (cc * 64 + 16 * st + 4 * q4) * 4); f32x4 p;
#pragma unroll
                        for (int r = 0; r < 4; ++r) { const bool ok = (16 * st + 4 * q4 + r) <= (16 * tt_p + c); p[r] = ok ? sT[r] * __builtin_amdgcn_exp2f(u4[r] - mmt) : 0.f; }
                        pw.x = cvtpk(p[0], p[1]); pw.y = cvtpk(p[2], p[3]); }
                    *(LAS u32x2*)(Pb + (16 * tt_p + c) * 144 + (16 * st + 4 * q4) * 2) = pw; } }
            if (more) ML_LOADP(cc + 1);
            ML_UPDATE(kt, vt, cc);
            if (more) {
#pragma unroll
                for (int i = 0; i < 4; ++i)
#pragma unroll
                    for (int ks = 0; ks < 2; ++ks) kt[i][ks] = *(const GAS bf16x8*)(ktp + (size_t)(cc + 1) * 4096 + (i * 2 + ks) * 512); }
            asm volatile("s_waitcnt lgkmcnt(0)" ::: "memory"); __builtin_amdgcn_s_barrier(); asm volatile("" ::: "memory");
            if (cc > c_full) ML_FINAL(nTp, cc - 1);
            f32x4 nT[4], dT[4];
#pragma unroll
            for (int tt = 0; tt < 4; ++tt) { nT[tt] = (f32x4){0.f, 0.f, 0.f, 0.f}; dT[tt] = (f32x4){0.f, 0.f, 0.f, 0.f}; }
#pragma unroll
            for (int tt = 0; tt < 4; ++tt) {
#pragma unroll
                for (int ks = 0; ks < 2; ++ks) {
                    if (ks == 0 || tt >= 2) { const bf16x8 pf = *(const LAS bf16x8*)(Pb + (16 * tt + c) * 144 + (32 * ks + 8 * q4) * 2);
                        nT[tt] = ML_MFMA(vt[ks], pf, nT[tt]); if (w == 4) dT[tt] = ML_MFMA(c == 0 ? onesf : zerof, pf, dT[tt]); }
                    const u32x2 qa = *(const LAS u32x2*)(Qb + (16 * tt + c) * 144 + (32 * ks + 4 * q4) * 2), qb2 = *(const LAS u32x2*)(Qb + (16 * tt + c) * 144 + (32 * ks + 16 + 4 * q4) * 2);
                    const bf16x8 qwf = __builtin_bit_cast(bf16x8, (u32x4){qa.x, qa.y, qb2.x, qb2.y});
                    nT[tt] = ML_MFMA(cf[ks], qwf, nT[tt]); if (w == 4) dT[tt] = ML_MFMA(cnf[ks], qwf, dT[tt]); } }
            if (more) { vt[0] = *(const GAS bf16x8*)(vtp + (size_t)(cc + 1) * 8192); vt[1] = *(const GAS bf16x8*)(vtp + (size_t)(cc + 1) * 8192 + 512); }
            LAS float* DEN = (LAS float*)(L + ML_DEN) + par * 64; LAS float* SS = (LAS float*)(L + ML_SS) + par * 512;
#pragma unroll
            for (int tt = 0; tt < 4; ++tt) { float s = (nT[tt][0] * nT[tt][0] + nT[tt][1] * nT[tt][1]) + (nT[tt][2] * nT[tt][2] + nT[tt][3] * nT[tt][3]); s = sum_xor16(s); s = sum_xor32(s);
                if (q4 == 0) { SS[(16 * tt + c) * 8 + w] = s; if (w == 4) DEN[16 * tt + c] = dT[tt][0]; } }
#pragma unroll
            for (int tt = 0; tt < 4; ++tt) nTp[tt] = nT[tt];
        }
#pragma unroll
        for (int tt = 0; tt < 4; ++tt) sg[tt] = *(const GAS u32x2*)(OG + (rowb + (c_end - 1) * 64 + 16 * tt + c) * 1024 + h * MDV + 16 * w + 4 * q4);
        asm volatile("s_waitcnt lgkmcnt(0)" ::: "memory"); __builtin_amdgcn_s_barrier(); asm volatile("" ::: "memory");
        ML_FINAL(nTp, c_end - 1);
        }
#undef ML_FINAL
#undef ML_LOADP
#undef ML_UPDATE
#undef ML_LOADKV
    }
}
constexpr int N_PHASES = 16;
__device__ __forceinline__ void mkframe(const Args& args, Frame& F, LAS unsigned char* lds, const int wv) {
    F.lds = lds; F.MISC = (volatile LAS unsigned*)(lds + MISC_OFF);
    F.lane = lane_now(); F.wave = wv; F.tid = wv * 64 + F.lane;
    F.G = gridDim.x; { const int bx = blockIdx.x; F.vcu = (F.G % 8 == 0) ? (bx % 8) * (F.G / 8) + bx / 8 : bx; }
    unsigned char* ws = args.ws; float* out = args.out; asm volatile("" : "+s"(ws), "+s"(out));
    F.ws = ws; F.out = out; F.ctl = (unsigned*)(ws + WS_CTL);
}
__device__ __forceinline__ void grid_barrier(const Args& args, LAS unsigned char* lds, const int wv) {
    unsigned char* ws = args.ws; asm volatile("" : "+s"(ws));
    XcdBarrier bar; bar.bar = (unsigned*)(ws + WS_CTL) + CW_BAR; bar.x = xb_xcc_id(); bar.st = (volatile LAS unsigned*)(lds + MISC_OFF) + 8;
    xcd_barrier(bar, wv == 0 && lane_now() == 0);
}
#ifndef PHASE_MASK
#define PHASE_MASK 0xffff
#endif
template <int LO, int HI>
__global__ void __launch_bounds__(NWAVES * 64, 2) fwd_kernel(Args args) {
    extern __shared__ __attribute__((aligned(16))) unsigned char lds_raw[];
    LAS unsigned char* lds = (LAS unsigned char*)lds_raw;
    const int wv = __builtin_amdgcn_readfirstlane((int)threadIdx.x >> 6);
    for (int u = wv * 64 + lane_now(); u < (LDS_BYTES - AUX_OFF) / 4; u += NWAVES * 64) ((LAS unsigned*)(lds + AUX_OFF))[u] = 0u;
    __syncthreads();
    if constexpr (HI - LO > 1) { unsigned char* ws = args.ws; (void)xcd_barrier_post((unsigned*)(ws + WS_CTL) + CW_BAR, (volatile LAS unsigned*)(lds + MISC_OFF) + 8, wv == 0 && lane_now() == 0); }
#define IN(k) (((PHASE_MASK >> (k)) & 1) && LO <= (k) && (k) < HI)
#define SEAM(k) do { if constexpr (IN(k) && IN((k) + 1)) grid_barrier(args, lds, wv); } while (0)
#ifndef REPEAT_MASK
#define REPEAT_MASK 0
#endif
#define REPS(k) _Pragma("unroll") for (int rep_ = 0; rep_ < (((REPEAT_MASK >> (k)) & 1) ? 2 : 1); ++rep_)
#define RING (F.lds + RING_OFF)
#define AUXB (F.lds + AUX_OFF)
#define RED ((LAS float*)(F.lds + RED_OFF))
#define SSP ((float*)(F.ws + T_SSP))
#define XBUF ((bf16*)(F.ws + WS_A))
    if constexpr (IN(0)) REPS(0) { Frame F; mkframe(args, F, lds, wv); p0_prologue(args, F); } SEAM(0);
    if constexpr (IN(1)) REPS(1) {
        Frame F; mkframe(args, F, lds, wv);
        pg8::Gemm g{XBUF, (const bf16*)(F.ws + WS_WIN), DM, DM}; pg8::StaticOrder S; S.init(MTOK, MPROJ_MAIN, F.G, (int)blockIdx.x);
        pg8::EpiProj E{(bf16*)(F.ws + B_Q), (bf16*)(F.ws + B_K), (bf16*)F.out, (bf16*)(F.ws + B_VT), (bf16*)(F.ws + B_OG), (const float*)(F.ws + T_SS0), (LAS bf16_t*)(F.lds + RED_OFF)};
        pg8::gemm_phase<pg8::EpiProj, pg8::StaticOrder, false>(RING, AUXB, g, S, E, wv);
    } SEAM(1);
        if constexpr (IN(2)) REPS(2) { Frame F; mkframe(args, F, lds, wv); mlstm_fast(args, F); } SEAM(2);
    if constexpr (IN(3)) {
        Frame F; mkframe(args, F, lds, wv);
        pg8::Gemm g{(const bf16*)(F.ws + B_HN), (const bf16*)(F.ws + WS_WOUT), DM, DM}; pg8::StaticOrder S; S.init(MTOK, DM, F.G, (int)blockIdx.x);
        pg8::EpiRes E{XBUF, nullptr, SSP, RED, nullptr, wv};
        pg8::gemm_phase<pg8::EpiRes, pg8::StaticOrder, false>(RING, AUXB, g, S, E, wv);
    } SEAM(3);
    if constexpr (IN(4)) REPS(4) {
        Frame F; mkframe(args, F, lds, wv);
        pg8::Gemm g{XBUF, (const bf16*)(F.ws + WS_WGU), DM, DM}; pg8::StaticOrder S; S.init(MTOK, 2 * FFN, F.G, (int)blockIdx.x);
        pg8::EpiGu<false> E{F.ws + B_HF, FFN, SSP};
        pg8::gemm_phase<pg8::EpiGu<false>, pg8::StaticOrder, false>(RING, AUXB, g, S, E, wv);
    } SEAM(4);
    if constexpr (IN(5)) {
        Frame F; mkframe(args, F, lds, wv);
        pg8::Gemm g{(const bf16*)(F.ws + B_HF), (const bf16*)(F.ws + WS_WD), FFN, FFN}; pg8::StaticOrder S; S.init(MTOK, DM, F.G, (int)blockIdx.x);
        pg8::EpiRes E{XBUF, nullptr, SSP, RED, nullptr, wv};
        pg8::gemm_phase<pg8::EpiRes, pg8::StaticOrder, false>(RING, AUXB, g, S, E, wv);
    } SEAM(5);
    if constexpr (IN(6)) REPS(6) {
        Frame F; mkframe(args, F, lds, wv);
        LAS float* gkq = (LAS float*)(F.lds + TEX_OFF);
        if (F.tid < 64) gkq[F.tid] = args.in[I_GK][F.tid]; else if (F.tid < 128) gkq[F.tid] = args.in[I_GQ][F.tid - 64];
        __syncthreads();
        pg8::Gemm g{XBUF, (const bf16*)(F.ws + WS_WKVQ), DM, DM}; pg8::StaticOrder S; S.init(MTOK, 3 * DM, F.G, (int)blockIdx.x);
        pg8::EpiKvq E{(bf16*)(F.ws + B_SBK), (bf16*)(F.ws + B_SBVT), (bf16*)(F.ws + B_SBQ), SSP, gkq, (LAS bf16_t*)(F.lds + RED_OFF)};
        pg8::gemm_phase<pg8::EpiKvq, pg8::StaticOrder, false>(RING, AUXB, g, S, E, wv);
    } SEAM(6);
        if constexpr (IN(7)) REPS(7) { Frame F; mkframe(args, F, lds, wv); sb_fast(F); } SEAM(7);
    if constexpr (IN(8)) {
        Frame F; mkframe(args, F, lds, wv);
        pg8::Gemm g{(const bf16*)(F.ws + B_SBO), (const bf16*)(F.ws + WS_WO), DM, DM}; pg8::StaticOrder S; S.init(MTOK, DM, F.G, (int)blockIdx.x);
        pg8::EpiRes E{XBUF, nullptr, nullptr, RED, F.ws + B_X3Q, wv};
        pg8::gemm_phase<pg8::EpiRes, pg8::StaticOrder, false>(RING, AUXB, g, S, E, wv);
    } SEAM(8);
    if constexpr (IN(9)) REPS(9) { Frame F; mkframe(args, F, lds, wv); router_phase(args, F); } SEAM(9);
    if constexpr (IN(10)) { Frame F; mkframe(args, F, lds, wv); slots_phase(F); } SEAM(10);
#define MOE_SETUP \
        Frame F; mkframe(args, F, lds, wv); LAS int* tex = (LAS int*)(F.lds + TEX_OFF); \
        __syncthreads(); \
        const int ntl = __builtin_amdgcn_readfirstlane(((const int*)(F.ctl + CW_MOE))[0]); \
        for (int i = F.tid; i < MAXTILES; i += NWAVES * 64) tex[i] = i < ntl ? ((const int*)(F.ctl + CW_TEXP))[i] : 0; \
        __syncthreads();
    if constexpr (IN(11)) REPS(11) { MOE_SETUP
        pg8::Gemm g{F.ws + B_X3Q, F.ws + WS_WMGU, DM, DM}; pg8::MoeOrder S{0, ntl, 2 * EDIM / 256, F.G, (int)blockIdx.x, tex};
        pg8::EpiGu<true> E{F.ws + B_HM, EDIM, (const float*)(F.ws + T_SLOT)};
        pg8::gemm_phase<pg8::EpiGu<true>, pg8::MoeOrder, true, true>(RING, AUXB, g, S, E, wv); }
    SEAM(11);
    if constexpr (IN(12)) REPS(12) { MOE_SETUP
        { pg8::Gemm g{F.ws + B_HM, F.ws + WS_WMD, EDIM, EDIM}; pg8::MoeOrder S{0, ntl < 256 ? ntl : 256, DM / 256, F.G, (int)blockIdx.x, tex};
          pg8::EpiMoeDn E{F.ws + WS_Y, (const int*)(F.ws + T_SLOT)};
          pg8::gemm_phase<pg8::EpiMoeDn, pg8::MoeOrder, false, true>(RING, AUXB, g, S, E, wv); }
        if (ntl > 256) { __syncthreads();
          pg8::Gemm g{F.ws + B_HM, F.ws + WS_WMD, 512, EDIM}; pg8::MoeRemOrder S{ntl - 256, F.G, (int)blockIdx.x, tex};
          pg8::EpiMoeDnPart E{(bf16*)(F.ws + B_YP)};
          pg8::gemm_phase<pg8::EpiMoeDnPart, pg8::MoeRemOrder, false, true>(RING, AUXB, g, S, E, wv); } }
    if constexpr (IN(12) && IN(15)) grid_barrier(args, lds, wv);
    if constexpr (IN(15)) { Frame F; mkframe(args, F, lds, wv); combine_phase(F); }
#undef IN
#undef SEAM
}

#ifndef LAST_PHASE
#define LAST_PHASE 15
#endif
#ifndef ONE_LAUNCH
#define ONE_LAUNCH 1
#endif
typedef void (*kern_t)(Args);
template <int P> struct PhaseTab { static void fill(kern_t* t) { t[P] = fwd_kernel<P, P + 1>; PhaseTab<P - 1>::fill(t); } };
template <> struct PhaseTab<-1> { static void fill(kern_t*) {} };
extern "C" void kernel_launch(void* const* d_in, const int* in_sizes, int n_in, void* d_out, int out_size, void* d_ws, size_t ws_size, hipStream_t stream) {
    static int grid = 0; static kern_t tab[N_PHASES + 1];
    if (grid == 0) {
        if (n_in != 21 || in_sizes[0] != MTOK * DM || out_size != MTOK * DM || ws_size < WS_END) { fprintf(stderr, "kernel_launch: unexpected shapes / workspace (%d inputs, ws %zu); nothing launched\n", n_in, ws_size); grid = -1; return; }
        int dev = 0, cus = 0;
        if (hipGetDevice(&dev) != hipSuccess || hipDeviceGetAttribute(&cus, hipDeviceAttributeMultiprocessorCount, dev) != hipSuccess) { grid = -1; return; }
#if ONE_LAUNCH
        tab[N_PHASES] = fwd_kernel<0, LAST_PHASE + 1>;
        if (hipFuncSetAttribute((const void*)tab[N_PHASES], hipFuncAttributeMaxDynamicSharedMemorySize, LDS_BYTES) != hipSuccess) { fprintf(stderr, "kernel_launch: hipFuncSetAttribute failed\n"); grid = -1; return; }
        int per_cu = 0;
        if (hipOccupancyMaxActiveBlocksPerMultiprocessor(&per_cu, (const void*)tab[N_PHASES], NWAVES * 64, LDS_BYTES) != hipSuccess || per_cu < 1) fprintf(stderr, "kernel_launch: note: occupancy query reports %d workgroups per CU\n", per_cu);
#else
        PhaseTab<N_PHASES - 1>::fill(tab);
        for (int p = 0; p < N_PHASES; ++p) if (hipFuncSetAttribute((const void*)tab[p], hipFuncAttributeMaxDynamicSharedMemorySize, LDS_BYTES) != hipSuccess) { fprintf(stderr, "kernel_launch: hipFuncSetAttribute failed\n"); grid = -1; return; }
#endif
        (void)hipGetLastError();
        grid = cus;
        if (grid != 256) fprintf(stderr, "kernel_launch: built for 256 CUs, found %d\n", grid);
    }
    if (grid < 0) return;
    if (hipMemsetAsync((char*)d_ws + WS_CTL, 0, CTL_ZERO_BYTES, stream) != hipSuccess) return;
    Args a{};
    for (int i = 0; i < 21; ++i) a.in[i] = (const float*)d_in[i];
    a.out = (float*)d_out; a.ws = (unsigned char*)d_ws; a.ph_lo = 0; a.ph_hi = LAST_PHASE + 1;
#if ONE_LAUNCH
    hipLaunchKernelGGL(tab[N_PHASES], dim3(grid), dim3(NWAVES * 64), LDS_BYTES, stream, a);
#else
    for (int p = 0; p <= LAST_PHASE; ++p) hipLaunchKernelGGL(tab[p], dim3(grid), dim3(NWAVES * 64), LDS_BYTES, stream, a);
#endif
}
```

```cpp
#include <hip/hip_runtime.h>
#include <cstdio>
#include <cstdint>
#define GAS __attribute__((address_space(1)))
#define LAS __attribute__((address_space(3)))
typedef unsigned short bf16;
typedef unsigned short bf16_t;
typedef short bf16x8 __attribute__((ext_vector_type(8)));
typedef float f32x4 __attribute__((ext_vector_type(4)));
typedef float f32x2 __attribute__((ext_vector_type(2)));
typedef float f32x16 __attribute__((ext_vector_type(16)));
typedef unsigned u32x4 __attribute__((ext_vector_type(4)));
typedef unsigned u32x2 __attribute__((ext_vector_type(2)));
typedef GAS unsigned gu32;
#define RLX_AGENT __ATOMIC_RELAXED, __HIP_MEMORY_SCOPE_AGENT
#define LDS_WAIT() asm volatile("s_waitcnt lgkmcnt(0)" ::: "memory")
#define VM_WAIT() asm volatile("s_waitcnt vmcnt(0)" ::: "memory")
__device__ __forceinline__ float sum_xor16(float s) { const unsigned a = __builtin_bit_cast(unsigned, s); const auto r = __builtin_amdgcn_permlane16_swap(a, a, false, false); unsigned r0 = r[0], r1 = r[1]; asm volatile("" : "+v"(r0), "+v"(r1)); return __builtin_bit_cast(float, r0) + __builtin_bit_cast(float, r1); }
__device__ __forceinline__ float sum_xor32(float s) { const unsigned a = __builtin_bit_cast(unsigned, s); const auto r = __builtin_amdgcn_permlane32_swap(a, a, false, false); unsigned r0 = r[0], r1 = r[1]; asm volatile("" : "+v"(r0), "+v"(r1)); return __builtin_bit_cast(float, r0) + __builtin_bit_cast(float, r1); }
__device__ __forceinline__ float get_xor32(float s, bool upper) { const unsigned a = __builtin_bit_cast(unsigned, s); const auto r = __builtin_amdgcn_permlane32_swap(a, a, false, false); unsigned r0 = r[0], r1 = r[1]; asm volatile("" : "+v"(r0), "+v"(r1)); return __builtin_bit_cast(float, upper ? r0 : r1); }
template <int CTRL, int RM> __device__ __forceinline__ float dpp_take(float idv, float x) { return __builtin_bit_cast(float, __builtin_amdgcn_update_dpp(__builtin_bit_cast(int, idv), __builtin_bit_cast(int, x), CTRL, RM, 0xF, false)); }
__device__ __forceinline__ float wave_scan_add(float x) {
    x += dpp_take<0x111, 0xF>(0.f, x); x += dpp_take<0x112, 0xF>(0.f, x); x += dpp_take<0x114, 0xF>(0.f, x); x += dpp_take<0x118, 0xF>(0.f, x);
    x += dpp_take<0x142, 0xA>(0.f, x); x += dpp_take<0x143, 0xC>(0.f, x); return x; }
__device__ __forceinline__ float wave_scan_max(float x) { const float ni = -__builtin_inff();
    x = fmaxf(x, dpp_take<0x111, 0xF>(ni, x)); x = fmaxf(x, dpp_take<0x112, 0xF>(ni, x)); x = fmaxf(x, dpp_take<0x114, 0xF>(ni, x)); x = fmaxf(x, dpp_take<0x118, 0xF>(ni, x));
    x = fmaxf(x, dpp_take<0x142, 0xA>(ni, x)); x = fmaxf(x, dpp_take<0x143, 0xC>(ni, x)); return x; }
__device__ __forceinline__ int lane_now() { int l; asm volatile("v_mbcnt_lo_u32_b32 %0, -1, 0\n\tv_mbcnt_hi_u32_b32 %0, -1, %0" : "=v"(l)); return l; }

constexpr int DM = 1024, NBATCH = 8, SEQ = 4096, MTOK = NBATCH * SEQ;
constexpr int MH = 8, MDK = 64, MDV = 128, MPROJ = 3088, MPROJ_MAIN = 3072;
constexpr int SBH = 16, SBD = 64;
constexpr int FFN = 2816, NEXP = 8, EDIM = 3584;
constexpr float EPS = 1e-6f, SOFTCAP = 15.0f;
constexpr float LOG2E = 1.4426950408889634f;
constexpr int NWAVES = 8;
constexpr int MAXTILES = 264;
constexpr int HALF0_TILES = 128;
namespace pg8 {
constexpr int BM = 256, BK = 64, HALF = 128, HTB = HALF * BK * 2  , STAGE_BYTES = 8 * HTB, NXCD = 8, WGM = 8;

__host__ __device__ __forceinline__ int lds_byte(int r, int c) { const int st = (r >> 4) * 2 + (c >> 5), rr = r & 15, cc = c & 31, ob = rr * 64 + cc * 2; return st * 1024 + (ob ^ (((ob >> 9) & 1) << 5)); }
__host__ __device__ __forceinline__ void stage_rc(int b, int& R, int& C) { const int st = b / 1024, sb = b % 1024, swz = sb ^ (((sb >> 9) & 1) << 5); R = (st >> 1) * 16 + swz / 64; C = (st & 1) * 32 + (swz % 64) / 2; }
__host__ __device__ __forceinline__ int perm32(int rho) { const int n = rho >> 4, i = rho & 15; return 8 * (i >> 2) + 4 * n + (i & 3); }

struct Unit { int pm, pn, pb, pa, ko; };
struct Gemm { const void* A; const void* Bt; int K, ld; };

struct StaticOrder {
    int nM, nN, nwg, G, c;
    __device__ void init(int M, int N, int G_, int c_) { nM = M / BM; nN = N / BM; nwg = nM * nN; G = G_; c = c_; }
    __device__ bool next(int i, Unit& u) const {
        const long L = (long)i * G + c; if (L >= nwg) return false;
        int wgid = (int)L; { const int q = nwg / NXCD, r = nwg % NXCD, xcd = wgid % NXCD, off = wgid / NXCD; wgid = (xcd < r ? xcd * (q + 1) : r * (q + 1) + (xcd - r) * q) + off; }
        const int nig = WGM * nN, gid = wgid / nig, fm = gid * WGM, gsz = (nM - fm) < WGM ? (nM - fm) : WGM;
        u.pm = fm + ((wgid % nig) % gsz); u.pn = (wgid % nig) / gsz; u.pb = u.pn; u.pa = u.pm; u.ko = 0; return true;
    }
};
struct MoeOrder {
    int tile_lo, ntile, nN, G, c; const LAS int* texp;
    __device__ bool next(int i, Unit& u) const {
        const int nwg = ntile * nN; const long L = (long)i * G + c; if (L >= nwg) return false;
        int wgid = (int)L; { const int q = nwg / NXCD, r = nwg % NXCD, xcd = wgid % NXCD, off = wgid / NXCD; wgid = (xcd < r ? xcd * (q + 1) : r * (q + 1) + (xcd - r) * q) + off; }
        const int nig = WGM * nN, gid = wgid / nig, fm = gid * WGM, gsz = (ntile - fm) < WGM ? (ntile - fm) : WGM;
        const int t = fm + ((wgid % nig) % gsz); u.pn = (wgid % nig) / gsz; u.pm = tile_lo + t; u.pa = t; u.pb = __builtin_amdgcn_readfirstlane(texp[u.pm]) * nN + u.pn; u.ko = 0; return true;
    }
};
struct MoeRemOrder {
    int ntile, G, c; const LAS int* texp;
    __device__ bool next(int i, Unit& u) const {
        const int L = i * G + c; if (L >= ntile * 28) return false;
        const int ks = L % 7, rest = L / 7; u.pn = rest & 3; const int r = rest >> 2; u.pm = r * 7 + ks; u.pa = 256 + r; u.pb = __builtin_amdgcn_readfirstlane(texp[256 + r]) * 4 + u.pn; u.ko = ks * 512; return true;
    }
};

typedef int v8i_t __attribute__((ext_vector_type(8)));
typedef int v4i_t __attribute__((ext_vector_type(4)));
typedef __bf16 bf16x2_t_ __attribute__((ext_vector_type(2)));
__device__ __forceinline__ unsigned cvt_pk_bf16(float lo, float hi) { f32x2 v = {lo, hi}; return __builtin_bit_cast(unsigned, __builtin_convertvector(v, bf16x2_t_)); }

template <class Epi, class Sched, bool GATHER, bool FP8 = false>
__device__ __forceinline__ void gemm_phase(LAS unsigned char* lds, LAS unsigned char* auxb, const Gemm g, const Sched& S, const Epi& E, const int wid) {
    constexpr int NAUX = Epi::NAUX; constexpr int EV = Epi::EPI_VMEM;
    const int lane = lane_now(), tid = wid * 64 + lane, wr = wid >> 2, wc = wid & 3, fr = lane & 15, fq = lane >> 4;
    const int KB = FP8 ? g.ld : g.ld * 2; int nt = (FP8 ? g.K : g.K * 2) / 128; asm volatile("" : "+s"(nt));
    unsigned voffB[2]; int Rr[2], Cc[2];
#pragma unroll
    for (int i = 0; i < 2; ++i) { int R, C; stage_rc(tid * 16 + i * 8192, R, C); const int Rb = Epi::PERM ? ((R & ~31) + perm32(R & 31)) : R;
        Rr[i] = R; Cc[i] = C; voffB[i] = (unsigned)(Rb * KB + C * 2); }
    const size_t kstep = (size_t)(BK * 2);
    const size_t hstep = (size_t)HALF * KB;
    const size_t tstep = 2 * hstep;
    const unsigned ldsw = (unsigned)wid * 1024u;
    const int aoff = lds_byte(wr * 64 + fr, fq * 8), boff = lds_byte(wc * 32 + fr, fq * 8);
    const int aoff2 = aoff + 1024, boff2 = boff + 1024;
#define PG8_SA(b, h) (((b) * 2 + (h)) * HTB)
#define PG8_SB(b, h) ((4 + (b) * 2 + (h)) * HTB)
#define PG8_STAGE(bufoff, gbase, voff) do { const char* _gb = (const char*)(gbase); asm volatile("" : "+s"(_gb));     \
        _Pragma("unroll") for (int _i = 0; _i < 2; ++_i) { asm volatile("" : "+v"((voff)[_i])); \
        __builtin_amdgcn_global_load_lds((const unsigned*)(_gb + (voff)[_i]), (LAS unsigned*)(lds + (bufoff) + ldsw + _i * 8192), 16, 0, 0); } } while (0)
#define PG8_LD8(p0, p1) __builtin_shufflevector(*(const LAS v4i_t*)(p0), *(const LAS v4i_t*)(p1), 0, 1, 2, 3, 4, 5, 6, 7)
#define PG8_LDA(dst, b, h) do { if constexpr (FP8) { _Pragma("unroll") for (int m = 0; m < 4; ++m) dst##8[m] = PG8_LD8(lds + PG8_SA(b, h) + aoff + m * 2048, lds + PG8_SA(b, h) + aoff2 + m * 2048); } \
        else { _Pragma("unroll") for (int m = 0; m < 4; ++m) _Pragma("unroll") for (int k = 0; k < 2; ++k) dst[m][k] = *(const LAS bf16x8*)(lds + PG8_SA(b, h) + aoff + k * 1024 + m * 2048); } } while (0)
#define PG8_LDB(dst, b, h) do { if constexpr (FP8) { _Pragma("unroll") for (int n = 0; n < 2; ++n) dst##8[n] = PG8_LD8(lds + PG8_SB(b, h) + boff + n * 2048, lds + PG8_SB(b, h) + boff2 + n * 2048); } \
        else { _Pragma("unroll") for (int n = 0; n < 2; ++n) _Pragma("unroll") for (int k = 0; k < 2; ++k) dst[n][k] = *(const LAS bf16x8*)(lds + PG8_SB(b, h) + boff + k * 1024 + n * 2048); } } while (0)
#define PG8_MMA(ai, bj, At, Bt) do { __builtin_amdgcn_s_setprio(1); _Pragma("unroll") for (int m = 0; m < 4; ++m) _Pragma("unroll") for (int n = 0; n < 2; ++n) { \
        if constexpr (FP8) asm volatile("v_mfma_scale_f32_16x16x128_f8f6f4 %0, %1, %2, %0, %3, %3 op_sel_hi:[0,0,0]" : "+v"(acc[ai][bj][m][n]) : "v"(Bt##8[n]), "v"(At##8[m]), "v"(sc1)); \
        else { _Pragma("unroll") for (int k = 0; k < 2; ++k) acc[ai][bj][m][n] = __builtin_amdgcn_mfma_f32_16x16x32_bf16(Bt[n][k], At[m][k], acc[ai][bj][m][n], 0, 0, 0); } } __builtin_amdgcn_s_setprio(0); } while (0)
#define PG8_MMA0(ai, bj, At, Bt) do { __builtin_amdgcn_s_setprio(1); _Pragma("unroll") for (int m = 0; m < 4; ++m) _Pragma("unroll") for (int n = 0; n < 2; ++n) { \
        if constexpr (FP8) asm volatile("v_mfma_scale_f32_16x16x128_f8f6f4 %0, %1, %2, 0, %3, %3 op_sel_hi:[0,0,0]" : "=&v"(acc[ai][bj][m][n]) : "v"(Bt##8[n]), "v"(At##8[m]), "v"(sc1)); \
        else { acc[ai][bj][m][n] = __builtin_amdgcn_mfma_f32_16x16x32_bf16(Bt[n][0], At[m][0], (f32x4){0.f, 0.f, 0.f, 0.f}, 0, 0, 0); acc[ai][bj][m][n] = __builtin_amdgcn_mfma_f32_16x16x32_bf16(Bt[n][1], At[m][1], acc[ai][bj][m][n], 0, 0, 0); } } __builtin_amdgcn_s_setprio(0); } while (0)
#define PG8_WAIT_V(n) asm volatile("s_waitcnt vmcnt(" #n ")" ::: "memory")
#define PG8_WAIT_L(n) asm volatile("s_waitcnt lgkmcnt(" #n ")" ::: "memory")
#define PG8_BAR __builtin_amdgcn_s_barrier()
#define PG8_SCHED __builtin_amdgcn_sched_barrier(0)
#define PG8_VAH(dst, _h, par) do { _Pragma("unroll") for (int _i = 0; _i < 2; ++_i) { \
        if constexpr (GATHER) { const int _ix = ((const LAS int*)(auxb + (size_t)(par) * NAUX * 1024))[(_h) * HALF + Rr[_i]]; dst[_i] = (unsigned)_ix * (unsigned)KB + (unsigned)(Cc[_i] * 2); } \
        else dst[_i] = (unsigned)(((_h) * HALF + Rr[_i]) * KB + Cc[_i] * 2); } } while (0)
#define PG8_AUX(un, par) do { if constexpr (NAUX > 0) { const unsigned* _src = (const unsigned*)((const char*)E.aux_src(un) + lane * 16); LAS unsigned* _dst = (LAS unsigned*)(auxb + (size_t)((par) * NAUX) * 1024); \
        _Pragma("unroll") for (int _p = 0; _p < NAUX; ++_p) { __builtin_amdgcn_global_load_lds(_src, _dst, 16, 0, 0); _src += 256; _dst += 256; asm volatile("" : "+v"(_src)); } } } while (0)
    Unit cur, nxt, prv; int ui = 0;
    if (!S.next(0, cur)) return;
#ifdef GEMM_SKEW_TICKS
    {
        const unsigned long long t0s = __builtin_amdgcn_s_memrealtime(); const unsigned long long dly = (unsigned long long)((blockIdx.x >> 3) & 7) * GEMM_SKEW_TICKS;
        while (__builtin_amdgcn_s_memrealtime() - t0s < dly) __builtin_amdgcn_s_sleep(8); }
#endif
    prv = cur;
    f32x4 acc[2][2][4][2];
    bf16x8 At[4][2], B0[2][2], B1[2][2];
    v8i_t At8[4], B08[2], B18[2]; const int sc1 = 0x7f7f7f7f;
    unsigned vAc[2][2];
    if constexpr (NAUX > 0) { if (wid == 0) PG8_AUX(cur, 0); if constexpr (GATHER) { PG8_WAIT_V(0); PG8_BAR; } }
    PG8_VAH(vAc[0], 0, 0); PG8_VAH(vAc[1], 1, 0);
    const char* cA = GATHER ? (const char*)g.A + cur.ko : (const char*)g.A + (size_t)cur.pa * tstep + cur.ko; const char* cB = (const char*)g.Bt + (size_t)cur.pb * tstep + cur.ko;
    PG8_STAGE(PG8_SB(0, 0), cB, voffB); PG8_STAGE(PG8_SB(0, 1), cB + hstep, voffB); PG8_STAGE(PG8_SA(0, 0), cA, vAc[0]); PG8_STAGE(PG8_SA(0, 1), cA, vAc[1]);
    PG8_STAGE(PG8_SB(1, 0), cB + kstep, voffB); PG8_STAGE(PG8_SA(1, 0), cA + kstep, vAc[0]); PG8_STAGE(PG8_SB(1, 1), cB + hstep + kstep, voffB);
    if (wr == 1) PG8_BAR;
    PG8_WAIT_V(6); PG8_BAR;
    if constexpr (EV > 0) PG8_WAIT_V(0);
    PG8_BAR;
    for (;;) {
        const bool has_next = S.next(ui + 1, nxt);
        const char* nA = has_next ? (GATHER ? (const char*)g.A + nxt.ko : (const char*)g.A + (size_t)nxt.pa * tstep + nxt.ko) : cA; const char* nB = has_next ? (const char*)g.Bt + (size_t)nxt.pb * tstep + nxt.ko : cB;
#define PG8_KSTEP(MMX, AUXNOW, LASTX, W1, W2, W3) do { \
            const bool last = (LASTX); \
            if constexpr (NAUX > 0) { if ((AUXNOW) && has_next && wid == 4) PG8_AUX(nxt, (ui + 1) & 1); } \
            if (last && has_next) { PG8_VAH(vAc[0], 0, (ui + 1) & 1); } \
            const char* a1 = cA + (size_t)(t + 1) * kstep; \
            const char* a2 = last ? nA : cA + (size_t)(t + 2) * kstep; const char* b2 = last ? nB : cB + (size_t)(t + 2) * kstep; \
            const char* a3 = a2 + kstep; const char* b3 = b2 + kstep; \
            PG8_LDB(B0, 0, 0); PG8_LDB(B1, 0, 1); PG8_SCHED; PG8_LDA(At, 0, 0); PG8_STAGE(PG8_SA(1, 1), a1, vAc[1]); \
            if (last && has_next) { PG8_VAH(vAc[1], 1, (ui + 1) & 1); } \
            W1; PG8_WAIT_L(0); PG8_BAR; MMX(0, 0, At, B0); MMX(0, 1, At, B1); PG8_BAR; PG8_SCHED; \
            PG8_LDA(At, 0, 1); PG8_STAGE(PG8_SB(0, 0), b2, voffB); PG8_STAGE(PG8_SB(0, 1), b2 + hstep, voffB); PG8_STAGE(PG8_SA(0, 0), a2, vAc[0]); \
            W2; PG8_WAIT_L(0); PG8_BAR; MMX(1, 0, At, B0); MMX(1, 1, At, B1); PG8_BAR; PG8_SCHED; \
            PG8_LDB(B0, 1, 0); PG8_LDB(B1, 1, 1); PG8_SCHED; PG8_LDA(At, 1, 0); PG8_STAGE(PG8_SA(0, 1), a2, vAc[1]); \
            W3; PG8_WAIT_L(0); PG8_BAR; PG8_MMA(0, 0, At, B0); PG8_MMA(0, 1, At, B1); PG8_BAR; PG8_SCHED; \
            PG8_LDA(At, 1, 1); PG8_STAGE(PG8_SB(1, 0), b3, voffB); PG8_STAGE(PG8_SB(1, 1), b3 + hstep, voffB); PG8_STAGE(PG8_SA(1, 0), a3, vAc[0]); \
            PG8_WAIT_V(8); PG8_WAIT_L(0); PG8_BAR; PG8_MMA(1, 0, At, B0); PG8_MMA(1, 1, At, B1); PG8_BAR; PG8_SCHED; } while (0)
#define PG8_WSEAM(n) do { if constexpr (EV > 0) asm volatile("s_waitcnt vmcnt(%0)" :: "n"((n) + EV) : "memory"); else PG8_WAIT_V(8); } while (0)
        { const int t = 0; PG8_KSTEP(PG8_MMA0, false, false, PG8_WSEAM(8), PG8_WSEAM(8), PG8_WSEAM(10)); }
#pragma clang loop unroll(disable)
        for (int t = 2; t < nt; t += 2) PG8_KSTEP(PG8_MMA, t == 2, t == nt - 2, PG8_WAIT_V(8), PG8_WAIT_V(8), PG8_WAIT_V(8));
        if constexpr (FP8) asm volatile("s_nop 15\n\ts_nop 7" ::: "memory");
        if (wr == 0) PG8_BAR;
        E(acc, cur, wr, wc, fr, fq, (const LAS unsigned char*)(auxb + (size_t)(ui & 1) * NAUX * 1024), ui, prv);
        if (!has_next) break;
        prv = cur; cur = nxt; cA = nA; cB = nB; ++ui;
        if (wr == 1) PG8_BAR;
    }
    PG8_WAIT_V(0); PG8_WAIT_L(0);
    PG8_BAR;
    E.finish(cur, ui);
#undef PG8_SA
#undef PG8_SB
#undef PG8_STAGE
#undef PG8_LDA
#undef PG8_LDB
#undef PG8_MMA
#undef PG8_MMA0
#undef PG8_KSTEP
#undef PG8_WSEAM
#undef PG8_WAIT_V
#undef PG8_WAIT_L
#undef PG8_BAR
#undef PG8_SCHED
#undef PG8_VAH
#undef PG8_AUX
}
}
namespace pg8 {
__device__ __forceinline__ float sigmoid_fast(float x) { return __builtin_amdgcn_rcpf(1.0f + __builtin_amdgcn_exp2f(-LOG2E * x)); }
template <int NP> __device__ __forceinline__ float row_rs(const LAS unsigned char* aux, int rl) {
    const LAS float* ax = (const LAS float*)aux; float ss = ax[rl];
#pragma unroll
    for (int p = 1; p < NP; ++p) ss += ax[p * 256 + rl];
    return rsqrtf(ss * (1.0f / DM) + EPS);
}
__device__ __forceinline__ unsigned pk4_fp8(float a, float b, float c, float d) { int v = __builtin_amdgcn_cvt_pk_fp8_f32(a, b, 0, false); v = __builtin_amdgcn_cvt_pk_fp8_f32(c, d, v, true); return (unsigned)v; }
__device__ __forceinline__ u32x2 pack8_fp8(const f32x4 a, const f32x4 b) { return (u32x2){pk4_fp8(a[0], a[1], a[2], a[3]), pk4_fp8(b[0], b[1], b[2], b[3])}; }
__device__ __forceinline__ u32x4 pack8(const f32x4 a, const f32x4 b) { u32x4 w; w.x = cvt_pk_bf16(a[0], a[1]); w.y = cvt_pk_bf16(a[2], a[3]); w.z = cvt_pk_bf16(b[0], b[1]); w.w = cvt_pk_bf16(b[2], b[3]); return w; }

struct EpiProj {
    static constexpr bool PERM = true; static constexpr int EPI_VMEM = 0; static constexpr int NAUX = 1;
    bf16_t* Q; bf16_t* Kk; bf16_t* Kt; bf16_t* Vt; bf16_t* OG; const float* ss0; LAS bf16_t* tlsb;
    __device__ __forceinline__ const void* aux_src(const Unit& u) const { return ss0 + (size_t)u.pm * 256; }
    __device__ __forceinline__ void operator()(const f32x4 (&acc)[2][2][4][2], const Unit& u, int wr, int wc, int fr, int fq, const LAS unsigned char* aux, int, const Unit&) const {
        asm volatile("" : "+v"(fr), "+v"(fq));
        const int pn = u.pn;
        if (pn < 4 || pn >= 8) {
            bf16_t* base; int ldc, colt; bool sig = false;
            if (pn < 2) { base = Q; ldc = 512; colt = pn * 256; } else if (pn < 4) { base = Kk; ldc = 512; colt = (pn - 2) * 256; } else { base = OG; ldc = 1024; colt = (pn - 8) * 256; sig = true; }
#pragma unroll
            for (int ai = 0; ai < 2; ++ai)
#pragma unroll
                for (int m = 0; m < 4; ++m) { const int rl = ai * HALF + wr * 64 + m * 16 + fr; const float rs = row_rs<1>(aux, rl);
                    bf16_t* rowp = base + (size_t)(u.pm * BM + rl) * ldc + colt + wc * 32 + 8 * fq;
#pragma unroll
                    for (int bj = 0; bj < 2; ++bj) { f32x4 v0 = acc[ai][bj][m][0] * rs, v1 = acc[ai][bj][m][1] * rs;
                        if (sig) {
#pragma unroll
                            for (int j = 0; j < 4; ++j) { v0[j] = sigmoid_fast(v0[j]); v1[j] = sigmoid_fast(v1[j]); } }
                        if (pn < 4) { const int row = u.pm * BM + rl, b = row >> 12, t = row & 4095, col = colt + bj * HALF + wc * 32 + 8 * fq, hd = col >> 6, dk0 = col & 63;
                            *(GAS u32x4*)(base + ((((size_t)((b * MH + hd) * 64 + (t >> 6)) * 4 + ((t >> 4) & 3)) * 2 + (dk0 >> 5)) * 64 + (t & 15) + 16 * ((dk0 >> 3) & 3)) * 8) = pack8(v0, v1); }
                        else *(GAS u32x4*)(rowp + bj * HALF) = pack8(v0, v1); }
                    asm volatile("" ::: "memory"); }
        }
        if (pn >= 2 && pn < 8) {
            const bool isk = pn < 4; const int colt = isk ? (pn - 2) * 256 : (pn - 4) * 256; bf16_t* tb = isk ? Kt : Vt; const int hshift = isk ? 6 : 7;
            const int lane64 = fr + 16 * fq; LAS bf16_t* tls = tlsb + (wr * 4 + wc) * 512;
#pragma unroll
            for (int ai = 0; ai < 2; ++ai)
#pragma unroll
                for (int m = 0; m < 4; ++m) { const int rl = ai * HALF + wr * 64 + m * 16 + fr; const float rs = row_rs<1>(aux, rl);
#pragma unroll
                    for (int bj = 0; bj < 2; ++bj) {
#pragma unroll
                        for (int n = 0; n < 2; ++n)
#pragma unroll
                            for (int j = 0; j < 4; ++j) tls[(8 * fq + 4 * n + j) * 16 + fr] = (bf16_t)(cvt_pk_bf16(acc[ai][bj][m][n][j] * rs, 0.f) & 0xffffu);
                        asm volatile("s_waitcnt lgkmcnt(0)" ::: "memory");
                        const int c32 = lane64 >> 1, hf = lane64 & 1; const u32x4 tv = *(const LAS u32x4*)(tls + c32 * 16 + 8 * hf);
                        asm volatile("s_waitcnt lgkmcnt(0)" ::: "memory");
                        const int tb0 = (u.pm * BM + ai * HALF + wr * 64 + m * 16 + 8 * hf) & 4095, bb = (u.pm * BM) >> 12;
                        const int col = colt + bj * HALF + wc * 32 + c32, hd = col >> hshift, cc = col & ((1 << hshift) - 1);
                        const size_t fi = isk ? ((((size_t)((bb * MH + hd) * 64 + (tb0 >> 6)) * 4 + (cc >> 4)) * 2 + ((tb0 >> 5) & 1)) * 64 + (cc & 15) + 16 * ((tb0 >> 3) & 3))
                                              : ((((size_t)((bb * MH + hd) * 64 + (tb0 >> 6)) * 8 + (cc >> 4)) * 2 + ((tb0 >> 5) & 1)) * 64 + (cc & 15) + 16 * ((tb0 >> 3) & 3));
                        *(GAS u32x4*)(tb + fi * 8) = tv; }
                    asm volatile("" ::: "memory"); }
        }
    }
    __device__ __forceinline__ void finish(const Unit&, int) const {}
};

struct EpiRes {
    static constexpr bool PERM = true; static constexpr int EPI_VMEM = 0; static constexpr int NAUX = 0;
    bf16_t* xb; float* out; float* ssp; LAS float* red; unsigned char* xq; int wv;
    __device__ __forceinline__ const void* aux_src(const Unit&) const { return nullptr; }
    __device__ __forceinline__ void flush(const Unit& p, int par) const {
        if (wv < 4) { const LAS float* r = red + par * 1024; const int row = wv * 64 + lane_now(); ssp[((size_t)p.pm * 4 + p.pn) * 256 + row] = (r[row] + r[256 + row]) + (r[512 + row] + r[768 + row]); } }
    __device__ __forceinline__ void operator()(const f32x4 (&acc)[2][2][4][2], const Unit& u, int wr, int wc, int fr, int fq, const LAS unsigned char*, int ui, const Unit& prv) const {
        asm volatile("" : "+v"(fr), "+v"(fq));
        if (ssp && ui > 0) flush(prv, (ui - 1) & 1);
#pragma unroll
        for (int ai = 0; ai < 2; ++ai)
#pragma unroll
            for (int m = 0; m < 4; ++m) { const int rl = ai * HALF + wr * 64 + m * 16 + fr; const size_t off = (size_t)(u.pm * BM + rl) * DM + u.pn * BM + wc * 32 + 8 * fq; float ss = 0.f;
#pragma unroll
                for (int bj = 0; bj < 2; ++bj) { const u32x4 bv = *(const GAS u32x4*)(xb + off + bj * HALF);
                    f32x4 v0, v1;
                    v0[0] = __builtin_bit_cast(float, bv[0] << 16); v0[1] = __builtin_bit_cast(float, bv[0] & 0xffff0000u); v0[2] = __builtin_bit_cast(float, bv[1] << 16); v0[3] = __builtin_bit_cast(float, bv[1] & 0xffff0000u);
                    v1[0] = __builtin_bit_cast(float, bv[2] << 16); v1[1] = __builtin_bit_cast(float, bv[2] & 0xffff0000u); v1[2] = __builtin_bit_cast(float, bv[3] << 16); v1[3] = __builtin_bit_cast(float, bv[3] & 0xffff0000u);
                    v0 = v0 + acc[ai][bj][m][0]; v1 = v1 + acc[ai][bj][m][1];
                    *(GAS u32x4*)(xb + off + bj * HALF) = pack8(v0, v1);
                    if (out) { *(GAS f32x4*)(out + off + bj * HALF) = v0; *(GAS f32x4*)(out + off + bj * HALF + 4) = v1; }
                    if (xq) *(GAS u32x2*)(xq + off + bj * HALF) = pack8_fp8(v0, v1);
                    ss += (v0[0] * v0[0] + v0[1] * v0[1]) + (v0[2] * v0[2] + v0[3] * v0[3]) + (v1[0] * v1[0] + v1[1] * v1[1]) + (v1[2] * v1[2] + v1[3] * v1[3]); }
                if (ssp) { ss = sum_xor16(ss); ss = sum_xor32(ss); if (fq == 0) red[(ui & 1) * 1024 + wc * 256 + rl] = ss; }
                asm volatile("" ::: "memory"); }
    }
    __device__ __forceinline__ void finish(const Unit& last, int ui) const { if (ssp) flush(last, ui & 1); }
};

constexpr float MOE_WSCALE = 32.0f, MOE_HSCALE = 8.0f;
template <bool MOE> struct EpiGu {
    static constexpr bool PERM = true; static constexpr int EPI_VMEM = 8;     static constexpr int NAUX = MOE ? 3 : 4;
    void* H; int ldh; const float* ssp;
    __device__ __forceinline__ const void* aux_src(const Unit& u) const { return ssp + (size_t)u.pm * 1024; }
    __device__ __forceinline__ void operator()(const f32x4 (&acc)[2][2][4][2], const Unit& u, int wr, int wc, int fr, int fq, const LAS unsigned char* aux, int, const Unit&) const {
        asm volatile("" : "+v"(fr), "+v"(fq));
        float rsv[2][4], wv[2][4];
#pragma unroll
        for (int ai = 0; ai < 2; ++ai)
#pragma unroll
            for (int m = 0; m < 4; ++m) { const int rl = ai * HALF + wr * 64 + m * 16 + fr;
                if constexpr (MOE) { rsv[ai][m] = ((const LAS float*)(aux + 1024))[rl] * (1.0f / MOE_WSCALE); wv[ai][m] = ((const LAS float*)(aux + 2048))[rl] * MOE_HSCALE; } else { rsv[ai][m] = row_rs<4>(aux, rl); wv[ai][m] = 1.f; } }
#pragma unroll
        for (int ai = 0; ai < 2; ++ai)
#pragma unroll
            for (int m = 0; m < 4; ++m) { const int rl = ai * HALF + wr * 64 + m * 16 + fr; const float rs = rsv[ai][m], w = wv[ai][m];
                GAS unsigned char* Hg = (GAS unsigned char*)H + ((size_t)(u.pa * BM + ai * HALF + wr * 64 + m * 16) * ldh + u.pn * HALF + wc * 32) * (MOE ? 1 : 2);
                unsigned vo = (unsigned)(fr * ldh + 8 * fq) * (MOE ? 1u : 2u); asm volatile("" : "+v"(vo));
                const float k120 = (-LOG2E * (1.0f / 120.0f)) * rs, crow = rs * rs * w; const f32x2 kk = (f32x2){k120, k120}, hh = (f32x2){0.5f, 0.5f};
                f32x4 h[2];
#pragma unroll
                for (int n = 0; n < 2; ++n) { const f32x4 G = acc[ai][0][m][n], U = acc[ai][1][m][n];
                    const f32x2 ga = (f32x2){G[0], G[1]}, gb = (f32x2){G[2], G[3]}, ua = (f32x2){U[0], U[1]}, ub = (f32x2){U[2], U[3]};
                    f32x2 ta, tb;
                    asm("v_pk_fma_f32 %0, %1, %2, %3 clamp" : "=v"(ta) : "v"(ga), "v"(kk), "v"(hh));
                    asm("v_pk_fma_f32 %0, %1, %2, %3 clamp" : "=v"(tb) : "v"(gb), "v"(kk), "v"(hh));
                    ta = ta * 120.0f - 60.0f; tb = tb * 120.0f - 60.0f;
                    f32x2 da, db; da.x = __builtin_amdgcn_exp2f(ta.x); da.y = __builtin_amdgcn_exp2f(ta.y); db.x = __builtin_amdgcn_exp2f(tb.x); db.y = __builtin_amdgcn_exp2f(tb.y);
                    da = da + 1.0f; db = db + 1.0f;
                    const f32x2 pab = da * db; const float r = __builtin_amdgcn_rcpf(pab.x * pab.y) * crow;
                    const f32x2 rr = (f32x2){pab.y, pab.x} * r;
                    const f32x2 ha = (ga * ua) * (rr * db), hb = (gb * ub) * (rr * da);
                    h[n] = (f32x4){ha.x, ha.y, hb.x, hb.y}; }
                if constexpr (MOE) *(GAS u32x2*)(Hg + vo) = pack8_fp8(h[0], h[1]); else *(GAS u32x4*)(Hg + vo) = pack8(h[0], h[1]);
                asm volatile("" ::: "memory"); }
    }
    __device__ __forceinline__ void finish(const Unit&, int) const {}
};

struct EpiKvq {
    static constexpr bool PERM = true; static constexpr int EPI_VMEM = 0; static constexpr int NAUX = 4;
    bf16_t* Kb; bf16_t* Vt; bf16_t* Qb; const float* ssp; const LAS float* gk; LAS bf16_t* tlsb;
    __device__ __forceinline__ const void* aux_src(const Unit& u) const { return ssp + (size_t)u.pm * 1024; }
    __device__ __forceinline__ void operator()(const f32x4 (&acc)[2][2][4][2], const Unit& u, int wr, int wc, int fr, int fq, const LAS unsigned char* aux, int, const Unit&) const {
        asm volatile("" : "+v"(fr), "+v"(fq));
        const int kind = u.pn >> 2, hd = (u.pn & 3) * 4 + wc;
#pragma unroll
        for (int ai = 0; ai < 2; ++ai)
#pragma unroll
            for (int m = 0; m < 4; ++m) { const int rl = ai * HALF + wr * 64 + m * 16 + fr; const float rs = row_rs<4>(aux, rl); const int row = u.pm * BM + rl;
                f32x4 y[2][2]; float ssq = 0.f;
#pragma unroll
                for (int bj = 0; bj < 2; ++bj)
#pragma unroll
                    for (int n = 0; n < 2; ++n) { y[bj][n] = acc[ai][bj][m][n] * rs; const f32x4 t = y[bj][n]; ssq += (t[0] * t[0] + t[1] * t[1]) + (t[2] * t[2] + t[3] * t[3]); }
                const int b = row >> 12, t = row & 4095, bh = b * 16 + hd, blk = t >> 5, tl = t & 31;
                if (kind != 1) {
                    ssq = sum_xor16(ssq); ssq = sum_xor32(ssq);
                    const float rinv = rsqrtf(ssq * (1.0f / 64.0f) + EPS) * (kind == 2 ? LOG2E * 0.125f : 1.0f);
                    const LAS float* g = gk + (kind == 2 ? 64 : 0);
                    const int r = kind == 2 ? tl : ((tl & 19) | ((tl & 4) << 1) | ((tl & 8) >> 1));
                    bf16_t* dst = (kind == 2 ? Qb : Kb) + ((size_t)(bh * 128 + blk) * 4 * 64 + r) * 8;
#pragma unroll
                    for (int bj = 0; bj < 2; ++bj) { const int pos0 = 32 * bj + 8 * fq; const f32x4 g0 = *(const LAS f32x4*)(g + pos0), g1 = *(const LAS f32x4*)(g + pos0 + 4);
                        *(GAS u32x4*)(dst + ((size_t)(pos0 >> 4) * 64 + 32 * ((pos0 >> 3) & 1)) * 8) = pack8(y[bj][0] * rinv * g0, y[bj][1] * rinv * g1); }
                } else {
                    const int lane64 = fr + 16 * fq; LAS bf16_t* tls = tlsb + (wr * 4 + wc) * 512;
#pragma unroll
                    for (int bj = 0; bj < 2; ++bj) {
#pragma unroll
                        for (int n = 0; n < 2; ++n)
#pragma unroll
                            for (int j = 0; j < 4; ++j) tls[(8 * fq + 4 * n + j) * 16 + fr] = (bf16_t)(cvt_pk_bf16(y[bj][n][j], 0.f) & 0xffffu);
                        asm volatile("s_waitcnt lgkmcnt(0)" ::: "memory");
                        const int c32 = lane64 >> 1, hf = lane64 & 1; const u32x4 tv = *(const LAS u32x4*)(tls + c32 * 16 + 8 * hf);
                        asm volatile("s_waitcnt lgkmcnt(0)" ::: "memory");
                        const int tb0 = (u.pm * BM + ai * HALF + wr * 64 + m * 16 + 8 * hf) & 4095, tl0 = tb0 & 31, pos = 32 * bj + c32;
                        *(GAS u32x4*)(Vt + (((((size_t)(bh * 128 + (tb0 >> 5)) * 2 + (pos >> 5)) * 2 + ((tl0 >> 4) & 1)) * 64 + (pos & 31) + 32 * ((tl0 >> 3) & 1)) * 8)) = tv; }
                }
                asm volatile("" ::: "memory"); }
    }
    __device__ __forceinline__ void finish(const Unit&, int) const {}
};

constexpr float MOE_YSCALE = 16.0f;
struct EpiMoeDn {
    static constexpr bool PERM = true; static constexpr int EPI_VMEM = 0; static constexpr int NAUX = 1;
    unsigned char* Y; const int* slot;
    __device__ __forceinline__ const void* aux_src(const Unit& u) const { return slot + (size_t)u.pm * 1024 + 768; }
    __device__ __forceinline__ void operator()(const f32x4 (&acc)[2][2][4][2], const Unit& u, int wr, int wc, int fr, int fq, const LAS unsigned char* aux, int, const Unit&) const {
        asm volatile("" : "+v"(fr), "+v"(fq));
        constexpr float sc = MOE_YSCALE / (MOE_WSCALE * MOE_HSCALE);
#pragma unroll
        for (int ai = 0; ai < 2; ++ai)
#pragma unroll
            for (int m = 0; m < 4; ++m) { const int rl = ai * HALF + wr * 64 + m * 16 + fr; const int yr = ((const LAS int*)aux)[rl];
                if (yr >= 0) { unsigned char* rowp = Y + (size_t)yr * DM + u.pn * BM + wc * 32 + 8 * fq;
#pragma unroll
                    for (int bj = 0; bj < 2; ++bj) *(GAS u32x2*)(rowp + bj * HALF) = pack8_fp8(acc[ai][bj][m][0] * sc, acc[ai][bj][m][1] * sc); }
                asm volatile("" ::: "memory"); }
    }
    __device__ __forceinline__ void finish(const Unit&, int) const {}
};
struct EpiMoeDnPart {
    static constexpr bool PERM = true; static constexpr int EPI_VMEM = 0; static constexpr int NAUX = 0;
    bf16_t* YP;
    __device__ __forceinline__ const void* aux_src(const Unit&) const { return nullptr; }
    __device__ __forceinline__ void operator()(const f32x4 (&acc)[2][2][4][2], const Unit& u, int wr, int wc, int fr, int fq, const LAS unsigned char*, int, const Unit&) const {
        asm volatile("" : "+v"(fr), "+v"(fq));
#pragma unroll
        for (int ai = 0; ai < 2; ++ai)
#pragma unroll
            for (int m = 0; m < 4; ++m) { const int rl = ai * HALF + wr * 64 + m * 16 + fr; bf16_t* rowp = YP + (size_t)(u.pm * BM + rl) * DM + u.pn * BM + wc * 32 + 8 * fq;
#pragma unroll
                for (int bj = 0; bj < 2; ++bj) *(GAS u32x4*)(rowp + bj * HALF) = pack8(acc[ai][bj][m][0] * (1.0f / (MOE_WSCALE * MOE_HSCALE)), acc[ai][bj][m][1] * (1.0f / (MOE_WSCALE * MOE_HSCALE)));
                asm volatile("" ::: "memory"); }
    }
    __device__ __forceinline__ void finish(const Unit&, int) const {}
};
}
constexpr size_t MiB = 1u << 20;
constexpr size_t WS_CTL = 0, CTL_ZERO_BYTES = 64 * 1024;
constexpr size_t WS_WIN = 1 * MiB, WS_WOUT = 7 * MiB, WS_WGU = 9 * MiB, WS_WD = 20 * MiB, WS_WKVQ = 26 * MiB, WS_WO = 32 * MiB, WS_WMGU = 34 * MiB, WS_WMD = 90 * MiB;
constexpr size_t WS_TAB = 118 * MiB;
constexpr size_t T_SS0 = WS_TAB, T_SSP = WS_TAB + 128 * 1024, T_GATES = WS_TAB + 1 * MiB, T_SELE = WS_TAB + 3 * MiB, T_SELW1 = T_SELE + 128 * 1024, T_SELW2 = T_SELE + 256 * 1024, T_SELRS = T_SELE + 384 * 1024;
constexpr size_t T_SLOTOF = WS_TAB + 5 * MiB + 256 * 1024;
constexpr size_t T_SLOT = WS_TAB + 4 * MiB;
constexpr size_t WS_A = 124 * MiB;
constexpr size_t WS_B = 188 * MiB;
constexpr size_t B_Q = WS_B, B_K = WS_B + 32 * MiB, B_VT = WS_B + 64 * MiB, B_OG = WS_B + 128 * MiB, B_HN = WS_B + 192 * MiB;
constexpr size_t B_HF = WS_B;
constexpr size_t B_SBK = WS_B, B_SBVT = WS_B + 64 * MiB, B_SBQ = WS_B + 128 * MiB, B_SBO = WS_B + 192 * MiB;
constexpr size_t WS_Y = 1 * MiB;
constexpr size_t B_YP = WS_B + 264 * MiB;
constexpr size_t B_X3Q = WS_B, B_HM = WS_B + 32 * MiB;
constexpr size_t WS_END = 528 * MiB;
static_assert(WS_Y + (size_t)2 * MTOK * DM <= WS_WMD && B_YP + (size_t)56 * 256 * DM * 2 <= WS_END && (size_t)MAXTILES * 4096 <= MiB + 256 * 1024 && B_HM + (size_t)MAXTILES * 256 * EDIM <= WS_END && B_HN + (size_t)MTOK * DM * 2 <= WS_END, "d_ws map");
constexpr int CW_TMO = 0, CW_BAR = 4096, CW_CNT = 8192, CW_MOE = 12288, CW_TEXP = CW_MOE + 64;
constexpr int RING_OFF = 0, RING_BYTES = 131072;
constexpr int AUX_OFF = RING_BYTES, AUX_BYTES = 8192;
constexpr int RED_OFF = AUX_OFF + AUX_BYTES, RED_BYTES = 8192;
constexpr int TEX_OFF = RED_OFF + RED_BYTES, TEX_BYTES = 2048;
constexpr int MISC_OFF = TEX_OFF + TEX_BYTES;
constexpr int LDS_BYTES = MISC_OFF + 128;
static_assert(LDS_BYTES <= 160 * 1024 && LDS_BYTES > 80 * 1024, "LDS map: one workgroup per CU");

#define XB_TMO      128
#define XB_XCNT(j)  (256  + 64 * (j))
#define XB_XSUB(j)  (1280 + 64 * (j))
#define XB_XGEN(j)  (2304 + 64 * (j))
#define XB_TOP      3328
#define XB_TOPGEN   3392
#define XCD_BAR_WORDS 3456
#define XB_SPIN_CAP (1u << 18)
__device__ __forceinline__ unsigned xb_ld(unsigned* p)              { return __hip_atomic_load(p, __ATOMIC_RELAXED, __HIP_MEMORY_SCOPE_AGENT); }
__device__ __forceinline__ unsigned xb_add(unsigned* p, unsigned v) { return __hip_atomic_fetch_add(p, v, __ATOMIC_RELAXED, __HIP_MEMORY_SCOPE_AGENT); }
__device__ __forceinline__ unsigned xb_xcc_id() { return (unsigned)__builtin_amdgcn_s_getreg((3 << 11) | 20) & 0xFu; }
#define XB_SPIN(cond, bar) do { unsigned _sp = 0; while (cond) { __builtin_amdgcn_s_sleep(1); \
    if ((++_sp & 255u) == 0u) { if (xb_ld(&(bar)[XB_TMO])) break; if (_sp > XB_SPIN_CAP) { atomicAdd(&(bar)[XB_TMO], 1u); break; } } } } while (0)
struct XcdBarrier { unsigned* bar; unsigned x; volatile LAS unsigned* st; };
__device__ __forceinline__ XcdBarrier xcd_barrier_post(unsigned* bar, volatile LAS unsigned* st, bool t0) {
    XcdBarrier b; b.bar = bar; b.x = xb_xcc_id(); b.st = st;
    if (t0) (void)xb_add(&bar[XB_XCNT(b.x)], 1u);
    return b;
}
__device__ __forceinline__ void xcd_barrier_complete(unsigned* bar, unsigned x, unsigned& nloc, unsigned& nx) {
    const unsigned G = gridDim.x * gridDim.y * gridDim.z;
    unsigned sum, cnt, mine, sp = 0u;
    for (;;) {
        sum = 0u; cnt = 0u; mine = 0u;
#pragma unroll
        for (unsigned j = 0; j < 16; ++j) { const unsigned c = xb_ld(&bar[XB_XCNT(j)]); sum += c; cnt += (c > 0u) ? 1u : 0u; mine = (j == x) ? c : mine; }
        if (sum == G) break;
        __builtin_amdgcn_s_sleep(1);
        if ((++sp & 255u) == 0u) { if (xb_ld(&bar[XB_TMO])) break; if (sp > XB_SPIN_CAP) { atomicAdd(&bar[XB_TMO], 1u); break; } }
    }
    nloc = mine > 0u ? mine : 1u; nx = cnt > 0u ? cnt : 1u;
}
__device__ __forceinline__ void xcd_barrier(const XcdBarrier& b, bool t0) {
    asm volatile("s_waitcnt vmcnt(0)" ::: "memory");
    __syncthreads();
    if (t0) {
        unsigned* bar = b.bar;
        __builtin_amdgcn_s_waitcnt(0);
        unsigned nloc = b.st[0], nx = b.st[1];
        if (nloc == 0u) { xcd_barrier_complete(bar, b.x, nloc, nx); b.st[0] = nloc; b.st[1] = nx; }
        const unsigned old = xb_add(&bar[XB_XSUB(b.x)], 1u);
        const unsigned gen = old / nloc;
        if (old + 1u == (gen + 1u) * nloc) {
            __builtin_amdgcn_fence(__ATOMIC_RELEASE, "agent");
            asm volatile("s_waitcnt vmcnt(0)" ::: "memory");
            const unsigned og = xb_add(&bar[XB_TOP], 1u);
            const unsigned tg = og / nx;
            if (og + 1u == (tg + 1u) * nx) xb_add(&bar[XB_TOPGEN], 1u);
            else XB_SPIN(xb_ld(&bar[XB_TOPGEN]) == tg, bar);
            __builtin_amdgcn_fence(__ATOMIC_ACQUIRE, "agent");
            xb_add(&bar[XB_XGEN(b.x)], 1u);
            asm volatile("s_waitcnt vmcnt(0)" ::: "memory");
        } else {
            XB_SPIN(xb_ld(&bar[XB_XGEN(b.x)]) == gen, bar);
            __builtin_amdgcn_fence(__ATOMIC_ACQUIRE, "agent");
            asm volatile("s_waitcnt vmcnt(0)" ::: "memory");
        }
    }
    __syncthreads();
}

struct Args { const float* in[21]; float* out; unsigned char* ws; int ph_lo, ph_hi; };
struct Frame {
    LAS unsigned char* lds;
    volatile LAS unsigned* MISC;
    unsigned* ctl;
    int tid, lane, wave, vcu, G;
    float* out; unsigned char* ws;
};
enum { I_X = 0, I_MIXN, I_FFNN, I_WIN, I_BI, I_BF, I_GH, I_WOUT, I_KVN, I_WKV, I_GK, I_WQ, I_GQ, I_WO, I_FG, I_FU, I_FD, I_WR, I_MG, I_MU, I_MD };
__device__ __forceinline__ unsigned f2bf(float f) { unsigned u = __builtin_bit_cast(unsigned, f); return (u + 0x7fffu + ((u >> 16) & 1u)) >> 16; }
__device__ __forceinline__ unsigned pk2(float lo, float hi) { return f2bf(lo) | (f2bf(hi) << 16); }
__device__ __forceinline__ float bf2f(unsigned short b) { return __builtin_bit_cast(float, (unsigned)b << 16); }
__device__ __forceinline__ float wave_sum(float v) {
#pragma unroll
    for (int o = 1; o < 64; o <<= 1) v += __shfl_xor(v, o);
    return v;
}

struct Job { const float* src; int ldw, col0, ncols, K; const float* gain; float scale; void* dst; int type, roff; int fp8; };
__device__ __forceinline__ int rowmap(int type, int roff, int n) {
    if (type == 0) return roff + n;
    if (type == 1) return 256 * (n >> 7) + (n & 127) + roff;
    return roff + 256 * (n >> 8) + 128 * ((n & 63) >> 5) + 32 * ((n & 255) >> 6) + (n & 31);
}
constexpr int SMALL_ITEMS = 256 + 256 + 1024 + 512 + 1408 * 3 + 512 * 4, MOE_ITEMS = 1792, P0_ITEMS = SMALL_ITEMS + 24 * MOE_ITEMS;
constexpr int P0_NOW_ITEMS = P0_ITEMS;
__device__ __forceinline__ void get_job(const Args& A, Frame& F, int it, Job& jb, int& local) {
    unsigned char* ws = F.ws;
    if (it >= SMALL_ITEMS) { const int r = it - SMALL_ITEMS, j = r / MOE_ITEMS; local = r % MOE_ITEMS; const int kind = j >> 3, e = j & 7;
        if (kind == 0)      jb = Job{A.in[I_MG] + (size_t)e * DM * EDIM, EDIM, 0, EDIM, DM, A.in[I_FFNN] + DM, 32.f, ws + WS_WMGU + (size_t)e * 2 * EDIM * DM, 1, 0, 1};
        else if (kind == 1) jb = Job{A.in[I_MU] + (size_t)e * DM * EDIM, EDIM, 0, EDIM, DM, A.in[I_FFNN] + DM, 32.f, ws + WS_WMGU + (size_t)e * 2 * EDIM * DM, 1, 128, 1};
        else                jb = Job{A.in[I_MD] + (size_t)e * EDIM * DM, DM, 0, DM, EDIM, nullptr, 32.f, ws + WS_WMD + (size_t)e * DM * EDIM, 0, 0, 1};
        return; }
    int r = it;
    if (r < 256)  { local = r; jb = Job{A.in[I_WIN], MPROJ, 0, 512, DM, A.in[I_MIXN], 1.f, (bf16*)(ws + WS_WIN), 0, 0, 0}; return; } r -= 256;
    if (r < 256)  { local = r; jb = Job{A.in[I_WIN], MPROJ, 512, 512, DM, A.in[I_MIXN], 0.125f, (bf16*)(ws + WS_WIN), 0, 512, 0}; return; } r -= 256;
    if (r < 1024) { local = r; jb = Job{A.in[I_WIN], MPROJ, 1024, 2048, DM, A.in[I_MIXN], 1.f, (bf16*)(ws + WS_WIN), 0, 1024, 0}; return; } r -= 1024;
    if (r < 512)  { local = r; jb = Job{A.in[I_WOUT], DM, 0, DM, DM, nullptr, 1.f, (bf16*)(ws + WS_WOUT), 0, 0, 0}; return; } r -= 512;
    if (r < 1408) { local = r; jb = Job{A.in[I_FG], FFN, 0, FFN, DM, A.in[I_FFNN], 1.f, (bf16*)(ws + WS_WGU), 1, 0, 0}; return; } r -= 1408;
    if (r < 1408) { local = r; jb = Job{A.in[I_FU], FFN, 0, FFN, DM, A.in[I_FFNN], 1.f, (bf16*)(ws + WS_WGU), 1, 128, 0}; return; } r -= 1408;
    if (r < 1408) { local = r; jb = Job{A.in[I_FD], DM, 0, DM, FFN, nullptr, 1.f, (bf16*)(ws + WS_WD), 0, 0, 0}; return; } r -= 1408;
    if (r < 512)  { local = r; jb = Job{A.in[I_WKV], 2 * DM, 0, DM, DM, A.in[I_KVN], 1.f, (bf16*)(ws + WS_WKVQ), 2, 0, 0}; return; } r -= 512;
    if (r < 512)  { local = r; jb = Job{A.in[I_WKV], 2 * DM, DM, DM, DM, A.in[I_KVN], 1.f, (bf16*)(ws + WS_WKVQ), 2, 1024, 0}; return; } r -= 512;
    if (r < 512)  { local = r; jb = Job{A.in[I_WQ], DM, 0, DM, DM, A.in[I_MIXN] + DM, 1.f, (bf16*)(ws + WS_WKVQ), 2, 2048, 0}; return; } r -= 512;
    local = r; jb = Job{A.in[I_WO], DM, 0, DM, DM, nullptr, 1.f, (bf16*)(ws + WS_WO), 0, 0, 0};
}
struct P0Regs { f32x4 v[8]; f32x4 g[2]; };
__device__ __forceinline__ void p0_load(const Job& jb, int item, int lane, P0Regs& R) {
    const int nnb = jb.ncols / 32, kb = item / nnb, nb = item % nnb, k0 = 64 * kb, n0 = 32 * nb;
    const float* gp = jb.gain ? jb.gain : jb.src;
    R.g[0] = *(const GAS f32x4*)(gp + k0 + 8 * (lane & 7)); R.g[1] = *(const GAS f32x4*)(gp + k0 + 8 * (lane & 7) + 4);
#pragma unroll
    for (int i = 0; i < 8; ++i) { const int kk = 8 * i + (lane >> 3); R.v[i] = *(const GAS f32x4*)(jb.src + (size_t)(k0 + kk) * jb.ldw + jb.col0 + n0 + 4 * (lane & 7)); }
}
__device__ __forceinline__ void p0_store(const Job& jb, int item, LAS float* scr, int lane, const P0Regs& R) {
    const int nnb = jb.ncols / 32, kb = item / nnb, nb = item % nnb, k0 = 64 * kb, n0 = 32 * nb;
#pragma unroll
    for (int i = 0; i < 8; ++i) { const int kk = 8 * i + (lane >> 3);
        LAS float* d = scr + kk * 33 + 4 * (lane & 7); d[0] = R.v[i][0]; d[1] = R.v[i][1]; d[2] = R.v[i][2]; d[3] = R.v[i][3]; }
    float gs[8];
#pragma unroll
    for (int j = 0; j < 8; ++j) gs[j] = (jb.gain ? R.g[j >> 2][j & 3] : 1.f) * jb.scale;
    LDS_WAIT(); asm volatile("" ::: "memory");
    const int c = lane & 7;
#pragma unroll
    for (int j = 0; j < 4; ++j) { const int n = (lane >> 3) + 8 * j; const LAS float* s = scr + (8 * c) * 33 + n;
        float t[8];
#pragma unroll
        for (int q = 0; q < 8; ++q) t[q] = s[q * 33] * gs[q];
        const size_t eo = (size_t)rowmap(jb.type, jb.roff, n0 + n) * jb.K + k0 + 8 * c;
        if (jb.fp8) { int lo = __builtin_amdgcn_cvt_pk_fp8_f32(t[0], t[1], 0, false); lo = __builtin_amdgcn_cvt_pk_fp8_f32(t[2], t[3], lo, true);
            int hi = __builtin_amdgcn_cvt_pk_fp8_f32(t[4], t[5], 0, false); hi = __builtin_amdgcn_cvt_pk_fp8_f32(t[6], t[7], hi, true);
            *(GAS u32x2*)((unsigned char*)jb.dst + eo) = (u32x2){(unsigned)lo, (unsigned)hi}; }
        else { u32x4 o; o.x = pg8::cvt_pk_bf16(t[0], t[1]); o.y = pg8::cvt_pk_bf16(t[2], t[3]); o.z = pg8::cvt_pk_bf16(t[4], t[5]); o.w = pg8::cvt_pk_bf16(t[6], t[7]); *(GAS u32x4*)((bf16*)jb.dst + eo) = o; } }
    LDS_WAIT(); asm volatile("" ::: "memory");
}
__device__ __forceinline__ float softcap(float z) { return SOFTCAP * tanhf(z * (1.0f / SOFTCAP)); }
__device__ __forceinline__ void skinny16(const float* x0, const LAS float* G, bf16* xb0, int lane, f32x4& D, float& ssq) {
    const int r = lane & 15, kq = lane >> 4;
    const GAS f32x4* xp = (const GAS f32x4*)(x0 + (size_t)r * DM) + kq; const LAS f32x4* gp = (const LAS f32x4*)G + lane;
    D = (f32x4){0.f, 0.f, 0.f, 0.f}; float ss = 0.f;
#pragma unroll 4
    for (int s = 0; s < 64; s += 2) { const f32x4 a = xp[4 * s], a2 = xp[4 * s + 4]; const f32x4 g = gp[64 * s], g2 = gp[64 * s + 64];
        ss += ((a[0] * a[0] + a[1] * a[1]) + (a[2] * a[2] + a[3] * a[3])) + ((a2[0] * a2[0] + a2[1] * a2[1]) + (a2[2] * a2[2] + a2[3] * a2[3]));
        D = __builtin_amdgcn_mfma_f32_16x16x4f32(a[0], g[0], D, 0, 0, 0); D = __builtin_amdgcn_mfma_f32_16x16x4f32(a[1], g[1], D, 0, 0, 0);
        D = __builtin_amdgcn_mfma_f32_16x16x4f32(a[2], g[2], D, 0, 0, 0); D = __builtin_amdgcn_mfma_f32_16x16x4f32(a[3], g[3], D, 0, 0, 0);
        D = __builtin_amdgcn_mfma_f32_16x16x4f32(a2[0], g2[0], D, 0, 0, 0); D = __builtin_amdgcn_mfma_f32_16x16x4f32(a2[1], g2[1], D, 0, 0, 0);
        D = __builtin_amdgcn_mfma_f32_16x16x4f32(a2[2], g2[2], D, 0, 0, 0); D = __builtin_amdgcn_mfma_f32_16x16x4f32(a2[3], g2[3], D, 0, 0, 0);
        if (xb0) {
            unsigned ax = pg8::cvt_pk_bf16(a[0], a[1]), ay = pg8::cvt_pk_bf16(a[2], a[3]), bx = pg8::cvt_pk_bf16(a2[0], a2[1]), by = pg8::cvt_pk_bf16(a2[2], a2[3]);
            { const auto rr = __builtin_amdgcn_permlane16_swap(ax, bx, false, false); ax = rr[0]; bx = rr[1]; }
            { const auto rr = __builtin_amdgcn_permlane16_swap(ay, by, false, false); ay = rr[0]; by = rr[1]; }
            asm volatile("" : "+v"(ax), "+v"(ay), "+v"(bx), "+v"(by));
            *(GAS u32x4*)(xb0 + (size_t)r * DM + 16 * (s + (kq & 1)) + 4 * (kq & 2)) = (u32x4){ax, ay, bx, by}; } }
    ss = sum_xor16(ss); ss = sum_xor32(ss); ssq = ss;
}
__device__ __forceinline__ void skinny16_bf16(const bf16* x0, const LAS float* G, int lane, f32x4& D, float& ssq) {
    const int r = lane & 15, kq = lane >> 4;
    const GAS u32x4* xp = (const GAS u32x4*)(x0 + (size_t)r * DM) + kq; const LAS f32x4* gp = (const LAS f32x4*)G + 32 * kq + (lane & 15);
    D = (f32x4){0.f, 0.f, 0.f, 0.f}; float ss = 0.f;
#pragma unroll 8
    for (int s = 0; s < 32; ++s) { const u32x4 av = xp[4 * s]; const f32x4 g = gp[128 * s], g2 = gp[128 * s + 16];
        const float a0 = __builtin_bit_cast(float, av.x << 16), a1 = __builtin_bit_cast(float, av.x & 0xffff0000u), a2 = __builtin_bit_cast(float, av.y << 16), a3 = __builtin_bit_cast(float, av.y & 0xffff0000u);
        const float a4 = __builtin_bit_cast(float, av.z << 16), a5 = __builtin_bit_cast(float, av.z & 0xffff0000u), a6 = __builtin_bit_cast(float, av.w << 16), a7 = __builtin_bit_cast(float, av.w & 0xffff0000u);
        ss += ((a0 * a0 + a1 * a1) + (a2 * a2 + a3 * a3)) + ((a4 * a4 + a5 * a5) + (a6 * a6 + a7 * a7));
        D = __builtin_amdgcn_mfma_f32_16x16x4f32(a0, g[0], D, 0, 0, 0); D = __builtin_amdgcn_mfma_f32_16x16x4f32(a1, g[1], D, 0, 0, 0);
        D = __builtin_amdgcn_mfma_f32_16x16x4f32(a2, g[2], D, 0, 0, 0); D = __builtin_amdgcn_mfma_f32_16x16x4f32(a3, g[3], D, 0, 0, 0);
        D = __builtin_amdgcn_mfma_f32_16x16x4f32(a4, g2[0], D, 0, 0, 0); D = __builtin_amdgcn_mfma_f32_16x16x4f32(a5, g2[1], D, 0, 0, 0);
        D = __builtin_amdgcn_mfma_f32_16x16x4f32(a6, g2[2], D, 0, 0, 0); D = __builtin_amdgcn_mfma_f32_16x16x4f32(a7, g2[3], D, 0, 0, 0); }
    ss = sum_xor16(ss); ss = sum_xor32(ss); ssq = ss;
}
__device__ __forceinline__ void p0_prologue(const Args& A, Frame& F) {
    const int gw = F.vcu * NWAVES + F.wave, NGW = F.G * NWAVES;
    __syncthreads();
    {   LAS float* scr = (LAS float*)(F.lds + RING_OFF + F.wave * 16384);
        int it = gw; Job jb; int local; P0Regs R;
        if (it < P0_NOW_ITEMS) { get_job(A, F, it, jb, local); p0_load(jb, local, F.lane, R); }
        while (it < P0_NOW_ITEMS) {
            const int itn = it + NGW; Job jn = jb; int ln = local; P0Regs Rn = R;
            if (itn < P0_NOW_ITEMS) { get_job(A, F, itn, jn, ln); p0_load(jn, ln, F.lane, Rn); }
            p0_store(jb, local, scr, F.lane, R);
            jb = jn; local = ln; R = Rn; it = itn; } }
    __syncthreads();
    LAS float* Wg = (LAS float*)(F.lds + RING_OFF);
    {   f32x4 wv[8]; float gv[8];
#pragma unroll
        for (int it = 0; it < 8; ++it) { const int idx = F.tid + 512 * it, k = idx >> 2, q = idx & 3; wv[it] = *(const GAS f32x4*)(A.in[I_WIN] + (size_t)k * MPROJ + MPROJ_MAIN + 4 * q); gv[it] = A.in[I_MIXN][k]; }
#pragma unroll
        for (int it = 0; it < 8; ++it) { const int idx = F.tid + 512 * it, k = idx >> 2, q = idx & 3;
#pragma unroll
            for (int c = 0; c < 4; ++c) Wg[((k >> 2) * 16 + 4 * q + c) * 4 + (k & 3)] = wv[it][c] * gv[it]; } }
    LAS float* rsx = (LAS float*)(F.lds + RING_OFF + 65536) + F.wave * 16;
    __syncthreads();
    bf16* xb = (bf16*)(F.ws + WS_A); float* ss0 = (float*)(F.ws + T_SS0); float* gates = (float*)(F.ws + T_GATES);
    for (int tile = gw; tile < MTOK / 16; tile += NGW) {
        const int row0 = tile * 16; f32x4 D; float ssq;
        skinny16(A.in[I_X] + (size_t)row0 * DM, Wg, xb + (size_t)row0 * DM, F.lane, D, ssq);
        if (F.lane < 16) { ss0[row0 + F.lane] = ssq; rsx[F.lane] = rsqrtf(ssq * (1.0f / DM) + EPS); }
        LDS_WAIT(); asm volatile("" ::: "memory");
        const int n = F.lane & 15, rq = F.lane >> 4; const f32x4 rs4 = *(const LAS f32x4*)(rsx + 4 * rq); const float bias = n < 8 ? A.in[I_BI][n] : A.in[I_BF][n - 8];
        f32x4 zz;
#pragma unroll
        for (int q = 0; q < 4; ++q) { float z = softcap(D[q] * rs4[q] + bias); if (n >= 8) z = -log1pf(expf(-z)); zz[q] = z; }
        *(GAS f32x4*)(gates + ((size_t)(row0 >> 12) * 16 + n) * SEQ + (row0 & (SEQ - 1)) + 4 * rq) = zz;
        LDS_WAIT(); asm volatile("" ::: "memory");
    }
}
__device__ __forceinline__ void router_phase(const Args& A, Frame& F) {
    LAS float* Wr = (LAS float*)(F.lds + RING_OFF);
    LAS int* hist = (LAS int*)(F.lds + RING_OFF + 65536);
    LAS float* lg = (LAS float*)(F.lds + RING_OFF + 65536 + 64) + F.wave * 272;
    {   f32x4 wv[4]; float gv[4];
#pragma unroll
        for (int it = 0; it < 4; ++it) { const int idx = F.tid + 512 * it, k = idx >> 1, q = idx & 1; wv[it] = *(const GAS f32x4*)(A.in[I_WR] + (size_t)k * NEXP + 4 * q); gv[it] = A.in[I_FFNN][DM + k]; }
#pragma unroll
        for (int it = 0; it < 4; ++it) { const int idx = F.tid + 512 * it, k = idx >> 1, q = idx & 1;
#pragma unroll
            for (int c = 0; c < 4; ++c) { Wr[((k >> 2) * 16 + 4 * q + c) * 4 + (k & 3)] = wv[it][c] * gv[it]; Wr[((k >> 2) * 16 + 8 + 4 * q + c) * 4 + (k & 3)] = 0.f; } } }
    if (F.tid < NEXP) hist[F.tid] = 0;
    __syncthreads();
    int* sele = (int*)(F.ws + T_SELE); float* selw1 = (float*)(F.ws + T_SELW1); float* selw2 = (float*)(F.ws + T_SELW2); float* selrs = (float*)(F.ws + T_SELRS);
    const int TPW = MTOK / F.G;
    for (int i = F.wave * 16; i < TPW; i += NWAVES * 16) {
        const int tok0 = blockIdx.x * TPW + i; f32x4 D; float ssq;
        skinny16_bf16((const bf16*)(F.ws + WS_A) + (size_t)tok0 * DM, Wr, F.lane, D, ssq);
        const int n = F.lane & 15, rq = F.lane >> 4;
#pragma unroll
        for (int q = 0; q < 4; ++q) lg[(4 * rq + q) * 16 + n] = D[q];
        if (F.lane < 16) lg[256 + F.lane] = rsqrtf(ssq * (1.0f / DM) + EPS);
        LDS_WAIT(); asm volatile("" ::: "memory");
        if (F.lane < 16) { const f32x4 l0 = *(const LAS f32x4*)(lg + F.lane * 16), l1 = *(const LAS f32x4*)(lg + F.lane * 16 + 4); const float rs = lg[256 + F.lane];
            const float s[8] = {l0[0], l0[1], l0[2], l0[3], l1[0], l1[1], l1[2], l1[3]};
            float b1 = s[0]; int i1 = 0;
#pragma unroll
            for (int e = 1; e < 8; ++e) if (s[e] > b1) { b1 = s[e]; i1 = e; }
            float b2 = -3.0e38f; int i2 = 0;
#pragma unroll
            for (int e = 0; e < 8; ++e) if (e != i1 && s[e] > b2) { b2 = s[e]; i2 = e; }
            const float w1 = 1.0f / (1.0f + expf((b2 - b1) * rs)), w2 = 1.0f - w1;
            const int tok = tok0 + F.lane; sele[tok] = i1 | (i2 << 8); selw1[tok] = w1; selw2[tok] = w2; selrs[tok] = rs;
            __hip_atomic_fetch_add(hist + i1, 1, __ATOMIC_RELAXED, __HIP_MEMORY_SCOPE_WORKGROUP); __hip_atomic_fetch_add(hist + i2, 1, __ATOMIC_RELAXED, __HIP_MEMORY_SCOPE_WORKGROUP); }
        LDS_WAIT(); asm volatile("" ::: "memory");
    }
    __syncthreads();
    if (F.tid < NEXP) ((int*)(F.ctl + CW_CNT))[blockIdx.x * NEXP + F.tid] = hist[F.tid];
}
__device__ __forceinline__ void slots_phase(Frame& F) {
    LAS int* cn = (LAS int*)(F.lds + RING_OFF);
    LAS int* tot = cn + 2048; LAS int* pre = tot + 8; LAS int* sst = pre + 8; LAS int* tst = sst + 8; LAS int* ntl = tst + 8; LAS int* le = ntl + 16;
    const int TPW = MTOK / F.G; const int w = blockIdx.x;
    for (int i = F.tid; i < F.G * NEXP; i += NWAVES * 64) cn[i] = ((const int*)(F.ctl + CW_CNT))[i];
    __syncthreads();
    {
        const int e = F.wave; float tp = 0.f, pp = 0.f;
#pragma unroll
        for (int i = 0; i < 4; ++i) { const int ww = 4 * F.lane + i; const float c = ww < F.G ? (float)cn[ww * NEXP + e] : 0.f; tp += c; pp += ww < w ? c : 0.f; }
        tp = wave_scan_add(tp); pp = wave_scan_add(pp);
        if (F.lane == 63) { tot[e] = (int)tp; pre[e] = (int)pp; } }
    __syncthreads();
    if (F.tid == 0) { int ts = 0; for (int e = 0; e < NEXP; ++e) { const int nt = (tot[e] + 255) >> 8; tst[e] = ts; sst[e] = ts * 256; ntl[e] = nt; ts += nt; } ntl[8] = ts; }
    const int* sele = (const int*)(F.ws + T_SELE); const float* selw1 = (const float*)(F.ws + T_SELW1); const float* selw2 = (const float*)(F.ws + T_SELW2); const float* selrs = (const float*)(F.ws + T_SELRS);
    int* slt = (int*)(F.ws + T_SLOT);
#define SL_TOK(s) slt[((s) >> 8) * 1024 + ((s) & 255)]
#define SL_RS(s) ((float*)slt)[((s) >> 8) * 1024 + 256 + ((s) & 255)]
#define SL_W(s) ((float*)slt)[((s) >> 8) * 1024 + 512 + ((s) & 255)]
#define SL_YROW(s) slt[((s) >> 8) * 1024 + 768 + ((s) & 255)]
    LAS unsigned long long* bal = (LAS unsigned long long*)(le + 128);
    if (F.tid < TPW) { const int mine = sele[w * TPW + F.tid]; le[F.tid] = mine; const int e1 = mine & 255, e2 = mine >> 8;
#pragma unroll
        for (int e = 0; e < NEXP; ++e) { const unsigned long long b = __ballot(e1 == e || e2 == e); if (F.lane == 0) bal[F.wave * NEXP + e] = b; } }
    __syncthreads();
    if (F.tid < 2 * TPW) { const int tl = F.tid >> 1, j = F.tid & 1, mine = le[tl], e = j ? (mine >> 8) : (mine & 255);
        const unsigned long long m0 = bal[e], m1 = bal[NEXP + e];
        const int rank = tl < 64 ? __popcll(m0 & ((1ull << tl) - 1ull)) : __popcll(m0) + __popcll(m1 & ((1ull << (tl - 64)) - 1ull));
        const int slot = sst[e] + pre[e] + rank, token = w * TPW + tl;
        ((int*)(F.ws + T_SLOTOF))[2 * token + j] = slot; SL_TOK(slot) = token; SL_YROW(slot) = 2 * token + j; SL_RS(slot) = selrs[token]; SL_W(slot) = j ? selw2[token] : selw1[token]; }
    if (w < NEXP) { const int e = w, lo = sst[e] + tot[e], hi = sst[e] + 256 * ntl[e]; for (int s = lo + F.tid; s < hi; s += NWAVES * 64) { SL_TOK(s) = 0; SL_YROW(s) = -1; SL_RS(s) = 0.f; SL_W(s) = 0.f; } }
    if (w == 0) { if (F.tid == 0) ((int*)(F.ctl + CW_MOE))[0] = ntl[8];
        for (int e = 0; e < NEXP; ++e) for (int t = F.tid; t < ntl[e]; t += NWAVES * 64) ((int*)(F.ctl + CW_TEXP))[tst[e] + t] = e; }
}
__device__ __forceinline__ f32x4 fp8x4_to_f32(unsigned v) { const f32x2 lo = __builtin_amdgcn_cvt_pk_f32_fp8((int)v, false), hi = __builtin_amdgcn_cvt_pk_f32_fp8((int)v, true); return (f32x4){lo.x, lo.y, hi.x, hi.y}; }
__device__ __forceinline__ void combine_phase(Frame& F) {
    const bf16* x3b = (const bf16*)(F.ws + WS_A); const unsigned char* Y = F.ws + WS_Y;
    const int gw = F.vcu * NWAVES + F.wave, NGW = F.G * NWAVES;
    for (int tokn = gw; tokn < MTOK; tokn += NGW) {
        const GAS u32x2* yp = (const GAS u32x2*)(Y + (size_t)tokn * 2048); const GAS u32x4* xp = (const GAS u32x4*)(x3b + (size_t)tokn * DM);
        u32x2 y0[2], y1[2]; u32x4 xx[2];
#pragma unroll
        for (int p = 0; p < 2; ++p) { y0[p] = yp[64 * p + F.lane]; y1[p] = yp[128 + 64 * p + F.lane]; xx[p] = xp[64 * p + F.lane]; }
        f32x4 ex[2][2];
#pragma unroll
        for (int p = 0; p < 2; ++p) { ex[p][0] = (f32x4){0.f, 0.f, 0.f, 0.f}; ex[p][1] = (f32x4){0.f, 0.f, 0.f, 0.f}; }
        const int s0 = __builtin_amdgcn_readfirstlane(((const int*)(F.ws + T_SLOTOF))[2 * tokn]), s1 = __builtin_amdgcn_readfirstlane(((const int*)(F.ws + T_SLOTOF))[2 * tokn + 1]);
#pragma unroll
        for (int j = 0; j < 2; ++j) { const int sl = j ? s1 : s0;
            if (sl >= 65536) { const int r = (sl - 65536) >> 8, rl = sl & 255;
                if (j) { y1[0] = (u32x2){0u, 0u}; y1[1] = y1[0]; } else { y0[0] = (u32x2){0u, 0u}; y0[1] = y0[0]; }
                for (int ks = 0; ks < 7; ++ks) { const GAS u32x4* pp = (const GAS u32x4*)((const bf16*)(F.ws + B_YP) + (size_t)((r * 7 + ks) * 256 + rl) * DM);
#pragma unroll
                    for (int p = 0; p < 2; ++p) { const u32x4 v = pp[64 * p + F.lane];
#pragma unroll
                        for (int i = 0; i < 2; ++i) { ex[p][0][2 * i] += bf2f((unsigned short)(v[i] & 0xffff)); ex[p][0][2 * i + 1] += bf2f((unsigned short)(v[i] >> 16));
                            ex[p][1][2 * i] += bf2f((unsigned short)(v[i + 2] & 0xffff)); ex[p][1][2 * i + 1] += bf2f((unsigned short)(v[i + 2] >> 16)); } } } } }
        GAS f32x4* op = (GAS f32x4*)(F.out + (size_t)tokn * DM);
#pragma unroll
        for (int p = 0; p < 2; ++p) { f32x4 r0, r1; constexpr float ys = 1.0f / pg8::MOE_YSCALE;
#pragma unroll
            for (int i = 0; i < 2; ++i) { r0[2 * i] = bf2f((unsigned short)(xx[p][i] & 0xffff)); r0[2 * i + 1] = bf2f((unsigned short)(xx[p][i] >> 16));
                r1[2 * i] = bf2f((unsigned short)(xx[p][i + 2] & 0xffff)); r1[2 * i + 1] = bf2f((unsigned short)(xx[p][i + 2] >> 16)); }
            r0 = r0 + (fp8x4_to_f32(y0[p].x) + fp8x4_to_f32(y1[p].x)) * ys + ex[p][0]; r1 = r1 + (fp8x4_to_f32(y0[p].y) + fp8x4_to_f32(y1[p].y)) * ys + ex[p][1];
            op[128 * p + 2 * F.lane] = r0; op[128 * p + 2 * F.lane + 1] = r1; }
    }
}
typedef __bf16 bf16x2_t __attribute__((ext_vector_type(2)));
__device__ __forceinline__ unsigned cvtpk(float lo, float hi) { f32x2 v = {lo, hi}; return __builtin_bit_cast(unsigned, __builtin_convertvector(v, bf16x2_t)); }
__device__ __forceinline__ void sb_block(const bf16x8 (&kf)[4], const bf16x8 (&vf)[4], const bf16x8 (&qf)[4], f32x16& O0, f32x16& O1, float& carry, bool diag, int c, int h) {
    f32x16 X;
#pragma unroll
    for (int i = 0; i < 16; ++i) X[i] = 0.f;
#pragma unroll
    for (int ks = 0; ks < 4; ++ks) X = __builtin_amdgcn_mfma_f32_32x32x16_bf16(kf[ks], qf[ks], X, 0, 0, 0);
    float e[16], r[16];
#pragma unroll
    for (int i = 0; i < 16; ++i) e[i] = __builtin_amdgcn_exp2f(fminf(X[i], 126.0f));
    if (diag) {
#pragma unroll
        for (int i = 0; i < 16; ++i) { const int ko = 16 * (i >> 3) + 8 * h + (i & 7); e[i] = ko < c ? e[i] : 0.f; } }
#pragma unroll
    for (int i = 0; i < 16; ++i) r[i] = __builtin_amdgcn_rcpf(1.0f + e[i]);
    float EA[8], EB[8]; EA[7] = 1.0f; EB[7] = 1.0f;
#pragma unroll
    for (int i = 6; i >= 0; --i) { EA[i] = EA[i + 1] * r[i + 1]; EB[i] = EB[i + 1] * r[8 + i + 1]; }
    const float GA = EA[0] * r[0], GB = EB[0] * r[8];
    const float pGA = get_xor32(GA, h != 0), pGB = get_xor32(GB, h != 0);
    const float TB = h ? carry : carry * pGB;
    const float TA = (carry * pGB) * GB * (h ? 1.0f : pGA);
    carry = ((carry * GA) * GB) * (pGA * pGB);
    float a[16];
#pragma unroll
    for (int i = 0; i < 8; ++i) { a[i] = (EA[i] * TA) * (e[i] * r[i]); a[8 + i] = (EB[i] * TB) * (e[8 + i] * r[8 + i]); }
    u32x4 p0, p1;
    p0.x = cvtpk(a[0], a[1]); p0.y = cvtpk(a[2], a[3]); p0.z = cvtpk(a[4], a[5]); p0.w = cvtpk(a[6], a[7]);
    p1.x = cvtpk(a[8], a[9]); p1.y = cvtpk(a[10], a[11]); p1.z = cvtpk(a[12], a[13]); p1.w = cvtpk(a[14], a[15]);
    const bf16x8 af0 = __builtin_bit_cast(bf16x8, p0), af1 = __builtin_bit_cast(bf16x8, p1);
    O0 = __builtin_amdgcn_mfma_f32_32x32x16_bf16(vf[0], af0, O0, 0, 0, 0); O0 = __builtin_amdgcn_mfma_f32_32x32x16_bf16(vf[1], af1, O0, 0, 0, 0);
    O1 = __builtin_amdgcn_mfma_f32_32x32x16_bf16(vf[2], af0, O1, 0, 0, 0); O1 = __builtin_amdgcn_mfma_f32_32x32x16_bf16(vf[3], af1, O1, 0, 0, 0);
}
constexpr int SBW_SLOTS = 8;
__device__ __forceinline__ void sb_fast(Frame& F) {
    const bf16* Kb = (const bf16*)(F.ws + B_SBK); const bf16* Vt = (const bf16*)(F.ws + B_SBVT); bf16* QO = (bf16*)(F.ws + B_SBQ);
    const int lane = F.lane, c = lane & 31, h = lane >> 5, w = F.wave;
    LAS unsigned char* win = F.lds + RING_OFF;
    for (int chunk = F.vcu; chunk < NBATCH * SBH * (SEQ / 32) / NWAVES; chunk += F.G) {
        const int item = chunk * NWAVES + w, bh = item >> 7, qb = item & 127, b = bh >> 4, hd = bh & 15, t0 = qb * 32, qb0 = qb - w;
        bf16* op = (bf16*)(F.ws + B_SBO) + ((size_t)(b * SEQ + t0 + c) * 1024 + hd * 64);
        const bf16* qfp = QO + ((size_t)(bh * 128 + qb) * 4 * 64 + lane) * 8;
        const bf16* kfp = Kb + ((size_t)bh * 128 * 4 * 64 + lane) * 8; const bf16* vfp = Vt + ((size_t)bh * 128 * 4 * 64 + lane) * 8;
        asm volatile("s_waitcnt lgkmcnt(0)" ::: "memory"); __builtin_amdgcn_s_barrier();
        {   const bf16* src = (w < 4 ? kfp + 512 * w : vfp + 512 * (w - 4));
#pragma unroll
            for (int j = 0; j < SBW_SLOTS; ++j) { const int kbw = qb0 + 7 - j;
                if (kbw >= 0) __builtin_amdgcn_global_load_lds((const unsigned*)(src + (size_t)kbw * 2048), (LAS unsigned*)(win + j * 8192 + w * 1024), 16, 0, 0); } }
        bf16x8 qf[4];
#pragma unroll
        for (int ks = 0; ks < 4; ++ks) qf[ks] = *(const GAS bf16x8*)(qfp + 512 * ks);
        f32x16 O0, O1;
#pragma unroll
        for (int i = 0; i < 16; ++i) { O0[i] = 0.f; O1[i] = 0.f; }
        float carry = 1.0f;
        asm volatile("s_waitcnt vmcnt(0)" ::: "memory"); __builtin_amdgcn_s_barrier(); asm volatile("" ::: "memory");
#define SB_FRAGS(KF, VF, KB) do { const int _j = qb0 + 7 - (KB); \
            if (_j < SBW_SLOTS) { const LAS unsigned char* _s = win + _j * 8192 + lane * 16; \
                _Pragma("unroll") for (int ks = 0; ks < 4; ++ks) { KF[ks] = *(const LAS bf16x8*)(_s + 1024 * ks); VF[ks] = *(const LAS bf16x8*)(_s + 4096 + 1024 * ks); } } \
            else { const bf16* _k = kfp + (size_t)(KB) * 2048; const bf16* _v = vfp + (size_t)(KB) * 2048; \
                _Pragma("unroll") for (int ks = 0; ks < 4; ++ks) { KF[ks] = *(const GAS bf16x8*)(_k + 512 * ks); VF[ks] = *(const GAS bf16x8*)(_v + 512 * ks); } } } while (0)
        bf16x8 kfA[4], vfA[4], kfB[4], vfB[4];
        SB_FRAGS(kfA, vfA, qb);
        for (int kb = qb; ; kb -= 2) {
            if (kb >= 1) SB_FRAGS(kfB, vfB, kb - 1);
            sb_block(kfA, vfA, qf, O0, O1, carry, kb == qb, c, h);
            if (kb == 0 || !__any(carry >= 1.17549435e-38f)) break;
            if (kb >= 2) SB_FRAGS(kfA, vfA, kb - 2);
            sb_block(kfB, vfB, qf, O0, O1, carry, false, c, h);
            if (kb == 1 || !__any(carry >= 1.17549435e-38f)) break;
        }
#undef SB_FRAGS
        bf16* opr = op;
#pragma unroll
        for (int g = 0; g < 4; g += 2) {
#pragma unroll
            for (int t = 0; t < 2; ++t) { const f32x16& O = t ? O1 : O0;
                unsigned ax = cvtpk(O[4 * g], O[4 * g + 1]), ay = cvtpk(O[4 * g + 2], O[4 * g + 3]), bx = cvtpk(O[4 * g + 4], O[4 * g + 5]), by = cvtpk(O[4 * g + 6], O[4 * g + 7]);
                { const auto r = __builtin_amdgcn_permlane32_swap(ax, bx, false, false); ax = r[0]; bx = r[1]; }
                { const auto r = __builtin_amdgcn_permlane32_swap(ay, by, false, false); ay = r[0]; by = r[1]; }
                asm volatile("" : "+v"(ax), "+v"(ay), "+v"(bx), "+v"(by));
                *(GAS u32x4*)(opr + 32 * t + 8 * (g + h)) = (u32x4){ax, ay, bx, by}; } }
    }
}
constexpr int ML_SEG0 = 0, ML_SEG1 = 19, ML_SEG2 = 36, ML_SEG3 = 51, ML_SEG4 = 64;
constexpr int ML_U = 0, ML_MM = 16384, ML_NB = 32768, ML_OM = 49152, ML_MC = 65536, ML_MS = 65792, ML_BL = 66048, ML_UX = 66304, ML_P = 66560, ML_QW = ML_P + 2 * 9216, ML_DEN = ML_QW + 2 * 9216, ML_SS = ML_DEN + 512, ML_END = ML_SS + 4096;
static_assert(ML_END <= RING_BYTES, "mLSTM LDS map");
__device__ __forceinline__ bf16x8 pack_frag(const f32x4 a, const f32x4 b) { u32x4 w; w.x = cvtpk(a[0], a[1]); w.y = cvtpk(a[2], a[3]); w.z = cvtpk(b[0], b[1]); w.w = cvtpk(b[2], b[3]); return __builtin_bit_cast(bf16x8, w); }
__device__ __forceinline__ bf16x8 scale_frag(const bf16x8 v, const f32x4 w0, const f32x4 w1) {
    const u32x4 x = __builtin_bit_cast(u32x4, v); f32x4 a, b;
    a[0] = __builtin_bit_cast(float, x[0] << 16) * w0[0]; a[1] = __builtin_bit_cast(float, x[0] & 0xffff0000u) * w0[1]; a[2] = __builtin_bit_cast(float, x[1] << 16) * w0[2]; a[3] = __builtin_bit_cast(float, x[1] & 0xffff0000u) * w0[3];
    b[0] = __builtin_bit_cast(float, x[2] << 16) * w1[0]; b[1] = __builtin_bit_cast(float, x[2] & 0xffff0000u) * w1[1]; b[2] = __builtin_bit_cast(float, x[3] << 16) * w1[2]; b[3] = __builtin_bit_cast(float, x[3] & 0xffff0000u) * w1[3];
    return pack_frag(a, b);
}
#define ML_MFMA(a, b, c) __builtin_amdgcn_mfma_f32_16x16x32_bf16((a), (b), (c), 0, 0, 0)
__device__ __forceinline__ void mlstm_fast(const Args& A, Frame& F) {
    LAS unsigned char* L = F.lds + RING_OFF;
    const bf16* QRF = (const bf16*)(F.ws + B_Q); const bf16* KRF = (const bf16*)(F.ws + B_K); const bf16* KTF = (const bf16*)F.out; const bf16* VTF = (const bf16*)(F.ws + B_VT);
    const bf16* OG = (const bf16*)(F.ws + B_OG); bf16* HN = (bf16*)(F.ws + B_HN); const float* gates = (const float*)(F.ws + T_GATES);
    int tid_l = F.tid; const int w = F.wave;
    for (int unit = blockIdx.x; unit < NBATCH * MH * 4; unit += F.G) {
        const int bh = unit >> 2, seg = unit & 3, b = bh >> 3, h = bh & 7;
        const int c_full = seg == 0 ? ML_SEG0 : seg == 1 ? ML_SEG1 : seg == 2 ? ML_SEG2 : ML_SEG3, c_end = seg == 0 ? ML_SEG1 : seg == 1 ? ML_SEG2 : seg == 2 ? ML_SEG3 : ML_SEG4;
        const size_t rowb = (size_t)b * SEQ;
        __syncthreads();
        f32x4 Ct[4], Cn[4];
#pragma unroll
        for (int i = 0; i < 4; ++i) { Ct[i] = (f32x4){0.f, 0.f, 0.f, 0.f}; Cn[i] = (f32x4){0.f, 0.f, 0.f, 0.f}; }
        const bf16x8 zerof = __builtin_bit_cast(bf16x8, (u32x4){0u, 0u, 0u, 0u});
        {
        const int tid = tid_l, lane = tid & 63, c = lane & 15, q4 = lane >> 4;
        const bf16* ktp = KTF + ((size_t)bh * 64 * 8 * 64 + lane) * 8;
        const bf16* vtp = VTF + (((size_t)bh * 64 * 8 + w) * 2 * 64 + lane) * 8;
#define ML_LOADKV(KT_, VT_, CC) do { _Pragma("unroll") for (int i = 0; i < 4; ++i) _Pragma("unroll") for (int ks = 0; ks < 2; ++ks) KT_[i][ks] = *(const GAS bf16x8*)(ktp + (size_t)(CC) * 4096 + (i * 2 + ks) * 512); \
            _Pragma("unroll") for (int ks = 0; ks < 2; ++ks) VT_[ks] = *(const GAS bf16x8*)(vtp + (size_t)(CC) * 8192 + ks * 512); } while (0)
        bf16x8 kt0[4][2], vt0[2], kt1[4][2], vt1[2], kt2[4][2], vt2[2];
        ML_LOADKV(kt0, vt0, 0); ML_LOADKV(kt1, vt1, 1); ML_LOADKV(kt2, vt2, 2);
        {
        { float ig2[8], lf2[8];
#pragma unroll
          for (int j = 0; j < 8; ++j) { const int cc = w + 8 * j; const int tk = (cc < c_end ? cc : 0) * 64 + lane; ig2[j] = gates[((size_t)b * 16 + h) * SEQ + tk] * LOG2E; lf2[j] = gates[((size_t)b * 16 + 8 + h) * SEQ + tk] * LOG2E; }
#pragma unroll
          for (int j = 0; j < 8; ++j) { const int cc = w + 8 * j; if (cc < c_end) {
            const float bb = wave_scan_add(lf2[j]);
            const float u = ig2[j] - bb; const float pm = wave_scan_max(u);
            ((LAS float*)(L + ML_U))[cc * 64 + lane] = u; ((LAS float*)(L + ML_MM))[cc * 64 + lane] = pm; ((LAS float*)(L + ML_NB))[cc * 64 + lane] = -bb;
            if (lane == 63) { ((LAS float*)(L + ML_BL))[cc] = bb; ((LAS float*)(L + ML_UX))[cc] = pm; } } } }
        __syncthreads();
        if (w == 0) { const int cc = lane; const float ux = ((LAS float*)(L + ML_UX))[cc]; float sa = ((LAS float*)(L + ML_BL))[cc], sb = sa + ux;
#pragma unroll
            for (int o = 1; o < 64; o <<= 1) { const float pa = __shfl_up(sa, o), pb = __shfl_up(sb, o); if (lane >= o) { sb = fmaxf(pb + sa, sb); sa = pa + sa; } }
            const float mp = __shfl_up(sb, 1); const float m = lane == 0 ? -__builtin_inff() : mp;
            if (cc < c_end) { ((LAS float*)(L + ML_MC))[cc] = m; ((LAS float*)(L + ML_MS))[cc] = fmaxf(m, ux); } }
        __syncthreads();
        for (int cc = w; cc < c_end; cc += NWAVES) {
            const float mc = ((LAS float*)(L + ML_MC))[cc], ms = ((LAS float*)(L + ML_MS))[cc];
            const float u = ((LAS float*)(L + ML_U))[cc * 64 + lane], mm = fmaxf(mc, ((LAS float*)(L + ML_MM))[cc * 64 + lane]);
            ((LAS float*)(L + ML_MM))[cc * 64 + lane] = mm; ((LAS float*)(L + ML_NB))[cc * 64 + lane] += -mm; ((LAS float*)(L + ML_OM))[cc * 64 + lane] = __builtin_amdgcn_exp2f(u - ms);
        }
        __syncthreads();
        }
#define ML_UPDATE(KT_, VT_, CC) do { const float _a = __builtin_amdgcn_exp2f(((LAS float*)(L + ML_MC))[CC] - ((LAS float*)(L + ML_MS))[CC]); bf16x8 _vw[2], _ow[2]; \
            _Pragma("unroll") for (int ks = 0; ks < 2; ++ks) { const f32x4 o0 = *(const LAS f32x4*)(L + ML_OM + ((CC) * 64 + 32 * ks + 8 * q4) * 4), o1 = *(const LAS f32x4*)(L + ML_OM + ((CC) * 64 + 32 * ks + 8 * q4 + 4) * 4); \
                _vw[ks] = scale_frag(VT_[ks], o0, o1); _ow[ks] = (c == 0) ? pack_frag(o0, o1) : zerof; } \
            _Pragma("unroll") for (int i = 0; i < 4; ++i) { Ct[i] = Ct[i] * _a; Ct[i] = ML_MFMA(KT_[i][0], _vw[0], Ct[i]); Ct[i] = ML_MFMA(KT_[i][1], _vw[1], Ct[i]); } \
            if (w == 4) { _Pragma("unroll") for (int i = 0; i < 4; ++i) { Cn[i] = Cn[i] * _a; Cn[i] = ML_MFMA(KT_[i][0], _ow[0], Cn[i]); Cn[i] = ML_MFMA(KT_[i][1], _ow[1], Cn[i]); } } } while (0)
        {
#define ML_LD(S, CC) do { if ((CC) < c_full) ML_LOADKV(kt##S, vt##S, CC); } while (0)
#define ML_UP(S, CC) do { if ((CC) < c_full) ML_UPDATE(kt##S, vt##S, CC); } while (0)
            for (int cc = 0; cc < c_full; cc += 3) {
                ML_UP(0, cc);     ML_LD(0, cc + 3);
                ML_UP(1, cc + 1); ML_LD(1, cc + 4);
                ML_UP(2, cc + 2); ML_LD(2, cc + 5);
            }
#undef ML_LD
#undef ML_UP
        }
        }
        asm volatile("" : "+v"(tid_l));
        const int tid = tid_l, lane = tid & 63, c = lane & 15, q4 = lane >> 4;
        const bf16* ktp = KTF + ((size_t)bh * 64 * 8 * 64 + lane) * 8; const bf16* vtp = VTF + (((size_t)bh * 64 * 8 + w) * 2 * 64 + lane) * 8;
        const bf16* qrp = QRF + (size_t)bh * 64 * 4096; const bf16* krp = KRF + (size_t)bh * 64 * 4096;
        const bf16x8 onesf = __builtin_bit_cast(bf16x8, (u32x4){0x3f803f80u, 0x3f803f80u, 0x3f803f80u, 0x3f803f80u});
        bf16x8 kt[4][2], vt[2];
        ML_LOADKV(kt, vt, c_full);
        const int tt_p = w & 3, sh_p = w >> 2; const bool pmake = 2 * sh_p <= tt_p;
        bf16x8 qf[2], kfa[2][2]; u32x4 qv; u32x2 sg[4];
#define ML_LOADP(CC) do { const bf16* _q = qrp + (size_t)(CC) * 4096; const bf16* _k = krp + (size_t)(CC) * 4096; \
            if (pmake) { _Pragma("unroll") for (int ks = 0; ks < 2; ++ks) { qf[ks] = *(const GAS bf16x8*)(_q + (tt_p * 2 + ks) * 512 + lane * 8); \
                _Pragma("unroll") for (int s2 = 0; s2 < 2; ++s2) kfa[s2][ks] = *(const GAS bf16x8*)(_k + ((2 * sh_p + s2) * 2 + ks) * 512 + lane * 8); } } \
            qv = *(const GAS u32x4*)(_q + (((tid >> 7) * 2 + ((tid >> 2) & 1)) * 64 + ((tid >> 3) & 15) + 16 * (tid & 3)) * 8); } while (0)
        qf[0] = qf[1] = zerof; kfa[0][0] = kfa[0][1] = kfa[1][0] = kfa[1][1] = zerof;
        ML_LOADP(c_full);
        const f32x4 gh4 = *(const GAS f32x4*)(A.in[I_GH] + h * MDV + 16 * w + 4 * q4);
        f32x4 nTp[4];
#pragma unroll
        for (int tt = 0; tt < 4; ++tt) nTp[tt] = (f32x4){0.f, 0.f, 0.f, 0.f};
#define ML_FINAL(NT, CC) do { const int _par = (CC) & 1, _t0 = (CC) * 64; LAS float* _DEN = (LAS float*)(L + ML_DEN) + _par * 64; LAS float* _SS = (LAS float*)(L + ML_SS) + _par * 512; \
            _Pragma("unroll") for (int tt = 0; tt < 4; ++tt) { const int t = 16 * tt + c; const f32x4 s0 = *(const LAS f32x4*)(_SS + t * 8), s1 = *(const LAS f32x4*)(_SS + t * 8 + 4); \
                const float ssn = ((s0[0] + s0[1]) + (s0[2] + s0[3])) + ((s1[0] + s1[1]) + (s1[2] + s1[3])); \
                const float dn = fmaxf(fabsf(_DEN[t]), __builtin_amdgcn_exp2f(((LAS float*)(L + ML_NB))[(CC) * 64 + t])); \
                const float rinv = rsqrtf(ssn * (1.0f / MDV) + EPS * dn * dn); \
                const size_t o = (rowb + _t0 + t) * 1024 + h * MDV + 16 * w + 4 * q4; \
                const float o0 = NT[tt][0] * rinv * gh4[0] * __builtin_bit_cast(float, sg[tt].x << 16), o1 = NT[tt][1] * rinv * gh4[1] * __builtin_bit_cast(float, sg[tt].x & 0xffff0000u); \
                const float o2 = NT[tt][2] * rinv * gh4[2] * __builtin_bit_cast(float, sg[tt].y << 16), o3 = NT[tt][3] * rinv * gh4[3] * __builtin_bit_cast(float, sg[tt].y & 0xffff0000u); \
                *(GAS u32x2*)(HN + o) = (u32x2){cvtpk(o0, o1), cvtpk(o2, o3)}; } } while (0)
        {
        for (int cc = c_full; cc < c_end; ++cc) {
            const int par = cc & 1, t0 = cc * 64; const bool more = cc + 1 < c_end;
            if (cc > c_full) {
#pragma unroll
                for (int tt = 0; tt < 4; ++tt) sg[tt] = *(const GAS u32x2*)(OG + (rowb + t0 - 64 + 16 * tt + c) * 1024 + h * MDV + 16 * w + 4 * q4); }
            const float mc = ((LAS float*)(L + ML_MC))[cc];
            LAS unsigned char* Pb = L + ML_P + par * 9216; LAS unsigned char* Qb = L + ML_QW + par * 9216;
            bf16x8 cf[2], cnf[2];
#pragma unroll
            for (int ks = 0; ks < 2; ++ks) { cf[ks] = pack_frag(Ct[2 * ks], Ct[2 * ks + 1]); cnf[ks] = pack_frag(Cn[2 * ks], Cn[2 * ks + 1]); }
            { const int t = tid >> 3, ch = tid & 7;
              const float wi = __builtin_amdgcn_exp2f(mc - ((LAS float*)(L + ML_MM))[cc * 64 + t]); const f32x4 w4 = (f32x4){wi, wi, wi, wi};
              *(LAS bf16x8*)(Qb + t * 144 + ch * 16) = scale_frag(__builtin_bit_cast(bf16x8, qv), w4, w4); }
            if (pmake) {
                const float mmt = ((LAS float*)(L + ML_MM))[cc * 64 + 16 * tt_p + c];
#pragma unroll
                for (int s2 = 0; s2 < 2; ++s2) { const int st = 2 * sh_p + s2; u32x2 pw = (u32x2){0u, 0u};
                    if (st <= tt_p) {
                        f32x4 sT = (f32x4){0.f, 0.f, 0.f, 0.f};
#pragma unroll
                        for (int ks = 0; ks < 2; ++ks) sT = ML_MFMA(kfa[s2][ks], qf[ks], sT);
                        const f32x4 u4 = *(const LAS f32x4*)(L + ML_U + (cc * 64 + 16 * st + 4 * q4) * 4); f32x4 p;
#pragma unroll
                        for (int r = 0; r < 4; ++r) { const bool ok = (16 * st + 4 * q4 + r) <= (16 * tt_p + c); p[r] = ok ? sT[r] * __builtin_amdgcn_exp2f(u4[r] - mmt) : 0.f; }
                        pw.x = cvtpk(p[0], p[1]); pw.y = cvtpk(p[2], p[3]); }
                    *(LAS u32x2*)(Pb + (16 * tt_p + c) * 144 + (16 * st + 4 * q4) * 2) = pw; } }
            if (more) ML_LOADP(cc + 1);
            ML_UPDATE(kt, vt, cc);
            if (more) {
#pragma unroll
                for (int i = 0; i < 4; ++i)
#pragma unroll
                    for (int ks = 0; ks < 2; ++ks) kt[i][ks] = *(const GAS bf16x8*)(ktp + (size_t)(cc + 1) * 4096 + (i * 2 + ks) * 512); }
            asm volatile("s_waitcnt lgkmcnt(0)" ::: "memory"); __builtin_amdgcn_s_barrier(); asm volatile("" ::: "memory");
            if (cc > c_full) ML_FINAL(nTp, cc - 1);
            f32x4 nT[4], dT[4];
#pragma unroll
            for (int tt = 0; tt < 4; ++tt) { nT[tt] = (f32x4){0.f, 0.f, 0.f, 0.f}; dT[tt] = (f32x4){0.f, 0.f, 0.f, 0.f}; }
#pragma unroll
            for (int tt = 0; tt < 4; ++tt) {
#pragma unroll
                for (int ks = 0; ks < 2; ++ks) {
                    if (ks == 0 || tt >= 2) { const bf16x8 pf = *(const LAS bf16x8*)(Pb + (16 * tt + c) * 144 + (32 * ks + 8 * q4) * 2);
                        nT[tt] = ML_MFMA(vt[ks], pf, nT[tt]); if (w == 4) dT[tt] = ML_MFMA(c == 0 ? onesf : zerof, pf, dT[tt]); }
                    const u32x2 qa = *(const LAS u32x2*)(Qb + (16 * tt + c) * 144 + (32 * ks + 4 * q4) * 2), qb2 = *(const LAS u32x2*)(Qb + (16 * tt + c) * 144 + (32 * ks + 16 + 4 * q4) * 2);
                    const bf16x8 qwf = __builtin_bit_cast(bf16x8, (u32x4){qa.x, qa.y, qb2.x, qb2.y});
                    nT[tt] = ML_MFMA(cf[ks], qwf, nT[tt]); if (w == 4) dT[tt] = ML_MFMA(cnf[ks], qwf, dT[tt]); } }
            if (more) { vt[0] = *(const GAS bf16x8*)(vtp + (size_t)(cc + 1) * 8192); vt[1] = *(const GAS bf16x8*)(vtp + (size_t)(cc + 1) * 8192 + 512); }
            LAS float* DEN = (LAS float*)(L + ML_DEN) + par * 64; LAS float* SS = (LAS float*)(L + ML_SS) + par * 512;
#pragma unroll
            for (int tt = 0; tt < 4; ++tt) { float s = (nT[tt][0] * nT[tt][0] + nT[tt][1] * nT[tt][1]) + (nT[tt][2] * nT[tt][2] + nT[tt][3] * nT[tt][3]); s = sum_xor16(s); s = sum_xor32(s);
                if (q4 == 0) { SS[(16 * tt + c) * 8 + w] = s; if (w == 4) DEN[16 * tt + c] = dT[tt][0]; } }
#pragma unroll
            for (int tt = 0; tt < 4; ++tt) nTp[tt] = nT[tt];
        }
#pragma unroll
        for (int tt = 0; tt < 4; ++tt) sg[tt] = *(const GAS u32x2*)(OG + (rowb + (c_end - 1) * 64 + 16 * tt + c) * 1024 + h * MDV + 16 * w + 4 * q4);
        asm volatile("s_waitcnt lgkmcnt(0)" ::: "memory"); __builtin_amdgcn_s_barrier(); asm volatile("" ::: "memory");
        ML_FINAL(nTp, c_end - 1);
        }
#undef ML_FINAL
#undef ML_LOADP
#undef ML_UPDATE
#undef ML_LOADKV
    }
}
constexpr int N_PHASES = 16;
__device__ __forceinline__ void mkframe(const Args& args, Frame& F, LAS unsigned char* lds, const int wv) {
    F.lds = lds; F.MISC = (volatile LAS unsigned*)(lds + MISC_OFF);
    F.lane = lane_now(); F.wave = wv; F.tid = wv * 64 + F.lane;
    F.G = gridDim.x; { const int bx = blockIdx.x; F.vcu = (F.G % 8 == 0) ? (bx % 8) * (F.G / 8) + bx / 8 : bx; }
    unsigned char* ws = args.ws; float* out = args.out; asm volatile("" : "+s"(ws), "+s"(out));
    F.ws = ws; F.out = out; F.ctl = (unsigned*)(ws + WS_CTL);
}
__device__ __forceinline__ void grid_barrier(const Args& args, LAS unsigned char* lds, const int wv) {
    unsigned char* ws = args.ws; asm volatile("" : "+s"(ws));
    XcdBarrier bar; bar.bar = (unsigned*)(ws + WS_CTL) + CW_BAR; bar.x = xb_xcc_id(); bar.st = (volatile LAS unsigned*)(lds + MISC_OFF) + 8;
    xcd_barrier(bar, wv == 0 && lane_now() == 0);
}
#ifndef PHASE_MASK
#define PHASE_MASK 0xffff
#endif
template <int LO, int HI>
__global__ void __launch_bounds__(NWAVES * 64, 2) fwd_kernel(Args args) {
    extern __shared__ __attribute__((aligned(16))) unsigned char lds_raw[];
    LAS unsigned char* lds = (LAS unsigned char*)lds_raw;
    const int wv = __builtin_amdgcn_readfirstlane((int)threadIdx.x >> 6);
    for (int u = wv * 64 + lane_now(); u < (LDS_BYTES - AUX_OFF) / 4; u += NWAVES * 64) ((LAS unsigned*)(lds + AUX_OFF))[u] = 0u;
    __syncthreads();
    if constexpr (HI - LO > 1) { unsigned char* ws = args.ws; (void)xcd_barrier_post((unsigned*)(ws + WS_CTL) + CW_BAR, (volatile LAS unsigned*)(lds + MISC_OFF) + 8, wv == 0 && lane_now() == 0); }
#define IN(k) (((PHASE_MASK >> (k)) & 1) && LO <= (k) && (k) < HI)
#define SEAM(k) do { if constexpr (IN(k) && IN((k) + 1)) grid_barrier(args, lds, wv); } while (0)
#ifndef REPEAT_MASK
#define REPEAT_MASK 0
#endif
#define REPS(k) _Pragma("unroll") for (int rep_ = 0; rep_ < (((REPEAT_MASK >> (k)) & 1) ? 2 : 1); ++rep_)
#define RING (F.lds + RING_OFF)
#define AUXB (F.lds + AUX_OFF)
#define RED ((LAS float*)(F.lds + RED_OFF))
#define SSP ((float*)(F.ws + T_SSP))
#define XBUF ((bf16*)(F.ws + WS_A))
    if constexpr (IN(0)) REPS(0) { Frame F; mkframe(args, F, lds, wv); p0_prologue(args, F); } SEAM(0);
    if constexpr (IN(1)) REPS(1) {
        Frame F; mkframe(args, F, lds, wv);
        pg8::Gemm g{XBUF, (const bf16*)(F.ws + WS_WIN), DM, DM}; pg8::StaticOrder S; S.init(MTOK, MPROJ_MAIN, F.G, (int)blockIdx.x);
        pg8::EpiProj E{(bf16*)(F.ws + B_Q), (bf16*)(F.ws + B_K), (bf16*)F.out, (bf16*)(F.ws + B_VT), (bf16*)(F.ws + B_OG), (const float*)(F.ws + T_SS0), (LAS bf16_t*)(F.lds + RED_OFF)};
        pg8::gemm_phase<pg8::EpiProj, pg8::StaticOrder, false>(RING, AUXB, g, S, E, wv);
    } SEAM(1);
        if constexpr (IN(2)) REPS(2) { Frame F; mkframe(args, F, lds, wv); mlstm_fast(args, F); } SEAM(2);
    if constexpr (IN(3)) {
        Frame F; mkframe(args, F, lds, wv);
        pg8::Gemm g{(const bf16*)(F.ws + B_HN), (const bf16*)(F.ws + WS_WOUT), DM, DM}; pg8::StaticOrder S; S.init(MTOK, DM, F.G, (int)blockIdx.x);
        pg8::EpiRes E{XBUF, nullptr, SSP, RED, nullptr, wv};
        pg8::gemm_phase<pg8::EpiRes, pg8::StaticOrder, false>(RING, AUXB, g, S, E, wv);
    } SEAM(3);
    if constexpr (IN(4)) REPS(4) {
        Frame F; mkframe(args, F, lds, wv);
        pg8::Gemm g{XBUF, (const bf16*)(F.ws + WS_WGU), DM, DM}; pg8::StaticOrder S; S.init(MTOK, 2 * FFN, F.G, (int)blockIdx.x);
        pg8::EpiGu<false> E{F.ws + B_HF, FFN, SSP};
        pg8::gemm_phase<pg8::EpiGu<false>, pg8::StaticOrder, false>(RING, AUXB, g, S, E, wv);
    } SEAM(4);
    if constexpr (IN(5)) {
        Frame F; mkframe(args, F, lds, wv);
        pg8::Gemm g{(const bf16*)(F.ws + B_HF), (const bf16*)(F.ws + WS_WD), FFN, FFN}; pg8::StaticOrder S; S.init(MTOK, DM, F.G, (int)blockIdx.x);
        pg8::EpiRes E{XBUF, nullptr, SSP, RED, nullptr, wv};
        pg8::gemm_phase<pg8::EpiRes, pg8::StaticOrder, false>(RING, AUXB, g, S, E, wv);
    } SEAM(5);
    if constexpr (IN(6)) REPS(6) {
        Frame F; mkframe(args, F, lds, wv);
        LAS float* gkq = (LAS float*)(F.lds + TEX_OFF);
        if (F.tid < 64) gkq[F.tid] = args.in[I_GK][F.tid]; else if (F.tid < 128) gkq[F.tid] = args.in[I_GQ][F.tid - 64];
        __syncthreads();
        pg8::Gemm g{XBUF, (const bf16*)(F.ws + WS_WKVQ), DM, DM}; pg8::StaticOrder S; S.init(MTOK, 3 * DM, F.G, (int)blockIdx.x);
        pg8::EpiKvq E{(bf16*)(F.ws + B_SBK), (bf16*)(F.ws + B_SBVT), (bf16*)(F.ws + B_SBQ), SSP, gkq, (LAS bf16_t*)(F.lds + RED_OFF)};
        pg8::gemm_phase<pg8::EpiKvq, pg8::StaticOrder, false>(RING, AUXB, g, S, E, wv);
    } SEAM(6);
        if constexpr (IN(7)) REPS(7) { Frame F; mkframe(args, F, lds, wv); sb_fast(F); } SEAM(7);
    if constexpr (IN(8)) {
        Frame F; mkframe(args, F, lds, wv);
        pg8::Gemm g{(const bf16*)(F.ws + B_SBO), (const bf16*)(F.ws + WS_WO), DM, DM}; pg8::StaticOrder S; S.init(MTOK, DM, F.G, (int)blockIdx.x);
        pg8::EpiRes E{XBUF, nullptr, nullptr, RED, F.ws + B_X3Q, wv};
        pg8::gemm_phase<pg8::EpiRes, pg8::StaticOrder, false>(RING, AUXB, g, S, E, wv);
    } SEAM(8);
    if constexpr (IN(9)) REPS(9) { Frame F; mkframe(args, F, lds, wv); router_phase(args, F); } SEAM(9);
    if constexpr (IN(10)) REPS(10) { Frame F; mkframe(args, F, lds, wv); slots_phase(F); } SEAM(10);
#define MOE_SETUP \
        Frame F; mkframe(args, F, lds, wv); LAS int* tex = (LAS int*)(F.lds + TEX_OFF); \
        __syncthreads(); \
        const int texv = F.tid < MAXTILES ? ((const int*)(F.ctl + CW_TEXP))[F.tid] : 0;     \
        const int ntl = __builtin_amdgcn_readfirstlane(((const int*)(F.ctl + CW_MOE))[0]); \
        if (F.tid < MAXTILES) tex[F.tid] = F.tid < ntl ? texv : 0; \
        __syncthreads();
    if constexpr (IN(11)) REPS(11) { MOE_SETUP
        pg8::Gemm g{F.ws + B_X3Q, F.ws + WS_WMGU, DM, DM}; pg8::MoeOrder S{0, ntl, 2 * EDIM / 256, F.G, (int)blockIdx.x, tex};
        pg8::EpiGu<true> E{F.ws + B_HM, EDIM, (const float*)(F.ws + T_SLOT)};
        pg8::gemm_phase<pg8::EpiGu<true>, pg8::MoeOrder, true, true>(RING, AUXB, g, S, E, wv); }
    SEAM(11);
    if constexpr (IN(12)) REPS(12) { MOE_SETUP
        { pg8::Gemm g{F.ws + B_HM, F.ws + WS_WMD, EDIM, EDIM}; pg8::MoeOrder S{0, ntl < 256 ? ntl : 256, DM / 256, F.G, (int)blockIdx.x, tex};
          pg8::EpiMoeDn E{F.ws + WS_Y, (const int*)(F.ws + T_SLOT)};
          pg8::gemm_phase<pg8::EpiMoeDn, pg8::MoeOrder, false, true>(RING, AUXB, g, S, E, wv); }
        if (ntl > 256) { __syncthreads();
          pg8::Gemm g{F.ws + B_HM, F.ws + WS_WMD, 512, EDIM}; pg8::MoeRemOrder S{ntl - 256, F.G, (int)blockIdx.x, tex};
          pg8::EpiMoeDnPart E{(bf16*)(F.ws + B_YP)};
          pg8::gemm_phase<pg8::EpiMoeDnPart, pg8::MoeRemOrder, false, true>(RING, AUXB, g, S, E, wv); } }
    if constexpr (IN(12) && IN(15)) grid_barrier(args, lds, wv);
    if constexpr (IN(15)) { Frame F; mkframe(args, F, lds, wv); combine_phase(F); }
#undef IN
#undef SEAM
}

#ifndef LAST_PHASE
#define LAST_PHASE 15
#endif
#ifndef ONE_LAUNCH
#define ONE_LAUNCH 1
#endif
typedef void (*kern_t)(Args);
template <int P> struct PhaseTab { static void fill(kern_t* t) { t[P] = fwd_kernel<P, P + 1>; PhaseTab<P - 1>::fill(t); } };
template <> struct PhaseTab<-1> { static void fill(kern_t*) {} };
extern "C" void kernel_launch(void* const* d_in, const int* in_sizes, int n_in, void* d_out, int out_size, void* d_ws, size_t ws_size, hipStream_t stream) {
    static int grid = 0; static kern_t tab[N_PHASES + 1];
    if (grid == 0) {
        if (n_in != 21 || in_sizes[0] != MTOK * DM || out_size != MTOK * DM || ws_size < WS_END) { fprintf(stderr, "kernel_launch: unexpected shapes / workspace (%d inputs, ws %zu); nothing launched\n", n_in, ws_size); grid = -1; return; }
        int dev = 0, cus = 0;
        if (hipGetDevice(&dev) != hipSuccess || hipDeviceGetAttribute(&cus, hipDeviceAttributeMultiprocessorCount, dev) != hipSuccess) { grid = -1; return; }
#if ONE_LAUNCH
        tab[N_PHASES] = fwd_kernel<0, LAST_PHASE + 1>;
        if (hipFuncSetAttribute((const void*)tab[N_PHASES], hipFuncAttributeMaxDynamicSharedMemorySize, LDS_BYTES) != hipSuccess) { fprintf(stderr, "kernel_launch: hipFuncSetAttribute failed\n"); grid = -1; return; }
        int per_cu = 0;
        if (hipOccupancyMaxActiveBlocksPerMultiprocessor(&per_cu, (const void*)tab[N_PHASES], NWAVES * 64, LDS_BYTES) != hipSuccess || per_cu < 1) fprintf(stderr, "kernel_launch: note: occupancy query reports %d workgroups per CU\n", per_cu);
#else
        PhaseTab<N_PHASES - 1>::fill(tab);
        for (int p = 0; p < N_PHASES; ++p) if (hipFuncSetAttribute((const void*)tab[p], hipFuncAttributeMaxDynamicSharedMemorySize, LDS_BYTES) != hipSuccess) { fprintf(stderr, "kernel_launch: hipFuncSetAttribute failed\n"); grid = -1; return; }
#endif
        (void)hipGetLastError();
        grid = cus;
        if (grid != 256) fprintf(stderr, "kernel_launch: built for 256 CUs, found %d\n", grid);
    }
    if (grid < 0) return;
    if (hipMemsetAsync((char*)d_ws + WS_CTL, 0, CTL_ZERO_BYTES, stream) != hipSuccess) return;
    Args a{};
    for (int i = 0; i < 21; ++i) a.in[i] = (const float*)d_in[i];
    a.out = (float*)d_out; a.ws = (unsigned char*)d_ws; a.ph_lo = 0; a.ph_hi = LAST_PHASE + 1;
#if ONE_LAUNCH
    hipLaunchKernelGGL(tab[N_PHASES], dim3(grid), dim3(NWAVES * 64), LDS_BYTES, stream, a);
#else
    for (int p = 0; p <= LAST_PHASE; ++p) hipLaunchKernelGGL(tab[p], dim3(grid), dim3(NWAVES * 64), LDS_BYTES, stream, a);
#endif
}
```
